# Optimizing an MI355X kernel written in HIP

```python
import math
import jax, jax.numpy as jnp
from jax import lax
import numpy as np

D_MODEL = 1024
BATCH = 32
SEQ = 2048
DEPTH = 4
DEC_BATCH = 8
DEC_SEQ = 8192
PAST_LEN = 128

MIX_WIDTH = D_MODEL
ATTN_WIDTH = MIX_WIDTH // 2
HYENA_WIDTH = MIX_WIDTH - ATTN_WIDTH
DA_HEADS = 4
DA_HEAD_DIM = ATTN_WIDTH // (2 * DA_HEADS)
DA_V_DIM = 2 * DA_HEAD_DIM
ROPE_DIM = DA_HEAD_DIM // 4
ROPE_THETA = 500000.0
Q_BLOCK = 128
IN_WIDTH = 3 * ATTN_WIDTH + 3 * HYENA_WIDTH
SHORT_CONV = 3
FILTER_EMB = 33
FILTER_ORDER = 64
FAST_DECAY_PCT = 0.3
SLOW_DECAY_PCT = 1.5
DECAY_TARGET = 1e-2
N_MEM = 256
X_HEADS = 4
X_HEAD_DIM = D_MODEL // X_HEADS
D_FF = -(-8 * D_MODEL // (3 * 256)) * 256
EPS = 1e-6

kernel_name = "hymba_diffattn_hyena_encoder"

F32 = jnp.float32


def rms_norm(x, g):
    xf = x.astype(F32)
    y = xf * lax.rsqrt(jnp.mean(xf * xf, axis=-1, keepdims=True) + EPS)
    return (y * g.astype(F32)).astype(x.dtype)


def rope_partial(x):
    L = x.shape[1]
    inv = ROPE_THETA ** (-jnp.arange(0, ROPE_DIM, 2, dtype=F32) / ROPE_DIM)
    ang = jnp.arange(L, dtype=F32)[:, None] * inv[None, :]
    cos = jnp.cos(ang)[:, None, None, :]
    sin = jnp.sin(ang)[:, None, None, :]
    xr = x[..., :ROPE_DIM].astype(F32)
    x1, x2 = xr[..., :ROPE_DIM // 2], xr[..., ROPE_DIM // 2:]
    rot = jnp.concatenate([x1 * cos - x2 * sin, x2 * cos + x1 * sin], axis=-1).astype(x.dtype)
    return jnp.concatenate([rot, x[..., ROPE_DIM:]], axis=-1)


def diff_attention(q, k, v, lam):
    B, L = q.shape[0], q.shape[1]
    nb = L // Q_BLOCK
    scale = DA_HEAD_DIM ** -0.5
    qb = q.reshape(B, nb, Q_BLOCK, DA_HEADS, 2, DA_HEAD_DIM).transpose(1, 0, 2, 3, 4, 5)

    def block(qblk):
        s = jnp.einsum('bqhcd,bkhcd->bchqk', qblk, k).astype(F32) * scale
        p = jax.nn.softmax(s, axis=-1)
        a = (p[:, 0] - lam * p[:, 1]).astype(v.dtype)
        return jnp.einsum('bhqk,bkhe->bqhe', a, v)

    o = lax.map(block, qb)
    return o.transpose(1, 0, 2, 3, 4).reshape(B, L, DA_HEADS, DA_V_DIM)


def short_conv(u, w, b):
    L = u.shape[1]
    pad = SHORT_CONV // 2
    up = jnp.pad(u, ((0, 0), (pad, pad), (0, 0)))
    y = w[0] * up[:, 0:L]
    for j in range(1, SHORT_CONV):
        y = y + w[j] * up[:, j:j + L]
    return y + b


def hyena_filters(L, w1, b1, fr1, w2, b2, fr2, w3):
    t = jnp.linspace(0.0, 1.0, L, dtype=F32)[:, None]
    bands = (FILTER_EMB - 1) // 2
    w = 2.0 * math.pi * jnp.arange(L, dtype=F32)[:, None] / L
    f = jnp.linspace(1e-4, bands - 1, bands, dtype=F32)[None, :]
    fw = f * w
    z = jnp.concatenate([t, jnp.cos(fw), -jnp.sin(fw)], axis=-1)
    h = jnp.sin(fr1 * (z.astype(w1.dtype) @ w1 + b1))
    h = jnp.sin(fr2 * (h @ w2 + b2))
    h = (h @ w3).astype(F32).reshape(L, 2, HYENA_WIDTH)
    max_decay = math.log(DECAY_TARGET) / FAST_DECAY_PCT
    min_decay = math.log(DECAY_TARGET) / SLOW_DECAY_PCT
    deltas = jnp.abs(jnp.linspace(min_decay, max_decay, HYENA_WIDTH, dtype=F32))
    h = h * jnp.exp(-t[:, :, None] * deltas)
    hf, hb = h[:, 0], h[:, 1]
    kern = jnp.concatenate([hf[:1] + hb[:1], hf[1:], jnp.zeros_like(hf[:1]), hb[:0:-1]], axis=0)
    return kern / jnp.sum(jnp.abs(kern), axis=0, keepdims=True)


def long_conv(u, kern):
    L = u.shape[1]
    uf = jnp.fft.rfft(u.astype(F32), n=2 * L, axis=1)
    kf = jnp.fft.rfft(kern, n=2 * L, axis=0)
    return jnp.fft.irfft(uf * kf[None], n=2 * L, axis=1)[:, :L]


def hybrid_mixer(h, l, P):
    B, L = h.shape[0], h.shape[1]
    proj = h @ P['w_in'][l]
    A = ATTN_WIDTH
    qa, ka, va, hy = proj[..., :A], proj[..., A:2 * A], proj[..., 2 * A:3 * A], proj[..., 3 * A:]
    q = rope_partial(qa.reshape(B, L, DA_HEADS, 2, DA_HEAD_DIM))
    k = rope_partial(ka.reshape(B, L, DA_HEADS, 2, DA_HEAD_DIM))
    v = va.reshape(B, L, DA_HEADS, DA_V_DIM)
    lam_init = 0.8 - 0.6 * math.exp(-0.3 * l)
    lam = (jnp.exp(jnp.sum(P['lambda_q1'][l].astype(F32) * P['lambda_k1'][l].astype(F32)))
           - jnp.exp(jnp.sum(P['lambda_q2'][l].astype(F32) * P['lambda_k2'][l].astype(F32))) + lam_init)
    o = diff_attention(q, k, v, lam)
    o = rms_norm(o, P['subln_g'][l]) * (1.0 - lam_init)
    attn_out = o.reshape(B, L, ATTN_WIDTH)
    hy = short_conv(hy, P['conv_w'][l], P['conv_b'][l])
    C = HYENA_WIDTH
    x0, x1, vh = hy[..., :C], hy[..., C:2 * C], hy[..., 2 * C:]
    kern = hyena_filters(L, P['filt_w1'][l], P['filt_b1'][l], P['filt_freq1'][l],
                         P['filt_w2'][l], P['filt_b2'][l], P['filt_freq2'][l], P['filt_w3'][l])
    u = x1 * vh
    y = (long_conv(u, kern).astype(u.dtype) + P['hyena_d'][l] * u) * x0
    return jnp.concatenate([attn_out, y], axis=-1) @ P['w_out'][l]


def memory_cross_attention(h, m, wq, wk, wv, wo):
    B, L = h.shape[0], h.shape[1]
    q = (h @ wq).reshape(B, L, X_HEADS, X_HEAD_DIM)
    k = (m @ wk).reshape(B, N_MEM, X_HEADS, X_HEAD_DIM)
    v = (m @ wv).reshape(B, N_MEM, X_HEADS, X_HEAD_DIM)
    s = jnp.einsum('bqhd,bkhd->bhqk', q, k).astype(F32) * (X_HEAD_DIM ** -0.5)
    p = jax.nn.softmax(s, axis=-1).astype(v.dtype)
    o = jnp.einsum('bhqk,bkhd->bqhd', p, v).reshape(B, L, D_MODEL)
    return o @ wo


def swiglu(h, wg, wu, wd):
    return (jax.nn.silu(h @ wg) * (h @ wu)) @ wd


def trunk(x, mem, P):
    for l in range(DEPTH):
        x = x + rms_norm(hybrid_mixer(rms_norm(x, P['ln_mix_pre'][l]), l, P), P['ln_mix_post'][l])
        m = rms_norm(mem, P['ln_mem'][l])
        x = x + rms_norm(memory_cross_attention(rms_norm(x, P['ln_x_pre'][l]), m, P['wq_x'][l], P['wk_x'][l],
                                                P['wv_x'][l], P['wo_x'][l]), P['ln_x_post'][l])
        x = x + rms_norm(swiglu(rms_norm(x, P['ln_ffn_pre'][l]), P['w_gate'][l], P['w_up'][l], P['w_down'][l]),
                         P['ln_ffn_post'][l])
    return x


def setup_inputs(seed: int = 0) -> dict:
    key = jax.random.key(seed)
    ks = iter(jax.random.split(key, 40))

    def nrm(shape, scale):
        return jax.random.normal(next(ks), shape, F32) * scale

    def gain(n):
        return 1.0 + nrm((DEPTH, n), 0.02)

    D = D_MODEL
    return {
        'x_prompt': nrm((BATCH, SEQ, D), 1.0),
        'x_sample': nrm((DEC_BATCH, DEC_SEQ, D), 1.0),
        'mem_prompt': nrm((BATCH, N_MEM, D), 1.0),
        'mem_sample': nrm((DEC_BATCH, N_MEM, D), 1.0),
        'ln_mix_pre': gain(D),
        'ln_mix_post': gain(D),
        'w_in': nrm((DEPTH, D, IN_WIDTH), D ** -0.5),
        'lambda_q1': nrm((DEPTH, DA_HEAD_DIM), 0.1),
        'lambda_k1': nrm((DEPTH, DA_HEAD_DIM), 0.1),
        'lambda_q2': nrm((DEPTH, DA_HEAD_DIM), 0.1),
        'lambda_k2': nrm((DEPTH, DA_HEAD_DIM), 0.1),
        'subln_g': gain(DA_V_DIM),
        'conv_w': nrm((DEPTH, SHORT_CONV, 3 * HYENA_WIDTH), SHORT_CONV ** -0.5),
        'conv_b': nrm((DEPTH, 3 * HYENA_WIDTH), 0.01),
        'filt_w1': nrm((DEPTH, FILTER_EMB, FILTER_ORDER), FILTER_EMB ** -0.5),
        'filt_b1': nrm((DEPTH, FILTER_ORDER), 0.01),
        'filt_freq1': gain(FILTER_ORDER),
        'filt_w2': nrm((DEPTH, FILTER_ORDER, FILTER_ORDER), FILTER_ORDER ** -0.5),
        'filt_b2': nrm((DEPTH, FILTER_ORDER), 0.01),
        'filt_freq2': gain(FILTER_ORDER),
        'filt_w3': nrm((DEPTH, FILTER_ORDER, 2 * HYENA_WIDTH), FILTER_ORDER ** -0.5),
        'hyena_d': nrm((DEPTH, HYENA_WIDTH), 1.0),
        'w_out': nrm((DEPTH, MIX_WIDTH, D), MIX_WIDTH ** -0.5),
        'ln_x_pre': gain(D),
        'ln_x_post': gain(D),
        'ln_mem': gain(D),
        'wq_x': nrm((DEPTH, D, D), D ** -0.5),
        'wk_x': nrm((DEPTH, D, D), D ** -0.5),
        'wv_x': nrm((DEPTH, D, D), D ** -0.5),
        'wo_x': nrm((DEPTH, D, D), D ** -0.5),
        'ln_ffn_pre': gain(D),
        'ln_ffn_post': gain(D),
        'w_gate': nrm((DEPTH, D, D_FF), D ** -0.5),
        'w_up': nrm((DEPTH, D, D_FF), D ** -0.5),
        'w_down': nrm((DEPTH, D_FF, D), D_FF ** -0.5),
    }


def reference(x_prompt, x_sample, mem_prompt, mem_sample, ln_mix_pre, ln_mix_post, w_in,
              lambda_q1, lambda_k1, lambda_q2, lambda_k2, subln_g, conv_w, conv_b,
              filt_w1, filt_b1, filt_freq1, filt_w2, filt_b2, filt_freq2, filt_w3, hyena_d, w_out,
              ln_x_pre, ln_x_post, ln_mem, wq_x, wk_x, wv_x, wo_x,
              ln_ffn_pre, ln_ffn_post, w_gate, w_up, w_down):
    P = dict(ln_mix_pre=ln_mix_pre, ln_mix_post=ln_mix_post, w_in=w_in,
             lambda_q1=lambda_q1, lambda_k1=lambda_k1, lambda_q2=lambda_q2, lambda_k2=lambda_k2,
             subln_g=subln_g, conv_w=conv_w, conv_b=conv_b,
             filt_w1=filt_w1, filt_b1=filt_b1, filt_freq1=filt_freq1,
             filt_w2=filt_w2, filt_b2=filt_b2, filt_freq2=filt_freq2, filt_w3=filt_w3,
             hyena_d=hyena_d, w_out=w_out,
             ln_x_pre=ln_x_pre, ln_x_post=ln_x_post, ln_mem=ln_mem,
             wq_x=wq_x, wk_x=wk_x, wv_x=wv_x, wo_x=wo_x,
             ln_ffn_pre=ln_ffn_pre, ln_ffn_post=ln_ffn_post,
             w_gate=w_gate, w_up=w_up, w_down=w_down)
    y_prompt = trunk(x_prompt, mem_prompt, P)
    y_sample = trunk(x_sample, mem_sample, P)
    return (y_prompt, y_sample)
```

```cpp
#include <hip/hip_runtime.h>
#include <cstdio>
#include <cstdint>
#define MK_PER_STEP 0
namespace pg8 {
#define PG8_LAS __attribute__((address_space(3)))
typedef unsigned short bf16_t;
typedef short bf16x8 __attribute__((ext_vector_type(8)));
typedef float f32x4 __attribute__((ext_vector_type(4)));
typedef unsigned u32x4 __attribute__((ext_vector_type(4)));
constexpr int BM = 256, BK = 64, HALF = 128, HTB = HALF * BK * 2  , STAGE_BYTES = 8 * HTB, NXCD = 8, WGM = 8;

__host__ __device__ __forceinline__ int lds_byte(int r, int c) { const int st = (r >> 4) * 2 + (c >> 5), rr = r & 15, cc = c & 31, ob = rr * 64 + cc * 2; return st * 1024 + (ob ^ (((ob >> 9) & 1) << 5)); }
__host__ __device__ __forceinline__ void stage_rc(int b, int& R, int& C) { const int st = b / 1024, sb = b % 1024, swz = sb ^ (((sb >> 9) & 1) << 5); R = (st >> 1) * 16 + swz / 64; C = (st & 1) * 32 + (swz % 64) / 2; }
__host__ __device__ __forceinline__ int perm32(int rho) { const int n = rho >> 4, i = rho & 15; return 8 * (i >> 2) + 4 * n + (i & 3); }

struct Unit { int pm, pn; };
struct Gemm { const bf16_t* A; const bf16_t* Bt; int M, N, K; };

struct StaticOrder {
    int nM, nN, nwg, G, c;
    __host__ __device__ void init(int M, int N, int G_, int c_) { nM = M / BM; nN = N / BM; nwg = nM * nN; G = G_; c = c_; }
    __host__ __device__ bool next(int i, Unit& u) const {
        const long L = (long)i * G + c; if (L >= nwg) return false;
        int wgid = (int)L; { const int q = nwg / NXCD, r = nwg % NXCD, xcd = wgid % NXCD, off = wgid / NXCD; wgid = (xcd < r ? xcd * (q + 1) : r * (q + 1) + (xcd - r) * q) + off; }
        const int nig = WGM * nN, gid = wgid / nig, fm = gid * WGM, gsz = (nM - fm) < WGM ? (nM - fm) : WGM;
        u.pm = fm + ((wgid % nig) % gsz); u.pn = (wgid % nig) / gsz; return true;
    }
    __device__ __forceinline__ void a_ready(const Unit&) const {}
    __device__ __forceinline__ void done(const Unit&) const {}
};
struct PanelOrder {
    int nM, nN, G, c; bool tr;
    __host__ __device__ void init(int M, int N, int G_, int c_, bool tr_) { nM = M / BM; nN = N / BM; G = G_; c = c_; tr = tr_; }
    __host__ __device__ bool next(int i, Unit& u) const {
        const int per = tr ? nM : nN, np = tr ? nN : nM; const int pi = i / per, ti = i % per; const int p = c + pi * G; if (p >= np) return false;
        if (tr) { u.pm = ti; u.pn = p; } else { u.pm = p; u.pn = ti; } return true;
    }
    __device__ __forceinline__ void a_ready(const Unit&) const {}
    __device__ __forceinline__ void done(const Unit&) const {}
};
typedef unsigned u32x2 __attribute__((ext_vector_type(2)));
__device__ __forceinline__ unsigned cvt_pk_bf16(float lo, float hi) { unsigned r; asm volatile("v_cvt_pk_bf16_f32 %0, %1, %2" : "=v"(r) : "v"(lo), "v"(hi)); return r; }

struct EpiBf16 {
    static constexpr bool PERM = true, AFTER_DRAIN = false;
    bf16_t* O; int ldc; float scale; const float* rowscale; const float* colscale;
    __device__ __forceinline__ void operator()(const f32x4 (&acc)[2][2][4][2], const Unit& u, int wr, int wc, int fr, int fq) const {
        const int row0 = u.pm * BM + wr * 64 + fr; const int col0 = u.pn * BM + wc * 32 + 8 * fq;
        f32x4 cs[2][2];
#pragma unroll
        for (int bj = 0; bj < 2; ++bj) { if (colscale) { cs[bj][0] = *(const f32x4*)(colscale + col0 + bj * HALF); cs[bj][1] = *(const f32x4*)(colscale + col0 + bj * HALF + 4); }
            else { cs[bj][0] = (f32x4){1.f, 1.f, 1.f, 1.f}; cs[bj][1] = cs[bj][0]; } }
        float rsv[2][4];
#pragma unroll
        for (int ai = 0; ai < 2; ++ai)
#pragma unroll
            for (int m = 0; m < 4; ++m) rsv[ai][m] = rowscale ? scale * rowscale[row0 + ai * HALF + m * 16] : scale;
#pragma unroll
        for (int ai = 0; ai < 2; ++ai)
#pragma unroll
            for (int m = 0; m < 4; ++m) { const int row = row0 + ai * HALF + m * 16; bf16_t* rowp = O + (size_t)row * ldc + col0; const float sc = rsv[ai][m];
#pragma unroll
                for (int bj = 0; bj < 2; ++bj) { const f32x4 v0 = acc[ai][bj][m][0] * cs[bj][0] * sc, v1 = acc[ai][bj][m][1] * cs[bj][1] * sc;
                    u32x4 w; w.x = cvt_pk_bf16(v0[0], v0[1]); w.y = cvt_pk_bf16(v0[2], v0[3]); w.z = cvt_pk_bf16(v1[0], v1[1]); w.w = cvt_pk_bf16(v1[2], v1[3]);
                    *(u32x4*)(rowp + bj * HALF) = w; } }
    }
};
struct EpiRopeQK {
    static constexpr bool PERM = true, AFTER_DRAIN = false;
    bf16_t* O; const float* tab; int lmask; float qscale; const float* rowscale;
    __device__ __forceinline__ void operator()(const f32x4 (&acc)[2][2][4][2], const Unit& u, int wr, int wc, int fr, int fq) const {
        const int row0 = u.pm * BM + wr * 64 + fr; const int col0 = u.pn * BM + wc * 32 + 8 * fq;
        const float sc0 = (u.pn < 2) ? qscale : 1.f;
        const bool ropew = (wc & 1) == 0;
        float scv[2][4];
#pragma unroll
        for (int ai = 0; ai < 2; ++ai)
#pragma unroll
            for (int m = 0; m < 4; ++m) scv[ai][m] = sc0 * rowscale[row0 + ai * HALF + m * 16];
#pragma unroll
        for (int ai = 0; ai < 2; ++ai)
#pragma unroll
          for (int mh = 0; mh < 2; ++mh) {
            f32x4 c0v[2], c1v[2], s0v[2], s1v[2];
#pragma unroll
            for (int mm = 0; mm < 2; ++mm) { const int row = row0 + ai * HALF + (2 * mh + mm) * 16;
                c0v[mm] = (f32x4){1.f, 1.f, 1.f, 1.f}; c1v[mm] = c0v[mm]; s0v[mm] = (f32x4){0.f, 0.f, 0.f, 0.f}; s1v[mm] = s0v[mm];
                if (ropew) { const float* tp = tab + (size_t)(row & lmask) * 16; c0v[mm] = *(const f32x4*)(tp); c1v[mm] = *(const f32x4*)(tp + 4); s0v[mm] = *(const f32x4*)(tp + 8); s1v[mm] = *(const f32x4*)(tp + 12); } }
#pragma unroll
            for (int mm = 0; mm < 2; ++mm) { const int m = 2 * mh + mm; const int row = row0 + ai * HALF + m * 16; bf16_t* rowp = O + (size_t)row * 1024 + col0; const float sc = scv[ai][m];
                f32x4 c0 = c0v[mm], c1 = c1v[mm], s0 = s0v[mm], s1 = s1v[mm];
                if (ropew) {
                    if (fq == 1) { s0 = -s0; s1 = -s1; }
                    if (fq >= 2) { s0 = (f32x4){0.f, 0.f, 0.f, 0.f}; s1 = s0; c0 = (f32x4){1.f, 1.f, 1.f, 1.f}; c1 = c0; } }
#pragma unroll
                for (int bj = 0; bj < 2; ++bj) { f32x4 v0 = acc[ai][bj][m][0], v1 = acc[ai][bj][m][1];
                    if (ropew) { f32x4 p0, p1;
#pragma unroll
                        for (int j = 0; j < 4; ++j) { p0[j] = __shfl_xor(v0[j], 16); p1[j] = __shfl_xor(v1[j], 16); }
                        v0 = v0 * c0 - p0 * s0; v1 = v1 * c1 - p1 * s1; }
                    v0 = v0 * sc; v1 = v1 * sc;
                    u32x4 w; w.x = cvt_pk_bf16(v0[0], v0[1]); w.y = cvt_pk_bf16(v0[2], v0[3]); w.z = cvt_pk_bf16(v1[0], v1[1]); w.w = cvt_pk_bf16(v1[2], v1[3]);
                    *(u32x4*)(rowp + bj * HALF) = w; } }
          }
    }
};
struct EpiSwiGLU {
    static constexpr bool PERM = true, AFTER_DRAIN = false;
    bf16_t* O; int ldc; const float* rowscale;
    __device__ __forceinline__ void operator()(const f32x4 (&acc)[2][2][4][2], const Unit& u, int wr, int wc, int fr, int fq) const {
        const int row0 = u.pm * BM + wr * 64 + fr; const int col0 = (u.pn * BM + wc * 32 + 8 * fq) >> 1;
        float rsv[2][4];
#pragma unroll
        for (int ai = 0; ai < 2; ++ai)
#pragma unroll
            for (int m = 0; m < 4; ++m) rsv[ai][m] = rowscale[row0 + ai * HALF + m * 16];
#pragma unroll
        for (int ai = 0; ai < 2; ++ai)
#pragma unroll
            for (int m = 0; m < 4; ++m) { const int row = row0 + ai * HALF + m * 16; bf16_t* rowp = O + (size_t)row * ldc + col0; const float rsc = rsv[ai][m];
#pragma unroll
                for (int bj = 0; bj < 2; ++bj) { const f32x4 g = acc[ai][bj][m][0] * rsc, up = acc[ai][bj][m][1] * rsc; f32x4 h;
#pragma unroll
                    for (int j = 0; j < 4; ++j) { const float e = __builtin_amdgcn_exp2f(-g[j] * 1.4426950408889634f); h[j] = g[j] * __builtin_amdgcn_rcpf(1.f + e) * up[j]; }
                    u32x2 w; w.x = cvt_pk_bf16(h[0], h[1]); w.y = cvt_pk_bf16(h[2], h[3]);
                    *(u32x2*)(rowp + bj * (HALF / 2)) = w; } }
    }
};
template <class Epi, class Sched, bool ALIGN_EPI = false, bool SP2 = false>
__device__ __forceinline__ void gemm_phase(PG8_LAS unsigned char* lds, const Gemm g, const Sched& S, const Epi& E) {
    int tid_l = threadIdx.x; asm volatile("" : "+v"(tid_l));
    const int tid = tid_l, wid = __builtin_amdgcn_readfirstlane(tid >> 6), lane = tid & 63, wr = wid >> 2, wc = wid & 3, fr = lane & 15, fq = lane >> 4;
    const int K = g.K, nt = K / BK;
    unsigned voffA[2], voffB[2];
#pragma unroll
    for (int i = 0; i < 2; ++i) { int R, C; stage_rc(tid * 16 + i * 8192, R, C); const int Rb = Epi::PERM ? ((R & ~31) + perm32(R & 31)) : R;
        voffA[i] = (unsigned)(R * K + C) * 2u; voffB[i] = (unsigned)(Rb * K + C) * 2u; }
    const size_t kstep = (size_t)(BK * 2);
    const size_t hstep = (size_t)HALF * K * 2;
    const size_t tstep = 2 * hstep;
    const unsigned ldsw = (unsigned)wid * 1024u;
    const int aoff = lds_byte(wr * 64 + fr, fq * 8), boff = lds_byte(wc * 32 + fr, fq * 8);
#define PG8_SA(b, h) (((b) * 2 + (h)) * HTB)
#define PG8_SB(b, h) ((4 + (b) * 2 + (h)) * HTB)
#define PG8_STAGE(bufoff, gbase, voff) do { _Pragma("unroll") for (int _i = 0; _i < 2; ++_i) \
        __builtin_amdgcn_global_load_lds((const unsigned*)((const char*)(gbase) + (voff)[_i]), (PG8_LAS unsigned*)(lds + (bufoff) + ldsw + _i * 8192), 16, 0, 0); } while (0)
#define PG8_LDA(dst, b, h) do { _Pragma("unroll") for (int m = 0; m < 4; ++m) _Pragma("unroll") for (int k = 0; k < 2; ++k) dst[m][k] = *(const PG8_LAS bf16x8*)(lds + PG8_SA(b, h) + aoff + m * 2048 + k * 1024); } while (0)
#define PG8_LDB(dst, b, h) do { _Pragma("unroll") for (int n = 0; n < 2; ++n) _Pragma("unroll") for (int k = 0; k < 2; ++k) dst[n][k] = *(const PG8_LAS bf16x8*)(lds + PG8_SB(b, h) + boff + n * 2048 + k * 1024); } while (0)
#define PG8_MMA(ai, bj, At, Bt) do { __builtin_amdgcn_s_setprio(1); _Pragma("unroll") for (int m = 0; m < 4; ++m) _Pragma("unroll") for (int n = 0; n < 2; ++n) _Pragma("unroll") for (int k = 0; k < 2; ++k) \
        acc[ai][bj][m][n] = __builtin_amdgcn_mfma_f32_16x16x32_bf16(Bt[n][k], At[m][k], acc[ai][bj][m][n], 0, 0, 0); __builtin_amdgcn_s_setprio(0); } while (0)
#define PG8_WAIT_V(n) asm volatile("s_waitcnt vmcnt(" #n ")" ::: "memory")
#define PG8_WAIT_L(n) asm volatile("s_waitcnt lgkmcnt(" #n ")" ::: "memory")
#define PG8_BAR __builtin_amdgcn_s_barrier()
#define PG8_SCHED __builtin_amdgcn_sched_barrier(0)
    Unit cur, nxt; int ui = 0;
    if (!S.next(0, cur)) return;
    f32x4 acc[2][2][4][2];
#pragma unroll
    for (int a = 0; a < 2; ++a)
#pragma unroll
        for (int b = 0; b < 2; ++b)
#pragma unroll
            for (int m = 0; m < 4; ++m)
#pragma unroll
                for (int n = 0; n < 2; ++n) acc[a][b][m][n] = (f32x4){0.f, 0.f, 0.f, 0.f};
    bf16x8 At[4][2], B0[2][2], B1[2][2];
    const char* cA = (const char*)g.A + (size_t)cur.pm * tstep; const char* cB = (const char*)g.Bt + (size_t)cur.pn * tstep;
    S.a_ready(cur);
    if constexpr (SP2) {
        PG8_STAGE(PG8_SB(0, 0), cB, voffB); PG8_STAGE(PG8_SB(0, 1), cB + hstep, voffB); PG8_STAGE(PG8_SA(0, 0), cA, voffA); PG8_STAGE(PG8_SA(0, 1), cA + hstep, voffA);
        if (wr == 1) PG8_BAR;
        PG8_WAIT_V(2); PG8_BAR;
        PG8_STAGE(PG8_SB(1, 0), cB + kstep, voffB); PG8_STAGE(PG8_SA(1, 0), cA + kstep, voffA); PG8_STAGE(PG8_SB(1, 1), cB + hstep + kstep, voffB);
        PG8_WAIT_V(6); PG8_BAR;
    } else {
        PG8_STAGE(PG8_SB(0, 0), cB, voffB); PG8_STAGE(PG8_SA(0, 0), cA, voffA); PG8_STAGE(PG8_SB(0, 1), cB + hstep, voffB); PG8_STAGE(PG8_SA(0, 1), cA + hstep, voffA);
        if (wr == 1) PG8_BAR;
        PG8_WAIT_V(4); PG8_BAR;
        PG8_STAGE(PG8_SB(1, 0), cB + kstep, voffB); PG8_STAGE(PG8_SA(1, 0), cA + kstep, voffA); PG8_STAGE(PG8_SB(1, 1), cB + hstep + kstep, voffB);
        PG8_WAIT_V(6); PG8_BAR;
    }
    for (;;) {
        const bool has_next = S.next(ui + 1, nxt);
        const char* nA = has_next ? (const char*)g.A + (size_t)nxt.pm * tstep : cA; const char* nB = has_next ? (const char*)g.Bt + (size_t)nxt.pn * tstep : cB;
        for (int t = 0; t < nt; t += 2) {
            const bool last = (t == nt - 2);
            const char* a1 = cA + (size_t)(t + 1) * kstep;
            const char* a2 = last ? nA : cA + (size_t)(t + 2) * kstep; const char* b2 = last ? nB : cB + (size_t)(t + 2) * kstep;
            const char* a3 = a2 + kstep; const char* b3 = b2 + kstep;
            if (last && has_next) S.a_ready(nxt);
            if constexpr (SP2) {
            PG8_LDB(B0, 0, 0); PG8_LDB(B1, 0, 1); PG8_SCHED; PG8_LDA(At, 0, 0); PG8_STAGE(PG8_SA(1, 1), a1 + hstep, voffA);
            PG8_WAIT_V(8); PG8_WAIT_L(0); PG8_BAR; PG8_MMA(0, 0, At, B0); PG8_MMA(0, 1, At, B1); PG8_BAR; PG8_SCHED;
            PG8_LDA(At, 0, 1); PG8_STAGE(PG8_SB(0, 0), b2, voffB); PG8_STAGE(PG8_SB(0, 1), b2 + hstep, voffB); PG8_STAGE(PG8_SA(0, 0), a2, voffA);
            PG8_WAIT_V(8); PG8_WAIT_L(0); PG8_BAR; PG8_MMA(1, 0, At, B0); PG8_MMA(1, 1, At, B1); PG8_BAR; PG8_SCHED;
            PG8_LDB(B0, 1, 0); PG8_LDB(B1, 1, 1); PG8_SCHED; PG8_LDA(At, 1, 0); PG8_STAGE(PG8_SA(0, 1), a2 + hstep, voffA);
            PG8_WAIT_V(8); PG8_WAIT_L(0); PG8_BAR; PG8_MMA(0, 0, At, B0); PG8_MMA(0, 1, At, B1); PG8_BAR; PG8_SCHED;
            PG8_LDA(At, 1, 1); PG8_STAGE(PG8_SB(1, 0), b3, voffB); PG8_STAGE(PG8_SB(1, 1), b3 + hstep, voffB); PG8_STAGE(PG8_SA(1, 0), a3, voffA);
            PG8_WAIT_V(8); PG8_WAIT_L(0); PG8_BAR; PG8_MMA(1, 0, At, B0); PG8_MMA(1, 1, At, B1); PG8_BAR; PG8_SCHED;
            } else {
            PG8_LDB(B0, 0, 0); PG8_SCHED; PG8_LDA(At, 0, 0); PG8_STAGE(PG8_SA(1, 1), a1 + hstep, voffA);
            PG8_WAIT_L(8); PG8_BAR; PG8_WAIT_L(0); PG8_MMA(0, 0, At, B0); PG8_BAR; PG8_SCHED;
            PG8_LDB(B1, 0, 1); PG8_STAGE(PG8_SB(0, 0), b2, voffB);
            PG8_BAR; PG8_WAIT_L(0); PG8_MMA(0, 1, At, B1); PG8_BAR;
            PG8_LDA(At, 0, 1); PG8_STAGE(PG8_SA(0, 0), a2, voffA);
            PG8_BAR; PG8_WAIT_L(0); PG8_MMA(1, 0, At, B0); PG8_BAR; PG8_SCHED;
            PG8_STAGE(PG8_SB(0, 1), b2 + hstep, voffB);
            PG8_WAIT_V(6); PG8_BAR; PG8_MMA(1, 1, At, B1); PG8_BAR;
            PG8_LDB(B0, 1, 0); PG8_SCHED; PG8_LDA(At, 1, 0); PG8_STAGE(PG8_SA(0, 1), a2 + hstep, voffA);
            PG8_WAIT_L(8); PG8_BAR; PG8_WAIT_L(0); PG8_MMA(0, 0, At, B0); PG8_BAR; PG8_SCHED;
            PG8_LDB(B1, 1, 1); PG8_STAGE(PG8_SB(1, 0), b3, voffB);
            PG8_BAR; PG8_WAIT_L(0); PG8_MMA(0, 1, At, B1); PG8_BAR;
            PG8_LDA(At, 1, 1); PG8_STAGE(PG8_SA(1, 0), a3, voffA);
            PG8_BAR; PG8_WAIT_L(0); PG8_MMA(1, 0, At, B0); PG8_BAR; PG8_SCHED;
            PG8_STAGE(PG8_SB(1, 1), b3 + hstep, voffB);
            PG8_WAIT_V(6); PG8_BAR; PG8_MMA(1, 1, At, B1); PG8_BAR;
            }
        }
        if constexpr (ALIGN_EPI) { if (wr == 0) PG8_BAR; }
        if constexpr (!Epi::AFTER_DRAIN) { E(acc, cur, wr, wc, fr, fq); S.done(cur); }
        if (!has_next) break;
#pragma unroll
        for (int a = 0; a < 2; ++a)
#pragma unroll
            for (int b = 0; b < 2; ++b)
#pragma unroll
                for (int m = 0; m < 4; ++m)
#pragma unroll
                    for (int n = 0; n < 2; ++n) acc[a][b][m][n] = (f32x4){0.f, 0.f, 0.f, 0.f};
        cur = nxt; cA = nA; cB = nB; ++ui;
        if constexpr (ALIGN_EPI) { if (wr == 1) PG8_BAR; }
    }
    PG8_WAIT_V(0);
    if constexpr (!ALIGN_EPI) { if (wr == 0) PG8_BAR; }
    PG8_BAR;
    if constexpr (Epi::AFTER_DRAIN) { E.fused(acc, cur, wr, wc, fr, fq, lds, wid, lane); S.done(cur); }
#undef PG8_SA
#undef PG8_SB
#undef PG8_STAGE
#undef PG8_LDA
#undef PG8_LDB
#undef PG8_MMA
#undef PG8_WAIT_V
#undef PG8_WAIT_L
#undef PG8_BAR
#undef PG8_SCHED
}
}
#define GAS __attribute__((address_space(1)))
#define LAS __attribute__((address_space(3)))
typedef unsigned short bf16;
typedef float f32x4 __attribute__((ext_vector_type(4)));
typedef float f32x2 __attribute__((ext_vector_type(2)));
typedef float f32x16 __attribute__((ext_vector_type(16)));
typedef short bf16x8 __attribute__((ext_vector_type(8)));
typedef short s16x4 __attribute__((ext_vector_type(4)));
typedef unsigned u32x4 __attribute__((ext_vector_type(4)));
typedef unsigned u32x2 __attribute__((ext_vector_type(2)));

constexpr int DM = 1024, DEPTH = 4, TOK = 65536, NMEMK = 256, DFF = 2816, NWAVES = 8, NTHR = 512;
constexpr float EPS = 1e-6f;
constexpr float LOG2E = 1.4426950408889634f;
constexpr size_t MiB = 1u << 20;
constexpr size_t WS_CTL = 0, CTL_ZERO_BYTES = 2 * MiB;
constexpr size_t WS_TAB = 2 * MiB;
constexpr size_t WS_RS = WS_TAB + 512 * 1024;
constexpr size_t WS_W = 3 * MiB;
constexpr size_t WL_IN = 0, WL_OUT = 3072 * 1024, WL_Q = WL_OUT + 1024 * 1024, WL_K = WL_Q + 1024 * 1024, WL_V = WL_K + 1024 * 1024, WL_O = WL_V + 1024 * 1024,
                 WL_GU = WL_O + 1024 * 1024, WL_D = WL_GU + 5632 * 1024, WL_STRIDE = WL_D + 1024 * 2816;
static_assert(WL_STRIDE * 2 * 4 == 130 * MiB, "weights");
constexpr size_t WS_HN = 133 * MiB;
constexpr size_t WS_QK = 261 * MiB;
constexpr size_t WS_VHT = 389 * MiB;
constexpr size_t WS_MIX = 645 * MiB;
constexpr size_t WS_YT = 773 * MiB;
constexpr size_t WS_KF = 837 * MiB;
constexpr size_t WS_KERNT = 901 * MiB;
constexpr size_t WS_MN = 933 * MiB, WS_KX = 949 * MiB, WS_VXT = 965 * MiB, WS_END = 981 * MiB;
constexpr int N_STEPS = 1 + 2 * 49;
constexpr int LDS_BYTES = 160 * 1024 - 512;
constexpr int LDS_MISC = 144 * 1024;
typedef GAS unsigned gu32;
#define RLX_AGENT __ATOMIC_RELAXED, __HIP_MEMORY_SCOPE_AGENT
#define LDS_WAIT() asm volatile("s_waitcnt lgkmcnt(0)" ::: "memory")
#define VM_WAIT() asm volatile("s_waitcnt vmcnt(0)" ::: "memory")
typedef __bf16 bf16x2_t __attribute__((ext_vector_type(2)));
__device__ __forceinline__ unsigned pkbf(float lo, float hi) { const f32x2 v = {lo, hi}; const bf16x2_t b = __builtin_convertvector(v, bf16x2_t); return __builtin_bit_cast(unsigned, b); }
__device__ __forceinline__ float bf_lo(unsigned w) { return __uint_as_float(w << 16); }
__device__ __forceinline__ float bf_hi(unsigned w) { return __uint_as_float(w & 0xffff0000u); }
__device__ __forceinline__ float bf1(bf16 h) { return __uint_as_float(((unsigned)h) << 16); }
__device__ __forceinline__ float dpp_add(float v, const int ctrl_sel) {
    const int x = __builtin_bit_cast(int, v); int y;
    if (ctrl_sel == 0) y = __builtin_amdgcn_update_dpp(0, x, 0xB1, 0xF, 0xF, true);
    else if (ctrl_sel == 1) y = __builtin_amdgcn_update_dpp(0, x, 0x4E, 0xF, 0xF, true);
    else if (ctrl_sel == 2) y = __builtin_amdgcn_update_dpp(0, x, 0x141, 0xF, 0xF, true);
    else y = __builtin_amdgcn_update_dpp(0, x, 0x140, 0xF, 0xF, true);
    return v + __builtin_bit_cast(float, y);
}
__device__ __forceinline__ float wave_sum(float v) {
    v = dpp_add(v, 0); v = dpp_add(v, 1); v = dpp_add(v, 2); v = dpp_add(v, 3);
    const int x = __builtin_bit_cast(int, v);
    const float r0 = __builtin_bit_cast(float, __builtin_amdgcn_readlane(x, 0)), r1 = __builtin_bit_cast(float, __builtin_amdgcn_readlane(x, 16)),
                r2 = __builtin_bit_cast(float, __builtin_amdgcn_readlane(x, 32)), r3 = __builtin_bit_cast(float, __builtin_amdgcn_readlane(x, 48));
    return (r0 + r1) + (r2 + r3);
}
#define XB_TMO      128
#define XB_XCNT(j)  (256  + 64 * (j))
#define XB_XSUB(j)  (1280 + 64 * (j))
#define XB_XGEN(j)  (2304 + 64 * (j))
#define XB_TOP      3328
#define XB_TOPGEN   3392
#define XCD_BAR_WORDS 3456
#define XB_SPIN_CAP (1u << 18)

__device__ __forceinline__ unsigned xb_ld(unsigned* p)              { return __hip_atomic_load(p, __ATOMIC_RELAXED, __HIP_MEMORY_SCOPE_AGENT); }
__device__ __forceinline__ unsigned xb_add(unsigned* p, unsigned v) { return __hip_atomic_fetch_add(p, v, __ATOMIC_RELAXED, __HIP_MEMORY_SCOPE_AGENT); }
__device__ __forceinline__ unsigned xb_xcc_id() { return (unsigned)__builtin_amdgcn_s_getreg((3 << 11) | 20) & 0xFu; }
#define XB_SPIN(cond, bar) do { unsigned _sp = 0; while (cond) { __builtin_amdgcn_s_sleep(1); \
    if ((++_sp & 255u) == 0u) { if (xb_ld(&(bar)[XB_TMO])) break; if (_sp > XB_SPIN_CAP) { atomicAdd(&(bar)[XB_TMO], 1u); break; } } } } while (0)

struct XcdBarrier {
    unsigned* bar; unsigned x;
    volatile LAS unsigned* st;
};

__device__ __forceinline__ XcdBarrier xcd_barrier_post(unsigned* bar, volatile LAS unsigned* st) {
    XcdBarrier b; b.bar = bar; b.x = xb_xcc_id(); b.st = st;
    if (threadIdx.x == 0) (void)xb_add(&bar[XB_XCNT(b.x)], 1u);
    return b;
}
__device__ __forceinline__ void xcd_barrier_complete(unsigned* bar, unsigned x, unsigned& nloc, unsigned& nx) {
    const unsigned G = gridDim.x * gridDim.y * gridDim.z;
    unsigned sum, cnt, mine, sp = 0u;
    for (;;) {
        sum = 0u; cnt = 0u; mine = 0u;
#pragma unroll
        for (unsigned j = 0; j < 16; ++j) { const unsigned c = xb_ld(&bar[XB_XCNT(j)]); sum += c; cnt += (c > 0u) ? 1u : 0u; mine = (j == x) ? c : mine; }
        if (sum == G) break;
        __builtin_amdgcn_s_sleep(1);
        if ((++sp & 255u) == 0u) { if (xb_ld(&bar[XB_TMO])) break; if (sp > XB_SPIN_CAP) { atomicAdd(&bar[XB_TMO], 1u); break; } }
    }
    nloc = mine > 0u ? mine : 1u; nx = cnt > 0u ? cnt : 1u;
}

__device__ __forceinline__ void xcd_barrier(const XcdBarrier& b) {
    asm volatile("s_waitcnt vmcnt(0)" ::: "memory");
    __syncthreads();
    if (threadIdx.x == 0) {
        unsigned* bar = b.bar;
        __builtin_amdgcn_s_waitcnt(0);
        unsigned nloc = b.st[0], nx = b.st[1];
        if (nloc == 0u) { xcd_barrier_complete(bar, b.x, nloc, nx); b.st[0] = nloc; b.st[1] = nx; }
        const unsigned old = xb_add(&bar[XB_XSUB(b.x)], 1u);
        const unsigned gen = old / nloc;
        if (old + 1u == (gen + 1u) * nloc) {
            __builtin_amdgcn_fence(__ATOMIC_RELEASE, "agent");
            asm volatile("s_waitcnt vmcnt(0)" ::: "memory");
            const unsigned og = xb_add(&bar[XB_TOP], 1u);
            const unsigned tg = og / nx;
            if (og + 1u == (tg + 1u) * nx) xb_add(&bar[XB_TOPGEN], 1u);
            else XB_SPIN(xb_ld(&bar[XB_TOPGEN]) == tg, bar);
            __builtin_amdgcn_fence(__ATOMIC_ACQUIRE, "agent");
            xb_add(&bar[XB_XGEN(b.x)], 1u);
            asm volatile("s_waitcnt vmcnt(0)" ::: "memory");
        } else {
            XB_SPIN(xb_ld(&bar[XB_XGEN(b.x)]) == gen, bar);
            __builtin_amdgcn_fence(__ATOMIC_ACQUIRE, "agent");
            asm volatile("s_waitcnt vmcnt(0)" ::: "memory");
        }
    }
    __syncthreads();
}
struct Args { const void* p[37]; int s_lo, s_hi, li, pad; };
#define AIN(a, k, zs) ((const float*)(a).p[(k) + (zs)])
#define AWS(a, zs) ((unsigned char*)(a).p[36 + (zs)])
#define AOUT(a, zs) ((float*)(a).p[35 + (zs)])
struct Frame {
    LAS unsigned char* lds;
    int tid, lane, wave, vcu, G, zs;
};
__device__ __forceinline__ int grpB(int g) { return g == 0 ? 32 : 8; }
__device__ __forceinline__ int grpL(int g) { return g == 0 ? 2048 : 8192; }
__device__ __forceinline__ int grpMem(int g) { return g == 0 ? 8192 : 2048; }

__device__ __forceinline__ void transpose_item(const float* W, int K, int N, bf16* WT, int mode, LAS float* scr, int item, int lane, const float* gk = nullptr) {
    const int nblk = N / 32, kb = item / nblk, nb = item % nblk, k0 = 64 * kb, n0 = 32 * nb;
#pragma unroll 8
    for (int i = 0; i < 32; ++i) { const int kk = 2 * i + (lane >> 5); scr[kk * 33 + (lane & 31)] = W[(size_t)(k0 + kk) * N + n0 + (lane & 31)]; }
    LDS_WAIT(); asm volatile("" ::: "memory");
    const int c = lane & 7;
    f32x4 g0 = (f32x4){1.f, 1.f, 1.f, 1.f}, g1 = g0;
    if (gk) { g0 = *(const GAS f32x4*)(gk + k0 + 8 * c); g1 = *(const GAS f32x4*)(gk + k0 + 8 * c + 4); }
#pragma unroll
    for (int j = 0; j < 4; ++j) { const int n = (lane >> 3) + 8 * j; const LAS float* s = scr + (8 * c) * 33 + n;
        u32x4 o; o.x = pkbf(s[0 * 33] * g0.x, s[1 * 33] * g0.y); o.y = pkbf(s[2 * 33] * g0.z, s[3 * 33] * g0.w); o.z = pkbf(s[4 * 33] * g1.x, s[5 * 33] * g1.y); o.w = pkbf(s[6 * 33] * g1.z, s[7 * 33] * g1.w);
        const int ng = n0 + n; const int dr = (mode == 0) ? ng : (8 * (ng >> 2) + (ng & 3) + (mode == 2 ? 4 : 0));
        *(GAS u32x4*)(WT + (size_t)dr * K + k0 + 8 * c) = o; }
    LDS_WAIT(); asm volatile("" ::: "memory");
}
__device__ __forceinline__ void phase_prologue(const Frame& F, const Args& a) {
    LAS float* scr = (LAS float*)(F.lds + F.wave * 16384);
    const int gw = F.vcu * NWAVES + F.wave, NGW = F.G * NWAVES;
    bf16* WB = (bf16*)(AWS(a, F.zs) + WS_W);
    constexpr int I_IN = 16 * 96, I_SQ = 16 * 32, I_G = 16 * 88, I_D = 44 * 32;
    constexpr int PER_LAYER = I_IN + 5 * I_SQ + 2 * I_G + I_D;
    for (int it = gw; it < DEPTH * PER_LAYER; it += NGW) {
        const int l = it / PER_LAYER; int r = it % PER_LAYER; bf16* wl = WB + (size_t)l * WL_STRIDE;
        if (r < I_IN) { transpose_item(AIN(a, 6, F.zs) + (size_t)l * 1024 * 3072, 1024, 3072, wl + WL_IN, 0, scr, r, F.lane, AIN(a, 4, F.zs) + l * DM); continue; } r -= I_IN;
        if (r < I_SQ) { transpose_item(AIN(a, 22, F.zs) + (size_t)l * 1024 * 1024, 1024, 1024, wl + WL_OUT, 0, scr, r, F.lane); continue; } r -= I_SQ;
        if (r < I_SQ) { transpose_item(AIN(a, 26, F.zs) + (size_t)l * 1024 * 1024, 1024, 1024, wl + WL_Q, 0, scr, r, F.lane, AIN(a, 23, F.zs) + l * DM); continue; } r -= I_SQ;
        if (r < I_SQ) { transpose_item(AIN(a, 27, F.zs) + (size_t)l * 1024 * 1024, 1024, 1024, wl + WL_K, 0, scr, r, F.lane); continue; } r -= I_SQ;
        if (r < I_SQ) { transpose_item(AIN(a, 28, F.zs) + (size_t)l * 1024 * 1024, 1024, 1024, wl + WL_V, 0, scr, r, F.lane); continue; } r -= I_SQ;
        if (r < I_SQ) { transpose_item(AIN(a, 29, F.zs) + (size_t)l * 1024 * 1024, 1024, 1024, wl + WL_O, 0, scr, r, F.lane); continue; } r -= I_SQ;
        if (r < I_G) { transpose_item(AIN(a, 32, F.zs) + (size_t)l * 1024 * DFF, 1024, DFF, wl + WL_GU, 1, scr, r, F.lane, AIN(a, 30, F.zs) + l * DM); continue; } r -= I_G;
        if (r < I_G) { transpose_item(AIN(a, 33, F.zs) + (size_t)l * 1024 * DFF, 1024, DFF, wl + WL_GU, 2, scr, r, F.lane, AIN(a, 30, F.zs) + l * DM); continue; } r -= I_G;
        transpose_item(AIN(a, 34, F.zs) + (size_t)l * DFF * 1024, DFF, 1024, wl + WL_D, 0, scr, r, F.lane);
    }
    float* tab = (float*)(AWS(a, F.zs) + WS_TAB);
    for (int i = F.vcu * NTHR + F.tid; i < 8192 * 8; i += F.G * NTHR) { const int pos = i >> 3, j = i & 7;
        const float inv = (float)pow(500000.0, -(double)j / 8.0); const float ang = (float)pos * inv;
        tab[pos * 16 + j] = (float)cos((double)ang); tab[pos * 16 + 8 + j] = (float)sin((double)ang); }
}

template <int R> __device__ __forceinline__ void rowop_rows(const float* xin, const bf16* sub, const float* gpost, float* xout, const float* gpre, bf16* hn, int m0, int rstride, int lane) {
    f32x4 v[R][4]; u32x2 sw[R][4];
#pragma unroll
    for (int r = 0; r < R; ++r) { const GAS f32x4* xr = (const GAS f32x4*)(xin + (size_t)(m0 + r * rstride) * DM) + lane;
#pragma unroll
        for (int j = 0; j < 4; ++j) v[r][j] = __builtin_nontemporal_load(xr + 64 * j); }
    if (sub) {
#pragma unroll
        for (int r = 0; r < R; ++r) { const GAS u32x2* sr = (const GAS u32x2*)(sub + (size_t)(m0 + r * rstride) * DM) + lane;
#pragma unroll
            for (int j = 0; j < 4; ++j) sw[r][j] = __builtin_nontemporal_load(sr + 64 * j); }
        f32x4 gp[4];
#pragma unroll
        for (int j = 0; j < 4; ++j) gp[j] = ((const GAS f32x4*)gpost + lane)[64 * j];
        float ss[R];
#pragma unroll
        for (int r = 0; r < R; ++r) { ss[r] = 0.f;
#pragma unroll
            for (int j = 0; j < 4; ++j) { const float a = bf_lo(sw[r][j].x), b = bf_hi(sw[r][j].x), c = bf_lo(sw[r][j].y), d = bf_hi(sw[r][j].y); ss[r] += (a * a + b * b) + (c * c + d * d); } }
#pragma unroll
        for (int r = 0; r < R; ++r) ss[r] = wave_sum(ss[r]);
#pragma unroll
        for (int r = 0; r < R; ++r) { const float rs = 1.0f / sqrtf(ss[r] * (1.f / DM) + EPS); GAS f32x4* xo = (GAS f32x4*)(xout + (size_t)(m0 + r * rstride) * DM) + lane;
#pragma unroll
            for (int j = 0; j < 4; ++j) { const f32x4 sv = (f32x4){bf_lo(sw[r][j].x), bf_hi(sw[r][j].x), bf_lo(sw[r][j].y), bf_hi(sw[r][j].y)};
                v[r][j] = v[r][j] + (sv * rs) * gp[j]; __builtin_nontemporal_store(v[r][j], xo + 64 * j); } }
    }
    if (hn) {
        f32x4 gq[4];
#pragma unroll
        for (int j = 0; j < 4; ++j) gq[j] = ((const GAS f32x4*)gpre + lane)[64 * j];
        float ss[R];
#pragma unroll
        for (int r = 0; r < R; ++r) { ss[r] = 0.f;
#pragma unroll
            for (int j = 0; j < 4; ++j) ss[r] += (v[r][j].x * v[r][j].x + v[r][j].y * v[r][j].y) + (v[r][j].z * v[r][j].z + v[r][j].w * v[r][j].w); }
#pragma unroll
        for (int r = 0; r < R; ++r) ss[r] = wave_sum(ss[r]);
#pragma unroll
        for (int r = 0; r < R; ++r) { const float rs = 1.0f / sqrtf(ss[r] * (1.f / DM) + EPS); GAS u32x2* ho = (GAS u32x2*)(hn + (size_t)(m0 + r * rstride) * DM) + lane;
#pragma unroll
            for (int j = 0; j < 4; ++j) { const f32x4 o = (v[r][j] * rs) * gq[j]; u32x2 w; w.x = pkbf(o.x, o.y); w.y = pkbf(o.z, o.w); ho[64 * j] = w; } }
    }
}

__device__ __forceinline__ void unpack8(const u32x4 w, float (&f)[8]) { f[0] = bf_lo(w.x); f[1] = bf_hi(w.x); f[2] = bf_lo(w.y); f[3] = bf_hi(w.y); f[4] = bf_lo(w.z); f[5] = bf_hi(w.z); f[6] = bf_lo(w.w); f[7] = bf_hi(w.w); }
__device__ __forceinline__ u32x4 pack8(const float (&f)[8]) { return (u32x4){pkbf(f[0], f[1]), pkbf(f[2], f[3]), pkbf(f[4], f[5]), pkbf(f[6], f[7])}; }
template <int MODE, int R> __device__ __forceinline__ void rowop_bf(const float* xf, bf16* xb, const bf16* sub, const float* gpost, float* rsout, float* outf, int m0, int rstride, int lane, bf16* xbo = nullptr) {
    if (!xbo) xbo = xb;
    f32x4 xr[MODE == 0 ? R : 1][4]; u32x4 xw[MODE == 0 ? 1 : R][2], sw[MODE == 0 ? 1 : R][2];
    if (MODE == 0) {
#pragma unroll
        for (int r = 0; r < R; ++r) { const GAS f32x4* p = (const GAS f32x4*)(xf + (size_t)(m0 + r * rstride) * DM) + 2 * lane;
            xr[r][0] = __builtin_nontemporal_load(p); xr[r][1] = __builtin_nontemporal_load(p + 1); xr[r][2] = __builtin_nontemporal_load(p + 128); xr[r][3] = __builtin_nontemporal_load(p + 129); }
    } else {
#pragma unroll
        for (int r = 0; r < R; ++r) { const GAS u32x4* p = (const GAS u32x4*)(xb + (size_t)(m0 + r * rstride) * DM) + lane; xw[r][0] = p[0]; xw[r][1] = p[64];
            const GAS u32x4* q = (const GAS u32x4*)(sub + (size_t)(m0 + r * rstride) * DM) + lane; sw[r][0] = __builtin_nontemporal_load(q); sw[r][1] = __builtin_nontemporal_load(q + 64); }
    }
    float g[16];
    if (MODE != 0) { const GAS f32x4* gp = (const GAS f32x4*)gpost + 2 * lane; const f32x4 a = gp[0], b = gp[1], c = gp[128], d = gp[129];
        g[0] = a.x; g[1] = a.y; g[2] = a.z; g[3] = a.w; g[4] = b.x; g[5] = b.y; g[6] = b.z; g[7] = b.w; g[8] = c.x; g[9] = c.y; g[10] = c.z; g[11] = c.w; g[12] = d.x; g[13] = d.y; g[14] = d.z; g[15] = d.w; }
#pragma unroll
    for (int r = 0; r < R; ++r) {
        const int m = m0 + r * rstride; float x[16];
        if (MODE == 0) {
#pragma unroll
            for (int j = 0; j < 4; ++j) { x[4 * j] = xr[r][j].x; x[4 * j + 1] = xr[r][j].y; x[4 * j + 2] = xr[r][j].z; x[4 * j + 3] = xr[r][j].w; }
        } else {
            float s0[8], s1[8], x0[8], x1[8]; unpack8(sw[r][0], s0); unpack8(sw[r][1], s1); unpack8(xw[r][0], x0); unpack8(xw[r][1], x1);
            float ss = 0.f;
#pragma unroll
            for (int j = 0; j < 8; ++j) ss += s0[j] * s0[j] + s1[j] * s1[j];
            const float rs = 1.0f / sqrtf(wave_sum(ss) * (1.f / DM) + EPS);
#pragma unroll
            for (int j = 0; j < 8; ++j) { x[j] = x0[j] + (s0[j] * rs) * g[j]; x[8 + j] = x1[j] + (s1[j] * rs) * g[8 + j]; }
        }
        if (MODE == 2) {
            GAS f32x4* p = (GAS f32x4*)(outf + (size_t)m * DM) + 2 * lane;
            __builtin_nontemporal_store((f32x4){x[0], x[1], x[2], x[3]}, p); __builtin_nontemporal_store((f32x4){x[4], x[5], x[6], x[7]}, p + 1);
            __builtin_nontemporal_store((f32x4){x[8], x[9], x[10], x[11]}, p + 128); __builtin_nontemporal_store((f32x4){x[12], x[13], x[14], x[15]}, p + 129);
        } else {
            float ss = 0.f;
#pragma unroll
            for (int j = 0; j < 16; ++j) ss += x[j] * x[j];
            ss = wave_sum(ss);
            GAS u32x4* p = (GAS u32x4*)(xbo + (size_t)m * DM) + lane; float a[8], b[8];
#pragma unroll
            for (int j = 0; j < 8; ++j) { a[j] = x[j]; b[j] = x[8 + j]; }
            p[0] = pack8(a); p[64] = pack8(b);
            if (lane == 0) rsout[m] = 1.0f / sqrtf(ss * (1.f / DM) + EPS);
        }
    }
}
__device__ __forceinline__ f32x2 cmul(f32x2 a, f32x2 b) { return (f32x2){a.x * b.x - a.y * b.y, a.x * b.y + a.y * b.x}; }
__device__ __forceinline__ f32x2 twid(float ph) { return (f32x2){__builtin_amdgcn_cosf(ph), -__builtin_amdgcn_sinf(ph)}; }
#define ZI(i) ((i) ^ (((i) >> 4) & 15))
template <bool INV> __device__ __forceinline__ void r4bf(f32x2& a0, f32x2& a1, f32x2& a2, f32x2& a3, float ph) {
    if (!INV) {
        const f32x2 t0 = a0 + a2, t1 = a0 - a2, t2 = a1 + a3, d = a1 - a3; const f32x2 t3 = (f32x2){d.y, -d.x};
        a0 = t0 + t2; a1 = cmul(t1 + t3, twid(ph)); a2 = cmul(t0 - t2, twid(2.f * ph)); a3 = cmul(t1 - t3, twid(3.f * ph));
    } else {
        f32x2 w1 = twid(ph), w2 = twid(2.f * ph), w3 = twid(3.f * ph); w1.y = -w1.y; w2.y = -w2.y; w3.y = -w3.y;
        const f32x2 b1 = cmul(a1, w1), b2 = cmul(a2, w2), b3 = cmul(a3, w3);
        const f32x2 t0 = a0 + b2, t1 = a0 - b2, t2 = b1 + b3, d = b1 - b3; const f32x2 t3 = (f32x2){-d.y, d.x};
        a0 = t0 + t2; a1 = t1 + t3; a2 = t0 - t2; a3 = t1 - t3;
    }
}
template <int LOGN, int NSEQ, int LS, bool INV, bool ZHALF> __device__ __forceinline__ void fft_pass16(LAS f32x2* z, int tid_in) {
    int tid = tid_in; asm volatile("" : "+v"(tid));
    constexpr int N = 1 << LOGN, NB = NSEQ * (N / 16), IT = (NB + NTHR - 1) / NTHR, s = 1 << LS;
#pragma unroll 1
    for (int jb = 0; jb < IT; ++jb) {
        const int j = tid + jb * NTHR;
        if (NB % NTHR == 0 || j < NB) {
            const int q = j >> (LOGN - 4), jj = j & (N / 16 - 1), k = jj & (s - 1), base = ((jj >> LS) << (LS + 4)) + k;
            LAS f32x2* zq = z + q * N;
            f32x2 a[16];
#pragma unroll
            for (int m = 0; m < 16; ++m) { if (ZHALF && !INV && m >= 8) a[m] = (f32x2){0.f, 0.f}; else a[m] = zq[ZI(base + m * s)]; }
            const float phb = (float)k * (1.0f / (float)(4 * s));
            if (!INV) {
#pragma unroll
                for (int r = 0; r < 4; ++r) r4bf<false>(a[r], a[r + 4], a[r + 8], a[r + 12], (float)(k + r * s) * (1.0f / (float)(16 * s)));
#pragma unroll
                for (int p = 0; p < 4; ++p) r4bf<false>(a[4 * p], a[4 * p + 1], a[4 * p + 2], a[4 * p + 3], phb);
            } else {
#pragma unroll
                for (int p = 0; p < 4; ++p) r4bf<true>(a[4 * p], a[4 * p + 1], a[4 * p + 2], a[4 * p + 3], phb);
#pragma unroll
                for (int r = 0; r < 4; ++r) r4bf<true>(a[r], a[r + 4], a[r + 8], a[r + 12], (float)(k + r * s) * (1.0f / (float)(16 * s)));
            }
#pragma unroll
            for (int m = 0; m < 16; ++m) { if (!(ZHALF && INV && m >= 8)) zq[ZI(base + m * s)] = a[m]; }
        }
    }
    __syncthreads();
}
template <int LOGN, int NSEQ, bool INV> __device__ __forceinline__ void fft_pass4s1(LAS f32x2* z, int tid_in) {
    int tid = tid_in; asm volatile("" : "+v"(tid));
    constexpr int N = 1 << LOGN, NB = NSEQ * (N / 4), IT = NB / NTHR, BT = 4;
    static_assert(IT % BT == 0, "span-1 stage: whole batches");
#pragma unroll 1
    for (int jb = 0; jb < IT; jb += BT) {
        f32x2 a[BT][4]; int idx[BT];
#pragma unroll
        for (int b = 0; b < BT; ++b) { const int j = tid + (jb + b) * NTHR; idx[b] = (j >> (LOGN - 2)) * N + 4 * (j & (N / 4 - 1));
#pragma unroll
            for (int qq = 0; qq < 4; ++qq) a[b][qq] = z[(idx[b] & ~(N - 1)) + ZI((idx[b] & (N - 1)) + qq)]; }
#pragma unroll
        for (int b = 0; b < BT; ++b) { r4bf<INV>(a[b][0], a[b][1], a[b][2], a[b][3], 0.f);
#pragma unroll
            for (int qq = 0; qq < 4; ++qq) z[(idx[b] & ~(N - 1)) + ZI((idx[b] & (N - 1)) + qq)] = a[b][qq]; }
    }
    __syncthreads();
}
template <int LOGN, int NSEQ, bool ZPAD> __device__ __forceinline__ void fft_fwd(LAS f32x2* z, int tid) {
    static_assert(LOGN == 12 || LOGN == 14, "sizes in use");
    if constexpr (LOGN == 14) { fft_pass16<14, NSEQ, 10, false, ZPAD>(z, tid); fft_pass16<14, NSEQ, 6, false, false>(z, tid); fft_pass16<14, NSEQ, 2, false, false>(z, tid); fft_pass4s1<14, NSEQ, false>(z, tid); }
    else { fft_pass16<12, NSEQ, 8, false, ZPAD>(z, tid); fft_pass16<12, NSEQ, 4, false, false>(z, tid); fft_pass16<12, NSEQ, 0, false, false>(z, tid); }
}
template <int LOGN, int NSEQ, bool ZPAD> __device__ __forceinline__ void fft_inv(LAS f32x2* z, int tid) {
    if constexpr (LOGN == 14) { fft_pass4s1<14, NSEQ, true>(z, tid); fft_pass16<14, NSEQ, 2, true, false>(z, tid); fft_pass16<14, NSEQ, 6, true, false>(z, tid); fft_pass16<14, NSEQ, 10, true, ZPAD>(z, tid); }
    else { fft_pass16<12, NSEQ, 0, true, false>(z, tid); fft_pass16<12, NSEQ, 4, true, false>(z, tid); fft_pass16<12, NSEQ, 8, true, ZPAD>(z, tid); }
}

__device__ __forceinline__ float sin_rev(float x) { return __builtin_amdgcn_sinf(x * 0.15915494309189535f); }
__device__ __forceinline__ float cos_rev(float x) { return __builtin_amdgcn_cosf(x * 0.15915494309189535f); }
__device__ __forceinline__ void filt_f1_item(const Frame& F, const Args& a, int l, int L, int item) {
    LAS float* zf = (LAS float*)F.lds;
    LAS float* h1 = zf + 33 * 64;
    LAS float* h2 = h1 + 64 * 64;
    LAS float* w3s = h2 + 64 * 64;
    const int jc = item >> 2, ch = item & 3, j0 = jc * 64, tid = F.tid, j = tid & 63, wv = F.wave, lane = F.lane;
    const float* w1 = AIN(a, 14, F.zs) + (size_t)l * 33 * 64; const float* b1 = AIN(a, 15, F.zs) + l * 64; const float* fr1 = AIN(a, 16, F.zs) + l * 64;
    const float* w2 = AIN(a, 17, F.zs) + (size_t)l * 64 * 64; const float* b2 = AIN(a, 18, F.zs) + l * 64; const float* fr2 = AIN(a, 19, F.zs) + l * 64;
    const float* w3 = AIN(a, 20, F.zs) + (size_t)l * 64 * 1024;
    const int jj = j0 + j; const float tj = (float)jj / (float)(L - 1);
    {
        const float w = (6.283185307179586f * (float)jj) / (float)L;
#pragma unroll
        for (int q = 0; q < 2; ++q) { const int m = 2 * wv + q; const float f = 1e-4f + (float)m * ((15.0f - 1e-4f) / 15.0f); const float fw = f * w;
            zf[(1 + m) * 64 + j] = cos_rev(fw); zf[(17 + m) * 64 + j] = -sin_rev(fw); }
        if (wv == 0) zf[j] = tj;
    }
    __syncthreads();
#pragma unroll 1
    for (int q = 0; q < 8; ++q) { const int o = wv * 8 + q; float acc = b1[o];
#pragma unroll 1
        for (int i = 0; i < 33; ++i) acc += zf[i * 64 + j] * w1[i * 64 + o];
        h1[o * 64 + j] = sin_rev(fr1[o] * acc); }
    __syncthreads();
#pragma unroll 1
    for (int q = 0; q < 8; ++q) { const int o = wv * 8 + q; float acc = b2[o];
#pragma unroll 4
        for (int i = 0; i < 64; ++i) acc += h1[i * 64 + j] * w2[i * 64 + o];
        h2[o * 64 + j] = sin_rev(fr2[o] * acc); }
    __syncthreads();
    float* KT = (float*)(AWS(a, F.zs) + WS_KERNT);
    float hreg[64];
#pragma unroll
    for (int i = 0; i < 64; ++i) hreg[i] = h2[i * 64 + j];
    LAS float* ws_ = w3s + wv * (64 * 16);
#pragma unroll 1
    for (int cc = 0; cc < 2; ++cc) {
        const int col0 = ch * 256 + wv * 32 + cc * 16;
        { const GAS f32x4* src = (const GAS f32x4*)(w3 + (size_t)lane * 1024 + col0);
          const f32x4 a0 = src[0], a1 = src[1], a2 = src[2], a3 = src[3];
          LAS f32x4* dst = (LAS f32x4*)(ws_ + lane * 16); dst[0] = a0; dst[1] = a1; dst[2] = a2; dst[3] = a3; }
        LDS_WAIT(); asm volatile("" ::: "memory");
#pragma unroll 1
        for (int c4 = 0; c4 < 4; ++c4) {
            float acc[4] = {0.f, 0.f, 0.f, 0.f};
#pragma unroll
            for (int kb = 0; kb < 8; ++kb) { f32x4 wv_[8];
#pragma unroll
                for (int u = 0; u < 8; ++u) wv_[u] = *(const LAS f32x4*)(ws_ + (kb * 8 + u) * 16 + c4 * 4);
#pragma unroll
                for (int u = 0; u < 8; ++u) { const float h_ = hreg[kb * 8 + u];
                    asm("v_fmac_f32 %0, %1, %2" : "+v"(acc[0]) : "v"(wv_[u].x), "v"(h_)); asm("v_fmac_f32 %0, %1, %2" : "+v"(acc[1]) : "v"(wv_[u].y), "v"(h_));
                    asm("v_fmac_f32 %0, %1, %2" : "+v"(acc[2]) : "v"(wv_[u].z), "v"(h_)); asm("v_fmac_f32 %0, %1, %2" : "+v"(acc[3]) : "v"(wv_[u].w), "v"(h_)); }
                __builtin_amdgcn_sched_barrier(0); }
#pragma unroll
            for (int e = 0; e < 4; ++e) { const int col = col0 + c4 * 4 + e; const int c = col & 511;
                const float delta = 3.0701134573253944f + (float)c * ((15.350567286626972f - 3.0701134573253944f) / 511.0f);
                KT[(size_t)col * 8192 + jj] = acc[e] * __builtin_amdgcn_exp2f(-tj * delta * 1.4426950408889634f); }
        }
        LDS_WAIT(); asm volatile("" ::: "memory");
    }
    __syncthreads();
}
template <int LOGN> __device__ __forceinline__ void filt_f2_item(const Frame& F, const Args& a, int l, int c) {
    constexpr int N = 1 << LOGN, L = N / 2;
    LAS f32x2* z = (LAS f32x2*)F.lds; LAS float* red = (LAS float*)(F.lds + LDS_MISC + 64);
    const float* KT = (const float*)(AWS(a, F.zs) + WS_KERNT); const float* hf = KT + (size_t)c * 8192; const float* hb = KT + (size_t)(512 + c) * 8192;
    const int tid = F.tid; float asum = 0.f;
    for (int j = tid; j < L; j += NTHR) { const float f = hf[j], b = hb[j];
        if (j == 0) { z[ZI(0)] = (f32x2){f + b, 0.f}; z[ZI(L)] = (f32x2){0.f, 0.f}; asum += fabsf(f + b); }
        else { z[ZI(j)] = (f32x2){f, 0.f}; z[ZI(N - j)] = (f32x2){b, 0.f}; asum += fabsf(f) + fabsf(b); } }
    asum = wave_sum(asum); if (F.lane == 0) red[F.wave] = asum;
    __syncthreads();
    float S = 0.f;
#pragma unroll
    for (int w = 0; w < NWAVES; ++w) S += red[w];
    fft_fwd<LOGN, 1, false>(z, tid);
    const float dsk = AIN(a, 21, F.zs)[l * 512 + c]; const float rS = 1.0f / S, rN = 1.0f / (float)N;
    f32x2* KF = (f32x2*)(AWS(a, F.zs) + WS_KF) + (size_t)c * N;
    for (int i = tid; i < N; i += NTHR) { const f32x2 v = z[i]; KF[i] = (f32x2){(v.x * rS + dsk) * rN, (v.y * rS) * rN}; }
    __syncthreads();
}

struct Chunk8 { u32x4 v; unsigned short pm, pp; };
__device__ __forceinline__ Chunk8 ld_chunk(const bf16* row, int ci, int nch) {
    Chunk8 c; c.v = *(const GAS u32x4*)(row + 8 * ci);
    c.pm = (ci > 0) ? *(const GAS unsigned short*)(row + 8 * ci - 1) : (unsigned short)0;
    c.pp = (ci + 1 < nch) ? *(const GAS unsigned short*)(row + 8 * ci + 8) : (unsigned short)0;
    return c;
}
__device__ __forceinline__ void conv8(const Chunk8& c, float w0, float w1, float w2, float b, float (&o)[8]) {
    float e[10]; e[0] = bf1(c.pm); e[9] = bf1(c.pp);
    e[1] = bf_lo(c.v.x); e[2] = bf_hi(c.v.x); e[3] = bf_lo(c.v.y); e[4] = bf_hi(c.v.y); e[5] = bf_lo(c.v.z); e[6] = bf_hi(c.v.z); e[7] = bf_lo(c.v.w); e[8] = bf_hi(c.v.w);
#pragma unroll
    for (int i = 0; i < 8; ++i) o[i] = w0 * e[i] + w1 * e[i + 1] + w2 * e[i + 2] + b;
}
template <int LOGN, int NSEQ> __device__ __forceinline__ void hyena_unit(const Frame& F, const Args& a, int l, int c, int p0) {
    constexpr int N = 1 << LOGN, L = N / 2, LOGCH = LOGN - 4, NCH = 1 << LOGCH, CPT = (NSEQ * NCH) / NTHR;
    static_assert(CPT * NTHR == NSEQ * NCH, "chunks divide evenly");
    LAS f32x2* z = (LAS f32x2*)F.lds; const int tid = F.tid;
    const bf16* VHT = (const bf16*)(AWS(a, F.zs) + WS_VHT);
    const float* cw = AIN(a, 12, F.zs) + (size_t)l * 3 * 1536; const float* cb = AIN(a, 13, F.zs) + l * 1536;
    const bf16* x0r = VHT + (size_t)(512 + c) * TOK + (size_t)(2 * p0) * L;
    const bf16* x1r = VHT + (size_t)(1024 + c) * TOK + (size_t)(2 * p0) * L;
    const bf16* vhr = VHT + (size_t)(1536 + c) * TOK + (size_t)(2 * p0) * L;
    const float a0 = cw[c], a1 = cw[1536 + c], a2 = cw[3072 + c], ab = cb[c];
    const float b0 = cw[512 + c], b1 = cw[1536 + 512 + c], b2 = cw[3072 + 512 + c], bb = cb[512 + c];
    const float c0 = cw[1024 + c], c1 = cw[1536 + 1024 + c], c2 = cw[3072 + 1024 + c], cbb = cb[1024 + c];
    constexpr int KPT = (N / 2) / NTHR; f32x4 kreg[KPT];
    {
        Chunk8 q1a[CPT], qva[CPT], q1b[CPT], qvb[CPT];
#pragma unroll
        for (int i = 0; i < CPT; ++i) { const int cg = tid + NTHR * i, q = cg >> LOGCH, ci = cg & (NCH - 1); const size_t ro = (size_t)(2 * q) * L;
            q1a[i] = ld_chunk(x1r + ro, ci, NCH); qva[i] = ld_chunk(vhr + ro, ci, NCH); q1b[i] = ld_chunk(x1r + ro + L, ci, NCH); qvb[i] = ld_chunk(vhr + ro + L, ci, NCH); }
#pragma unroll
        for (int i = 0; i < CPT; ++i) { const int cg = tid + NTHR * i, q = cg >> LOGCH, ci = cg & (NCH - 1);
            float xa[8], va[8], xb[8], vb[8]; conv8(q1a[i], b0, b1, b2, bb, xa); conv8(qva[i], c0, c1, c2, cbb, va); conv8(q1b[i], b0, b1, b2, bb, xb); conv8(qvb[i], c0, c1, c2, cbb, vb);
            const bool swp = (ci >> 1) & 1;
#pragma unroll
            for (int j = 0; j < 4; ++j) { const f32x2 e0 = (f32x2){xa[2 * j] * va[2 * j], xb[2 * j] * vb[2 * j]}, e1 = (f32x2){xa[2 * j + 1] * va[2 * j + 1], xb[2 * j + 1] * vb[2 * j + 1]};
                *(LAS f32x4*)(z + q * N + (ZI(8 * ci + 2 * j) & ~1)) = swp ? (f32x4){e1.x, e1.y, e0.x, e0.y} : (f32x4){e0.x, e0.y, e1.x, e1.y}; } }
    }
    __syncthreads();
#define HY_LOADK() do { const f32x2* KF = (const f32x2*)(AWS(a, F.zs) + WS_KF) + (size_t)c * N; \
        _Pragma("unroll") for (int ii = 0; ii < KPT; ++ii) kreg[ii] = *(const GAS f32x4*)(KF + 2 * (tid + NTHR * ii)); } while (0)
    if constexpr (LOGN == 14) { fft_pass16<14, NSEQ, 10, false, true>(z, tid); fft_pass16<14, NSEQ, 6, false, false>(z, tid); fft_pass16<14, NSEQ, 2, false, false>(z, tid); HY_LOADK(); fft_pass4s1<14, NSEQ, false>(z, tid); }
    else { fft_pass16<12, NSEQ, 8, false, true>(z, tid); fft_pass16<12, NSEQ, 4, false, false>(z, tid); HY_LOADK(); fft_pass16<12, NSEQ, 0, false, false>(z, tid); }
#undef HY_LOADK
#pragma unroll
    for (int ii = 0; ii < KPT; ++ii) { const int i = tid + NTHR * ii; const f32x4 k = kreg[ii];
#pragma unroll
        for (int q = 0; q < NSEQ; ++q) { const f32x4 v = *(LAS f32x4*)(z + q * N + 2 * i);
            *(LAS f32x4*)(z + q * N + 2 * i) = (f32x4){v.x * k.x - v.y * k.y, v.x * k.y + v.y * k.x, v.z * k.z - v.w * k.w, v.z * k.w + v.w * k.z}; } }
    __syncthreads();
    Chunk8 q0a[CPT], q0b[CPT];
#define HY_LOADX0() do { _Pragma("unroll") for (int i = 0; i < CPT; ++i) { const int cg = tid + NTHR * i, q = cg >> LOGCH, ci = cg & (NCH - 1); const size_t ro = (size_t)(2 * q) * L; \
        q0a[i] = ld_chunk(x0r + ro, ci, NCH); q0b[i] = ld_chunk(x0r + ro + L, ci, NCH); } } while (0)
    if constexpr (LOGN == 14) { fft_pass4s1<14, NSEQ, true>(z, tid); fft_pass16<14, NSEQ, 2, true, false>(z, tid); fft_pass16<14, NSEQ, 6, true, false>(z, tid); HY_LOADX0(); fft_pass16<14, NSEQ, 10, true, true>(z, tid); }
    else { fft_pass16<12, NSEQ, 0, true, false>(z, tid); fft_pass16<12, NSEQ, 4, true, false>(z, tid); HY_LOADX0(); fft_pass16<12, NSEQ, 8, true, true>(z, tid); }
#undef HY_LOADX0
    bf16* YT = (bf16*)(AWS(a, F.zs) + WS_YT) + (size_t)c * TOK + (size_t)(2 * p0) * L;
    {
#pragma unroll
        for (int i = 0; i < CPT; ++i) { const int cg = tid + NTHR * i, q = cg >> LOGCH, ci = cg & (NCH - 1); const size_t ro = (size_t)(2 * q) * L;
            float ga[8], gb[8]; conv8(q0a[i], a0, a1, a2, ab, ga); conv8(q0b[i], a0, a1, a2, ab, gb);
            float ya[8], yb[8];
            const bool swp = (ci >> 1) & 1;
#pragma unroll
            for (int j = 0; j < 4; ++j) { f32x4 v = *(LAS f32x4*)(z + q * N + (ZI(8 * ci + 2 * j) & ~1)); if (swp) v = (f32x4){v.z, v.w, v.x, v.y};
                ya[2 * j] = v.x * ga[2 * j]; yb[2 * j] = v.y * gb[2 * j]; ya[2 * j + 1] = v.z * ga[2 * j + 1]; yb[2 * j + 1] = v.w * gb[2 * j + 1]; }
            *(GAS u32x4*)(YT + ro + 8 * ci) = (u32x4){pkbf(ya[0], ya[1]), pkbf(ya[2], ya[3]), pkbf(ya[4], ya[5]), pkbf(ya[6], ya[7])};
            *(GAS u32x4*)(YT + ro + L + 8 * ci) = (u32x4){pkbf(yb[0], yb[1]), pkbf(yb[2], yb[3]), pkbf(yb[4], yb[5]), pkbf(yb[6], yb[7])}; }
    }
    __syncthreads();
}
__device__ __forceinline__ void ytrans_tile(const Frame& F, const Args& a, int tile) {
    LAS bf16* sm = (LAS bf16*)F.lds;
    const int cb = tile & 7, tb = tile >> 3, tid = F.tid;
    const bf16* YT = (const bf16*)(AWS(a, F.zs) + WS_YT); bf16* MIX = (bf16*)(AWS(a, F.zs) + WS_MIX);
    { const int c = tid >> 3, ch = tid & 7; const u32x4 v = *(const GAS u32x4*)(YT + (size_t)(cb * 64 + c) * TOK + (size_t)tb * 64 + ch * 8);
      *(LAS u32x4*)(sm + c * 72 + ch * 8) = v; }
    __syncthreads();
    { const int t = tid >> 3, cc = tid & 7; unsigned w[4];
#pragma unroll
      for (int q = 0; q < 4; ++q) { const unsigned lo = sm[(cc * 8 + 2 * q) * 72 + t], hi = sm[(cc * 8 + 2 * q + 1) * 72 + t]; w[q] = lo | (hi << 16); }
      *(GAS u32x4*)(MIX + (size_t)(tb * 64 + t) * 1024 + 512 + cb * 64 + cc * 8) = (u32x4){w[0], w[1], w[2], w[3]}; }
    __syncthreads();
}
__device__ __forceinline__ int crow(int r, int hi) { return (r & 3) + 8 * (r >> 2) + 4 * hi; }
template <bool DIFF> struct AttnCfg {
    static constexpr int DQK = DIFF ? 64 : 256, KW = DIFF ? 128 : 256, VR = DIFF ? 128 : 256;
    static constexpr int KROWB = KW * 2 + 16, VROWB = 136, KBYTES = 64 * KROWB, VBYTES = VR * VROWB, STAGE = KBYTES + VBYTES;
    static constexpr int NKP = 64 * (KW / 8) / NTHR, NVP = VR * 8 / NTHR, NKS = DQK / 16;
};
struct AttnPtrs {
    const bf16* Q; int ldq;
    const bf16* K; int ldk;
    const bf16* VT; size_t ldv;
    int nkeys;
    bf16* O; int ldo;
};
template <bool DIFF> __device__ __forceinline__ void attn_unit(const Frame& F, const AttnPtrs& P, float lam, float outscale, const float* subg) {
    typedef AttnCfg<DIFF> C;
    const int tid = F.tid, lane = F.lane, wid = F.wave, r32 = lane & 31, hi = lane >> 5, qsub = wid >> 1, role = wid & 1;
    LAS unsigned char* lds = F.lds;
#ifndef XQ_REGS
#define XQ_REGS 0
#endif
    constexpr bool QREG = DIFF || XQ_REGS;
    bf16x8 qf[QREG ? C::NKS : 1];
    const bf16* qp = P.Q + (size_t)(qsub * 32 + r32) * P.ldq + (DIFF ? role * 64 : 0) + hi * 8;
    if constexpr (QREG) {
#pragma unroll
      for (int ks = 0; ks < C::NKS; ++ks) qf[ks] = *(const GAS bf16x8*)(qp + ks * 16); }
    u32x4 kst[C::NKP];
    const int NT = P.nkeys / 64;
#define ATT_LOADK(t) do { \
        _Pragma("unroll") for (int i = 0; i < C::NKP; ++i) { const int p = tid + NTHR * i, key = p / (C::KW / 8), ch = p % (C::KW / 8); \
            kst[i] = *(const GAS u32x4*)(P.K + (size_t)((t) * 64 + key) * P.ldk + ch * 8); } } while (0)
#define ATT_LOADV(t) do { \
        _Pragma("unroll") for (int i = 0; i < C::NVP; ++i) { const int p = tid + NTHR * i, row = p >> 3, ch = p & 7; \
            kst[i] = *(const GAS u32x4*)(P.VT + (size_t)row * P.ldv + (size_t)(t) * 64 + ch * 8); } } while (0)
#define ATT_STOREK(buf) do { LAS unsigned char* kb_ = lds + (buf) * C::STAGE; \
        _Pragma("unroll") for (int i = 0; i < C::NKP; ++i) { const int p = tid + NTHR * i, key = p / (C::KW / 8), ch = p % (C::KW / 8); \
            *(LAS u32x4*)(kb_ + key * C::KROWB + ch * 16) = kst[i]; } } while (0)
#define ATT_STOREV(buf) do { LAS unsigned char* vb_ = lds + (buf) * C::STAGE + C::KBYTES; \
        _Pragma("unroll") for (int i = 0; i < C::NVP; ++i) { const int p = tid + NTHR * i, row = p >> 3, ch = p & 7; \
            *(LAS u32x2*)(vb_ + row * C::VROWB + ch * 16) = (u32x2){kst[i].x, kst[i].y}; *(LAS u32x2*)(vb_ + row * C::VROWB + ch * 16 + 8) = (u32x2){kst[i].z, kst[i].w}; } } while (0)
    static_assert(C::NKP == C::NVP, "one staging register set serves K then V");
    ATT_LOADK(0); ATT_STOREK(0); ATT_LOADV(0); ATT_STOREV(0);
    __syncthreads();
    f32x16 o[4];
#pragma unroll
    for (int d = 0; d < 4; ++d) o[d] = (f32x16){0.f, 0.f, 0.f, 0.f, 0.f, 0.f, 0.f, 0.f, 0.f, 0.f, 0.f, 0.f, 0.f, 0.f, 0.f, 0.f};
    float mrun = -INFINITY, lrun = 0.f;
    const int koff = (DIFF ? role * 64 : 0) * 2 + hi * 16, vroff = (DIFF ? 0 : role * 128);
#pragma unroll 1
    for (int t = 0; t < NT; ++t) {
        if (t + 1 < NT) ATT_LOADK(t + 1);
        const LAS unsigned char* kb = lds + (t & 1) * C::STAGE; const LAS unsigned char* vb = kb + C::KBYTES;
        f32x16 s0 = (f32x16){0.f, 0.f, 0.f, 0.f, 0.f, 0.f, 0.f, 0.f, 0.f, 0.f, 0.f, 0.f, 0.f, 0.f, 0.f, 0.f}, s1 = s0;
        int zo = 0; if constexpr (!QREG) asm volatile("" : "+v"(zo));
#pragma unroll
        for (int ks = 0; ks < C::NKS; ++ks) {
            const bf16x8 a0 = *(const LAS bf16x8*)(kb + r32 * C::KROWB + koff + ks * 32);
            const bf16x8 a1 = *(const LAS bf16x8*)(kb + (32 + r32) * C::KROWB + koff + ks * 32);
            bf16x8 qv; if constexpr (QREG) qv = qf[ks]; else qv = *(const GAS bf16x8*)(qp + ks * 16 + zo);
            s0 = __builtin_amdgcn_mfma_f32_32x32x16_bf16(a0, qv, s0, 0, 0, 0);
            s1 = __builtin_amdgcn_mfma_f32_32x32x16_bf16(a1, qv, s1, 0, 0, 0);
        }
        if (t + 1 < NT) { ATT_STOREK((t + 1) & 1); ATT_LOADV(t + 1); }
        float mx = fmaxf(s0[0], s1[0]);
#pragma unroll
        for (int r = 1; r < 16; ++r) mx = fmaxf(mx, fmaxf(s0[r], s1[r]));
        mx = fmaxf(mx, __shfl_xor(mx, 32));
        const float mnew = fmaxf(mrun, mx), alpha = __builtin_amdgcn_exp2f(mrun - mnew); mrun = mnew;
        float rs = 0.f;
#pragma unroll
        for (int r = 0; r < 16; ++r) { s0[r] = __builtin_amdgcn_exp2f(s0[r] - mnew); s1[r] = __builtin_amdgcn_exp2f(s1[r] - mnew); rs += s0[r] + s1[r]; }
        lrun = lrun * alpha + rs;
#pragma unroll
        for (int d = 0; d < 4; ++d)
#pragma unroll
            for (int r = 0; r < 16; ++r) o[d][r] *= alpha;
        bf16x8 pf[2][2];
#pragma unroll
        for (int s = 0; s < 2; ++s) {
            u32x4 w0, w1;
            w0.x = pkbf(s0[8 * s + 0], s0[8 * s + 1]); w0.y = pkbf(s0[8 * s + 2], s0[8 * s + 3]); w0.z = pkbf(s0[8 * s + 4], s0[8 * s + 5]); w0.w = pkbf(s0[8 * s + 6], s0[8 * s + 7]);
            w1.x = pkbf(s1[8 * s + 0], s1[8 * s + 1]); w1.y = pkbf(s1[8 * s + 2], s1[8 * s + 3]); w1.z = pkbf(s1[8 * s + 4], s1[8 * s + 5]); w1.w = pkbf(s1[8 * s + 6], s1[8 * s + 7]);
            pf[0][s] = __builtin_bit_cast(bf16x8, w0); pf[1][s] = __builtin_bit_cast(bf16x8, w1);
        }
#pragma unroll
        for (int d = 0; d < 4; ++d)
#pragma unroll
            for (int kt = 0; kt < 2; ++kt)
#pragma unroll
                for (int s = 0; s < 2; ++s) {
                    const LAS unsigned char* vp = vb + (vroff + 32 * d + r32) * C::VROWB + (32 * kt + 16 * s + 4 * hi) * 2;
                    const s16x4 lo = *(const LAS s16x4*)(vp), hh = *(const LAS s16x4*)(vp + 16);
                    const bf16x8 vf = (bf16x8){lo[0], lo[1], lo[2], lo[3], hh[0], hh[1], hh[2], hh[3]};
                    o[d] = __builtin_amdgcn_mfma_f32_32x32x16_bf16(vf, pf[kt][s], o[d], 0, 0, 0);
                }
        if (t + 1 < NT) ATT_STOREV((t + 1) & 1);
        __syncthreads();
    }
#undef ATT_LOADK
#undef ATT_LOADV
#undef ATT_STOREK
#undef ATT_STOREV
    const float linv = 1.0f / (lrun + __shfl_xor(lrun, 32));
#pragma unroll
    for (int d = 0; d < 4; ++d)
#pragma unroll
        for (int r = 0; r < 16; ++r) o[d][r] *= linv;
    if constexpr (DIFF) {
        LAS float* ex = (LAS float*)lds + (size_t)qsub * 64 * 64 + lane;
        if (role == 1) {
#pragma unroll
            for (int d = 0; d < 4; ++d)
#pragma unroll
                for (int r = 0; r < 16; ++r) ex[(d * 16 + r) * 64] = o[d][r];
        }
        __syncthreads();
        if (role == 0) {
            float ss = 0.f;
#pragma unroll
            for (int d = 0; d < 4; ++d)
#pragma unroll
                for (int r = 0; r < 16; ++r) { const float v = o[d][r] - lam * ex[(d * 16 + r) * 64]; o[d][r] = v; ss += v * v; }
            ss += __shfl_xor(ss, 32);
            const float rstd = outscale / sqrtf(ss * (1.f / 128.f) + EPS);
            bf16* op = P.O + (size_t)(qsub * 32 + r32) * P.ldo;
#pragma unroll
            for (int d = 0; d < 4; ++d)
#pragma unroll
                for (int rg = 0; rg < 4; ++rg) { const int dd = 32 * d + 8 * rg + 4 * hi; const f32x4 g = *(const f32x4*)(subg + dd);
                    u32x2 w; w.x = pkbf(o[d][4 * rg + 0] * rstd * g.x, o[d][4 * rg + 1] * rstd * g.y); w.y = pkbf(o[d][4 * rg + 2] * rstd * g.z, o[d][4 * rg + 3] * rstd * g.w);
                    *(GAS u32x2*)(op + dd) = w; }
        }
        __syncthreads();
    } else {
        bf16* op = P.O + (size_t)(qsub * 32 + r32) * P.ldo + role * 128;
#pragma unroll
        for (int d = 0; d < 4; ++d)
#pragma unroll
            for (int rg = 0; rg < 4; ++rg) { const int dd = 32 * d + 8 * rg + 4 * hi;
                u32x2 w; w.x = pkbf(o[d][4 * rg + 0], o[d][4 * rg + 1]); w.y = pkbf(o[d][4 * rg + 2], o[d][4 * rg + 3]);
                *(GAS u32x2*)(op + dd) = w; }
    }
}
template <bool DIFF> struct PA {
    static constexpr int TK = DIFF ? 64 : 32, NKT = TK / 32, NKS = DIFF ? 4 : 16, KW = DIFF ? 128 : 256, VR = DIFF ? 128 : 256;
    static constexpr int KROWB = KW * 2 + 16, VROWB = TK * 2 + 16, KB = TK * KROWB, VB = VR * VROWB, VOFF = 2 * KB, LDSB = 2 * KB + 3 * VB;
    static constexpr int KCH = KW / 8, VCH = TK / 8;
    static constexpr int NQK = NKS * NKT, NPV = 4 * NKT * 2, EPG = (16 * NKT) / NQK;
    static_assert(TK * KCH == 2 * NTHR && VR * VCH == 2 * NTHR, "two staging pieces per thread for K and for V");
};
#ifndef DTHR_VAL
#define DTHR_VAL 8.0f
#endif
constexpr float DTHR = DTHR_VAL;
__device__ __forceinline__ float half_swap_max(float m) {
    auto rr = __builtin_amdgcn_permlane32_swap(__float_as_uint(m), __float_as_uint(m), false, false);
    return fmaxf(__uint_as_float(rr[0]), __uint_as_float(rr[1]));
}
__device__ __forceinline__ float half_swap_sum(float m) {
    auto rr = __builtin_amdgcn_permlane32_swap(__float_as_uint(m), __float_as_uint(m), false, false);
    return __uint_as_float(rr[0]) + __uint_as_float(rr[1]);
}
__device__ __forceinline__ float max16(const f32x16& a) {
    float x = fmaxf(fmaxf(a[0], a[1]), a[2]), y = fmaxf(fmaxf(a[3], a[4]), a[5]);
    x = fmaxf(fmaxf(x, a[6]), a[7]); y = fmaxf(fmaxf(y, a[8]), a[9]); x = fmaxf(fmaxf(x, a[10]), a[11]); y = fmaxf(fmaxf(y, a[12]), a[13]); x = fmaxf(fmaxf(x, a[14]), a[15]);
    return fmaxf(x, y);
}
template <bool DIFF> __device__ __forceinline__ void pipe_attn_unit(const Frame& F, const AttnPtrs& P, float lam, float outscale, const float* subg) {
    typedef PA<DIFF> C;
    const int tid = F.tid, lane = F.lane, wid = F.wave, r32 = lane & 31, hi = lane >> 5, qsub = wid >> 1, role = wid & 1;
    LAS unsigned char* lds = F.lds;
    bf16x8 qf[C::NKS];
    { const bf16* qp = P.Q + (size_t)(qsub * 32 + r32) * P.ldq + (DIFF ? role * 64 : 0) + hi * 8;
#pragma unroll
      for (int ks = 0; ks < C::NKS; ++ks) qf[ks] = *(const GAS bf16x8*)(qp + ks * 16); }
    u32x4 kst[2], vst[2];
    const int NT = P.nkeys / C::TK;
    const int kkey0 = tid / C::KCH, kch = tid % C::KCH, vrow0 = tid / C::VCH, vch = tid % C::VCH;
    const bf16* kg = P.K + (size_t)kkey0 * P.ldk + kch * 8; const bf16* vg = P.VT + (size_t)vrow0 * P.ldv + vch * 8;
    const int kl = kkey0 * C::KROWB + kch * 16, vl = vrow0 * C::VROWB + (vch >> 1) * 32 + (vch & 1) * 8;
#define DA_LOADK(t) do { kst[0] = *(const GAS u32x4*)(kg + (size_t)(t) * C::TK * P.ldk); kst[1] = *(const GAS u32x4*)(kg + (size_t)((t) * C::TK + C::TK / 2) * P.ldk); } while (0)
#define DA_LOADV(t) do { vst[0] = *(const GAS u32x4*)(vg + (size_t)(t) * C::TK); vst[1] = *(const GAS u32x4*)(vg + (size_t)(C::VR / 2) * P.ldv + (size_t)(t) * C::TK); } while (0)
#define DA_STOREK(b) do { *(LAS u32x4*)(lds + (b) * C::KB + kl) = kst[0]; *(LAS u32x4*)(lds + (b) * C::KB + kl + (C::TK / 2) * C::KROWB) = kst[1]; } while (0)
#define DA_STOREV(off) do { LAS unsigned char* v_ = lds + (off) + vl; *(LAS u32x2*)(v_) = (u32x2){vst[0].x, vst[0].y}; *(LAS u32x2*)(v_ + 16) = (u32x2){vst[0].z, vst[0].w}; \
        *(LAS u32x2*)(v_ + (C::VR / 2) * C::VROWB) = (u32x2){vst[1].x, vst[1].y}; *(LAS u32x2*)(v_ + (C::VR / 2) * C::VROWB + 16) = (u32x2){vst[1].z, vst[1].w}; } while (0)
    const int koff = (DIFF ? role * 128 : 0) + hi * 16, vroff = DIFF ? 0 : role * 128;
    const f32x16 Z16 = (f32x16){0.f, 0.f, 0.f, 0.f, 0.f, 0.f, 0.f, 0.f, 0.f, 0.f, 0.f, 0.f, 0.f, 0.f, 0.f, 0.f};
    f32x16 o[4]; o[0] = Z16; o[1] = Z16; o[2] = Z16; o[3] = Z16;
    f32x16 A[C::NKT], B[C::NKT];
    float mref, lrun = 0.f;
#define DA_PIN(x) asm volatile("" : "+v"(x))
#define DA_SB() __builtin_amdgcn_sched_barrier(0)
#define DA_KFR(i) (*(const LAS bf16x8*)(kb_ + ((i) % C::NKT) * 32 * C::KROWB + ((i) / C::NKT) * 32))
#define DA_VOFS(i) ((32 * ((i) / (2 * C::NKT))) * C::VROWB + (32 * (((i) >> 1) % C::NKT) + 16 * ((i) & 1)) * 2)
#define DA_VFR(i) (*(const LAS bf16x8*)(vb_ + DA_VOFS(i)))
#define DA_PV(i) do { \
        o[(i) / (2 * C::NKT)] = __builtin_amdgcn_mfma_f32_32x32x16_bf16(vfr_[(i) % 3], __builtin_bit_cast(bf16x8, pw_[(((i) >> 1) % C::NKT) * 2 + ((i) & 1)]), o[(i) / (2 * C::NKT)], 0, 0, 0); } while (0)
#define DA_QK0(S, b) do { const LAS unsigned char* kb_ = lds + (b) * C::KB + r32 * C::KROWB + koff; \
        _Pragma("unroll") for (int i = 0; i < C::NQK; ++i) { const bf16x8 a_ = DA_KFR(i); \
            if (i < C::NKT) S[i % C::NKT] = __builtin_amdgcn_mfma_f32_32x32x16_bf16(a_, qf[i / C::NKT], Z16, 0, 0, 0); else S[i % C::NKT] = __builtin_amdgcn_mfma_f32_32x32x16_bf16(a_, qf[i / C::NKT], S[i % C::NKT], 0, 0, 0); } } while (0)
    DA_LOADK(0); DA_STOREK(0); DA_LOADV(0); DA_STOREV(C::VOFF);
    DA_LOADK(1);
    __syncthreads();
    DA_QK0(A, 0);
    DA_STOREK(1); DA_LOADV(1);
    { float mx = max16(A[0]); if (C::NKT == 2) mx = fmaxf(mx, max16(A[C::NKT - 1])); mref = half_swap_max(mx); }
#pragma unroll
    for (int kt = 0; kt < C::NKT; ++kt)
#pragma unroll
        for (int r = 0; r < 16; ++r) A[kt][r] = __builtin_amdgcn_exp2f(A[kt][r] - mref);
    DA_STOREV(C::VOFF + C::VB);
    DA_LOADK(2); DA_LOADV(2);
    __syncthreads();
    int vprev = 0, vcur = C::VB, vnext = 2 * C::VB;
#define DA_STEP(S, Pv, t, KBUF, PF, PF2) do { \
        if (PF) DA_STOREK(1 - (KBUF)); if (PF2) DA_LOADK((t) + 2); \
        const LAS unsigned char* kb_ = lds + (KBUF) * C::KB + r32 * C::KROWB + koff; \
        bf16x8 kf_[3]; kf_[0] = DA_KFR(0); kf_[1] = DA_KFR(1); \
        u32x4 pw_[2 * C::NKT]; float rs_ = 0.f; \
        DA_SB(); \
        _Pragma("unroll") for (int i = 0; i < C::NQK; ++i) { \
            if (i + 2 < C::NQK) kf_[(i + 2) % 3] = DA_KFR(i + 2); \
            if (i < C::NKT) S[i % C::NKT] = __builtin_amdgcn_mfma_f32_32x32x16_bf16(kf_[i % 3], qf[i / C::NKT], Z16, 0, 0, 0); \
            else S[i % C::NKT] = __builtin_amdgcn_mfma_f32_32x32x16_bf16(kf_[i % 3], qf[i / C::NKT], S[i % C::NKT], 0, 0, 0); \
              \
            _Pragma("unroll") for (int e = i * C::EPG; e < (i + 1) * C::EPG; ++e) { rs_ += Pv[e >> 4][e & 15]; \
                if (e & 1) { const int kt_ = e >> 4, r_ = e & 15; pw_[kt_ * 2 + (r_ >> 3)][(r_ & 7) >> 1] = pkbf(Pv[kt_][r_ - 1], Pv[kt_][r_]); } } \
            DA_PIN(rs_); if (((i + 1) * C::EPG) % 8 == 0 || C::EPG >= 2) DA_PIN(pw_[(((i + 1) * C::EPG - 1) >> 4) * 2 + ((((i + 1) * C::EPG - 1) & 15) >> 3)]); \
            DA_SB(); } \
        lrun += rs_; \
        if (PF) DA_STOREV(C::VOFF + vnext); if (PF2) DA_LOADV((t) + 2); \
        float mx_ = max16(S[0]); if (C::NKT == 2) mx_ = fmaxf(mx_, max16(S[C::NKT - 1])); mx_ = half_swap_max(mx_); \
        float dl_ = 0.f; bool resc_ = false; \
        if (__builtin_expect(__any(mx_ > mref + DTHR), 0)) { dl_ = fmaxf(mx_ - mref, 0.f); mref += dl_; resc_ = true; } \
        const LAS unsigned char* vb_ = lds + C::VOFF + vprev + (vroff + r32) * C::VROWB + hi * 16; \
        bf16x8 vfr_[3]; vfr_[0] = DA_VFR(0); vfr_[1] = DA_VFR(1); \
        DA_SB(); \
        _Pragma("unroll") for (int i = 0; i < C::NPV; ++i) { \
            if (i + 2 < C::NPV) vfr_[(i + 2) % 3] = DA_VFR(i + 2); \
            DA_PV(i); \
            { const int e0_ = 2 * i, e1_ = 2 * i + 1; S[e0_ >> 4][e0_ & 15] = __builtin_amdgcn_exp2f(S[e0_ >> 4][e0_ & 15] - mref); S[e1_ >> 4][e1_ & 15] = __builtin_amdgcn_exp2f(S[e1_ >> 4][e1_ & 15] - mref); } \
            DA_PIN(S[(2 * i) >> 4]); DA_SB(); } \
        if (resc_) { const float f_ = __builtin_amdgcn_exp2f(-dl_); lrun *= f_; \
            _Pragma("unroll") for (int d = 0; d < 4; ++d) _Pragma("unroll") for (int r = 0; r < 16; ++r) o[d][r] *= f_; } \
        __syncthreads(); \
        { const int tmp_ = vprev; vprev = vcur; vcur = vnext; vnext = tmp_; } \
    } while (0)
#pragma unroll 1
    for (int t = 1; t < NT - 3; t += 2) {
        DA_STEP(B, A, t, 1, true, true);
        DA_STEP(A, B, t + 1, 0, true, true);
    }
    DA_STEP(B, A, NT - 3, 1, true, true);
    DA_STEP(A, B, NT - 2, 0, true, false);
    DA_STEP(B, A, NT - 1, 1, false, false);
    {
        float rs_ = 0.f; u32x4 pw_[2 * C::NKT];
#pragma unroll
        for (int kt = 0; kt < C::NKT; ++kt) {
#pragma unroll
            for (int r = 0; r < 16; ++r) rs_ += B[kt][r];
#pragma unroll
            for (int s = 0; s < 2; ++s) { pw_[kt * 2 + s].x = pkbf(B[kt][8 * s + 0], B[kt][8 * s + 1]); pw_[kt * 2 + s].y = pkbf(B[kt][8 * s + 2], B[kt][8 * s + 3]); pw_[kt * 2 + s].z = pkbf(B[kt][8 * s + 4], B[kt][8 * s + 5]); pw_[kt * 2 + s].w = pkbf(B[kt][8 * s + 6], B[kt][8 * s + 7]); } }
        lrun += rs_;
        const LAS unsigned char* vb_ = lds + C::VOFF + vprev + (vroff + r32) * C::VROWB + hi * 16;
#pragma unroll
        for (int i = 0; i < C::NPV; ++i) { const bf16x8 vf_ = DA_VFR(i);
            o[i / (2 * C::NKT)] = __builtin_amdgcn_mfma_f32_32x32x16_bf16(vf_, __builtin_bit_cast(bf16x8, pw_[((i >> 1) % C::NKT) * 2 + (i & 1)]), o[i / (2 * C::NKT)], 0, 0, 0); }
    }
#undef DA_STEP
#undef DA_QK0
#undef DA_PIN
#undef DA_SB
#undef DA_KFR
#undef DA_VOFS
#undef DA_VFR
#undef DA_PV
#undef DA_LOADK
#undef DA_LOADV
#undef DA_STOREK
#undef DA_STOREV
    const float linv = 1.0f / half_swap_sum(lrun);
#pragma unroll
    for (int d = 0; d < 4; ++d)
#pragma unroll
        for (int r = 0; r < 16; ++r) o[d][r] *= linv;
    __syncthreads();
    if constexpr (DIFF) {
        LAS float* ex = (LAS float*)lds + (size_t)qsub * 64 * 64 + lane;
        if (role == 1) {
#pragma unroll
            for (int d = 0; d < 4; ++d)
#pragma unroll
                for (int r = 0; r < 16; ++r) ex[(d * 16 + r) * 64] = o[d][r];
        }
        __syncthreads();
        if (role == 0) {
            float ss = 0.f;
#pragma unroll
            for (int d = 0; d < 4; ++d)
#pragma unroll
                for (int r = 0; r < 16; ++r) { const float v = o[d][r] - lam * ex[(d * 16 + r) * 64]; o[d][r] = v; ss += v * v; }
            ss = half_swap_sum(ss);
            const float rstd = outscale / sqrtf(ss * (1.f / 128.f) + EPS);
            bf16* op = P.O + (size_t)(qsub * 32 + r32) * P.ldo;
#pragma unroll
            for (int d = 0; d < 4; ++d)
#pragma unroll
                for (int rg = 0; rg < 4; ++rg) { const int dd = 32 * d + 8 * rg + 4 * hi; const f32x4 g = *(const f32x4*)(subg + dd);
                    u32x2 w; w.x = pkbf(o[d][4 * rg + 0] * rstd * g.x, o[d][4 * rg + 1] * rstd * g.y); w.y = pkbf(o[d][4 * rg + 2] * rstd * g.z, o[d][4 * rg + 3] * rstd * g.w);
                    *(GAS u32x2*)(op + dd) = w; }
        }
        __syncthreads();
    } else {
        bf16* op = P.O + (size_t)(qsub * 32 + r32) * P.ldo + role * 128;
#pragma unroll
        for (int d = 0; d < 4; ++d)
#pragma unroll
            for (int rg = 0; rg < 4; ++rg) { const int dd = 32 * d + 8 * rg + 4 * hi;
                u32x2 w; w.x = pkbf(o[d][4 * rg + 0], o[d][4 * rg + 1]); w.y = pkbf(o[d][4 * rg + 2], o[d][4 * rg + 3]);
                *(GAS u32x2*)(op + dd) = w; }
    }
}
#ifndef MK_PER_STEP
#define MK_PER_STEP 0
#endif
#ifndef PH_MASK
#define PH_MASK 0x1fff
#endif
#ifndef DUP_MASK
#define DUP_MASK 0
#endif
#define REPS(k) ((((DUP_MASK) >> (k)) & 1) ? 2 : 1)
#ifndef SITE_MASK
#define SITE_MASK 7
#endif
#define PFRAME() Frame P = F; { int t_ = F.tid; asm volatile("" : "+v"(t_)); P.tid = t_; P.lane = t_ & 63; P.wave = __builtin_amdgcn_readfirstlane(t_ >> 6); int z_ = 0; asm volatile("" : "+s"(z_)); P.zs = z_; } \
    const int gw = P.vcu * NWAVES + P.wave, NGW = P.G * NWAVES; (void)gw; (void)NGW; unsigned char* const ws = AWS(args, P.zs); (void)ws
#define WSP(off) ((bf16*)(ws + (off)))
#define P_WL()  (WSP(WS_W) + (size_t)l * WL_STRIDE)
#define P_HN()  WSP(WS_HN)
#define P_QK()  WSP(WS_QK)
#define P_VHT() WSP(WS_VHT)
#define P_MIX() WSP(WS_MIX)
#define P_MO()  WSP(WS_QK)
#define P_XO()  WSP(WS_QK)
#define P_HID() WSP(WS_QK)
#define P_QX()  WSP(WS_VHT)
#define P_OX()  (WSP(WS_VHT) + (size_t)TOK * 1024)
#define P_FO()  WSP(WS_MIX)
#define P_MN()  WSP(WS_MN)
#define P_KX()  WSP(WS_KX)
#define P_VXT() WSP(WS_VXT)
#define P_XRES() (AOUT(args, P.zs) + (size_t)g * TOK * DM)
#define P_RS() ((float*)(ws + WS_RS))

__global__ void __launch_bounds__(NTHR, 2) hymba_fwd(Args args) {
    extern __shared__ __attribute__((aligned(16))) unsigned char lds_raw[];
    Frame F;
    F.lds = (LAS unsigned char*)lds_raw;
    F.tid = threadIdx.x; F.lane = F.tid & 63; F.wave = __builtin_amdgcn_readfirstlane(F.tid >> 6); F.zs = 0;
    F.G = gridDim.x; { const int bx = blockIdx.x; F.vcu = (F.G % 8 == 0) ? (bx % 8) * (F.G / 8) + bx / 8 : bx; }
    volatile LAS unsigned* MISC = (volatile LAS unsigned*)(F.lds + LDS_MISC);
    if (F.tid < 64) MISC[F.tid] = 0u;
    __syncthreads();
    XcdBarrier bar = xcd_barrier_post((unsigned*)(AWS(args, 0) + WS_CTL) + 1024 + (size_t)args.li * XCD_BAR_WORDS, MISC);
    const int s_lo = args.s_lo, s_hi = args.s_hi;
#define RUNK(s, k) ((((PH_MASK) >> (k)) & 1) && s_lo <= (s) && (s) < s_hi)
#ifndef GEMM_ALIGN
#define GEMM_ALIGN true
#endif
#ifndef GEMM_SP2
#define GEMM_SP2 true
#endif
#ifndef SEAM_REPS
#define SEAM_REPS 1
#endif
#define SEAM(s) do { if ((s) + 1 < s_hi) { for (int sr_ = 0; sr_ < SEAM_REPS; ++sr_) xcd_barrier(bar); } } while (0)

    if (RUNK(0, 0)) { _Pragma("unroll 1") for (int rep_ = 0; rep_ < REPS(0); ++rep_) { PFRAME(); phase_prologue(P, args); } SEAM(0); }

#pragma unroll 1
    for (int g = 0; g < 2; ++g) {
#pragma unroll 1
        for (int l = 0; l <= DEPTH; ++l) {
            const int sb = 1 + g * 49 + l * 12;
            const int L = grpL(g), NB = grpB(g), MG = grpMem(g);
            if (RUNK(sb + 0, 1)) {
                _Pragma("unroll 1") for (int rep_ = 0; rep_ < REPS(1); ++rep_) {
                { PFRAME();
                bf16* XB = P_HN(); float* RS = P_RS(); const float* gpost = AIN(args, 31, P.zs) + (size_t)(l > 0 ? l - 1 : 0) * DM;
#ifndef SKIP_ROWOPA
                if (l == 0) { const float* xi = AIN(args, g, P.zs); for (int m = gw; m < TOK; m += 4 * NGW) rowop_bf<0, 4>(xi, XB, nullptr, nullptr, RS, nullptr, m, NGW, P.lane); }
                else if (l < DEPTH) { const bf16* FO = P_FO(); for (int m = gw; m < TOK; m += 8 * NGW) rowop_bf<1, 8>(nullptr, XB, FO, gpost, RS, nullptr, m, NGW, P.lane); }
                else { const bf16* FO = P_FO(); float* xres = P_XRES(); for (int m = gw; m < TOK; m += 8 * NGW) rowop_bf<2, 8>(nullptr, XB, FO, gpost, nullptr, xres, m, NGW, P.lane); }
#endif
                if (l < DEPTH) {
                    const float* gm = AIN(args, 25, P.zs) + (size_t)l * DM; const float* memin = AIN(args, 2 + g, P.zs); bf16* MN = P_MN();
                    for (int m = gw; m < MG; m += NGW) rowop_rows<1>(memin, nullptr, nullptr, nullptr, gm, MN, m, 0, P.lane);
                    const int nit = (L / 64) * 4;
                    _Pragma("unroll 1") for (int r2_ = 0; r2_ < REPS(14); ++r2_)
                    for (int it = P.vcu; it < nit; it += P.G) filt_f1_item(P, args, l, L, it);
                } }
                }
                SEAM(sb + 0);
            }
            if (l == DEPTH) continue;
            if (RUNK(sb + 1, 2)) {
                _Pragma("unroll 1") for (int rep_ = 0; rep_ < REPS(2); ++rep_) {
                { PFRAME(); pg8::Gemm gq{P_HN(), P_WL() + WL_IN, TOK, 1024, 1024}; pg8::StaticOrder S; S.init(TOK, 1024, P.G, (int)blockIdx.x);
                  pg8::EpiRopeQK E{P_QK(), (const float*)(ws + WS_TAB), L - 1, 0.125f * LOG2E, P_RS()};
                  pg8::gemm_phase<pg8::EpiRopeQK, pg8::StaticOrder, GEMM_ALIGN, GEMM_SP2>(P.lds, gq, S, E); }
                { PFRAME(); pg8::Gemm gv{P_WL() + WL_IN + (size_t)1024 * 1024, P_HN(), 2048, TOK, 1024}; pg8::StaticOrder S; S.init(2048, TOK, P.G, (int)blockIdx.x);
                  pg8::EpiBf16 E{P_VHT(), TOK, 1.f, nullptr, P_RS()};
                  pg8::gemm_phase<pg8::EpiBf16, pg8::StaticOrder, GEMM_ALIGN, GEMM_SP2>(P.lds, gv, S, E); }
                __syncthreads();
                _Pragma("unroll 1") for (int r2_ = 0; r2_ < REPS(15); ++r2_)
                { PFRAME();
                if (g == 0) { for (int c = P.vcu; c < 512; c += P.G) filt_f2_item<12>(P, args, l, c); }
                else        { for (int c = P.vcu; c < 512; c += P.G) filt_f2_item<14>(P, args, l, c); } }
                }
                SEAM(sb + 1);
            }
            if (RUNK(sb + 2, 3)) {
                _Pragma("unroll 1") for (int rep_ = 0; rep_ < REPS(3); ++rep_) {
                { PFRAME();
                float lam, lam_init;
                { const float p1 = AIN(args, 7, P.zs)[l * 64 + P.lane] * AIN(args, 8, P.zs)[l * 64 + P.lane]; const float p2 = AIN(args, 9, P.zs)[l * 64 + P.lane] * AIN(args, 10, P.zs)[l * 64 + P.lane];
                  lam_init = 0.8f - 0.6f * expf(-0.3f * (float)l); lam = expf(wave_sum(p1)) - expf(wave_sum(p2)) + lam_init; }
                const int nqb = L / 128, nun = NB * 4 * nqb; bf16* QK = P_QK(); bf16* VHT = P_VHT(); bf16* MIX = P_MIX(); const float* sg = AIN(args, 11, P.zs) + l * 128;
#pragma unroll 1
                for (int u = P.vcu; u < nun; u += P.G) {
                    const int qb = u % nqb, bh = u / nqb, h = bh & 3, b = bh >> 2; const size_t t0 = (size_t)b * L;
                    AttnPtrs A; A.Q = QK + (t0 + (size_t)qb * 128) * 1024 + h * 128; A.ldq = 1024;
                    A.K = QK + t0 * 1024 + 512 + h * 128; A.ldk = 1024; A.VT = VHT + (size_t)(h * 128) * TOK + t0; A.ldv = TOK; A.nkeys = L;
                    A.O = MIX + (t0 + (size_t)qb * 128) * 1024 + h * 128; A.ldo = 1024;
#ifndef SKIP_DATTN
                    pipe_attn_unit<true>(P, A, lam, 1.f - lam_init, sg);
#endif
                } } }
                __syncthreads();
                _Pragma("unroll 1") for (int rep_ = 0; rep_ < REPS(13); ++rep_) {
                { PFRAME();
                if (g == 0) { for (int u = P.vcu; u < 512 * 4; u += P.G) hyena_unit<12, 4>(P, args, l, u >> 2, (u & 3) * 4); }
                else        { for (int u = P.vcu; u < 512 * 4; u += P.G) hyena_unit<14, 1>(P, args, l, u >> 2, u & 3); } }
                }
                SEAM(sb + 2);
            }
            if (RUNK(sb + 3, 4)) {
                _Pragma("unroll 1") for (int rep_ = 0; rep_ < REPS(4); ++rep_) { { PFRAME(); for (int t = P.vcu; t < 8 * (TOK / 64); t += P.G) ytrans_tile(P, args, t); } }
                SEAM(sb + 3); }
            if (RUNK(sb + 4, 5)) {
                _Pragma("unroll 1") for (int rep_ = 0; rep_ < REPS(5); ++rep_) {
                { PFRAME(); pg8::Gemm gm{P_MIX(), P_WL() + WL_OUT, TOK, 1024, 1024}; pg8::StaticOrder S; S.init(TOK, 1024, P.G, (int)blockIdx.x);
                  pg8::EpiBf16 E{P_MO(), 1024, 1.f, nullptr, nullptr};
                  pg8::gemm_phase<pg8::EpiBf16, pg8::StaticOrder, GEMM_ALIGN, GEMM_SP2>(P.lds, gm, S, E); }
                }
                SEAM(sb + 4);
            }
            if (RUNK(sb + 5, 6)) {
                _Pragma("unroll 1") for (int rep_ = 0; rep_ < REPS(6); ++rep_) {
                { PFRAME();
                bf16* XB = P_HN(); float* RS = P_RS(); const bf16* MO = P_MO(); const float* gpost = AIN(args, 5, P.zs) + (size_t)l * DM;
                if (rep_ == 0) for (int m = gw; m < TOK; m += 8 * NGW) rowop_bf<1, 8>(nullptr, XB, MO, gpost, RS, nullptr, m, NGW, P.lane);
                else for (int m = gw; m < TOK; m += 8 * NGW) rowop_bf<1, 8>(nullptr, XB, MO, gpost, (float*)(ws + WS_MIX), nullptr, m, NGW, P.lane, WSP(WS_VHT)); }
                }
                SEAM(sb + 5);
            }
            if (RUNK(sb + 6, 7)) {
                _Pragma("unroll 1") for (int rep_ = 0; rep_ < REPS(7); ++rep_) {
                if (SITE_MASK & 1) { PFRAME(); pg8::Gemm gq{P_HN(), P_WL() + WL_Q, TOK, 1024, 1024}; pg8::StaticOrder S; S.init(TOK, 1024, P.G, (int)blockIdx.x);
                  pg8::EpiBf16 E{P_QX(), 1024, 0.0625f * LOG2E, P_RS(), nullptr};
                  pg8::gemm_phase<pg8::EpiBf16, pg8::StaticOrder, GEMM_ALIGN, GEMM_SP2>(P.lds, gq, S, E); }
                if (SITE_MASK & 2) { PFRAME(); pg8::Gemm gk{P_MN(), P_WL() + WL_K, MG, 1024, 1024}; pg8::StaticOrder S; S.init(MG, 1024, P.G, (int)blockIdx.x);
                  pg8::EpiBf16 E{P_KX(), 1024, 1.f, nullptr, nullptr};
                  pg8::gemm_phase<pg8::EpiBf16, pg8::StaticOrder, GEMM_ALIGN, GEMM_SP2>(P.lds, gk, S, E); }
                if (SITE_MASK & 4) { PFRAME(); pg8::Gemm gv{P_WL() + WL_V, P_MN(), 1024, MG, 1024}; pg8::StaticOrder S; S.init(1024, MG, P.G, (int)((blockIdx.x + P.G / 2) % P.G));
                  pg8::EpiBf16 E{P_VXT(), MG, 1.f, nullptr, nullptr};
                  pg8::gemm_phase<pg8::EpiBf16, pg8::StaticOrder, GEMM_ALIGN, GEMM_SP2>(P.lds, gv, S, E); }
                }
                SEAM(sb + 6);
            }
            if (RUNK(sb + 7, 8)) {
                _Pragma("unroll 1") for (int rep_ = 0; rep_ < REPS(8); ++rep_) {
                { PFRAME();
                const int nqb = L / 128, nun = NB * 4 * nqb; bf16* QX = P_QX(); bf16* KX = P_KX(); bf16* VXT = P_VXT(); bf16* OX = P_OX();
#pragma unroll 1
                for (int u = P.vcu; u < nun; u += P.G) {
                    const int qb = u % nqb, bh = u / nqb, h = bh & 3, b = bh >> 2; const size_t t0 = (size_t)b * L;
                    AttnPtrs A; A.Q = QX + (t0 + (size_t)qb * 128) * 1024 + h * 256; A.ldq = 1024;
                    A.K = KX + (size_t)(b * NMEMK) * 1024 + h * 256; A.ldk = 1024; A.VT = VXT + (size_t)(h * 256) * MG + (size_t)b * NMEMK; A.ldv = MG; A.nkeys = NMEMK;
                    A.O = OX + (t0 + (size_t)qb * 128) * 1024 + h * 256; A.ldo = 1024;
                    pipe_attn_unit<false>(P, A, 0.f, 1.f, nullptr);
                } }
                }
                SEAM(sb + 7);
            }
            if (RUNK(sb + 8, 9)) {
                _Pragma("unroll 1") for (int rep_ = 0; rep_ < REPS(9); ++rep_) {
                { PFRAME(); pg8::Gemm gm{P_OX(), P_WL() + WL_O, TOK, 1024, 1024}; pg8::StaticOrder S; S.init(TOK, 1024, P.G, (int)blockIdx.x);
                  pg8::EpiBf16 E{P_XO(), 1024, 1.f, nullptr, nullptr};
                  pg8::gemm_phase<pg8::EpiBf16, pg8::StaticOrder, GEMM_ALIGN, GEMM_SP2>(P.lds, gm, S, E); }
                }
                SEAM(sb + 8);
            }
            if (RUNK(sb + 9, 10)) {
                _Pragma("unroll 1") for (int rep_ = 0; rep_ < REPS(10); ++rep_) {
                { PFRAME();
                bf16* XB = P_HN(); float* RS = P_RS(); const bf16* XO = P_XO(); const float* gpost = AIN(args, 24, P.zs) + (size_t)l * DM;
                if (rep_ == 0) for (int m = gw; m < TOK; m += 8 * NGW) rowop_bf<1, 8>(nullptr, XB, XO, gpost, RS, nullptr, m, NGW, P.lane);
                else for (int m = gw; m < TOK; m += 8 * NGW) rowop_bf<1, 8>(nullptr, XB, XO, gpost, (float*)(ws + WS_MIX), nullptr, m, NGW, P.lane, WSP(WS_VHT)); }
                }
                SEAM(sb + 9);
            }
            if (RUNK(sb + 10, 11)) {
                _Pragma("unroll 1") for (int rep_ = 0; rep_ < REPS(11); ++rep_) {
#ifdef PANEL_GU
                { PFRAME(); pg8::Gemm gm{P_HN(), P_WL() + WL_GU, TOK, 2 * DFF, 1024}; pg8::PanelOrder S; S.init(TOK, 2 * DFF, P.G, P.vcu, false);
                  pg8::EpiSwiGLU E{P_HID(), DFF, P_RS()};
                  pg8::gemm_phase<pg8::EpiSwiGLU, pg8::PanelOrder, true, true>(P.lds, gm, S, E); }
#else
                { PFRAME(); pg8::Gemm gm{P_HN(), P_WL() + WL_GU, TOK, 2 * DFF, 1024}; pg8::StaticOrder S; S.init(TOK, 2 * DFF, P.G, (int)blockIdx.x);
                  pg8::EpiSwiGLU E{P_HID(), DFF, P_RS()};
                  pg8::gemm_phase<pg8::EpiSwiGLU, pg8::StaticOrder, GEMM_ALIGN, GEMM_SP2>(P.lds, gm, S, E); }
#endif
                }
                SEAM(sb + 10);
            }
            if (RUNK(sb + 11, 12)) {
                _Pragma("unroll 1") for (int rep_ = 0; rep_ < REPS(12); ++rep_) {
                { PFRAME(); pg8::Gemm gm{P_HID(), P_WL() + WL_D, TOK, 1024, DFF}; pg8::StaticOrder S; S.init(TOK, 1024, P.G, (int)blockIdx.x);
                  pg8::EpiBf16 E{P_FO(), 1024, 1.f, nullptr, nullptr};
                  pg8::gemm_phase<pg8::EpiBf16, pg8::StaticOrder, GEMM_ALIGN, GEMM_SP2>(P.lds, gm, S, E); }
                }
                SEAM(sb + 11);
            }
        }
    }
#undef RUNK
#undef SEAM
}

extern "C" void kernel_launch(void* const* d_in, const int* in_sizes, int n_in, void* d_out, int out_size, void* d_ws, size_t ws_size, hipStream_t stream) {
    static int grid = 0;
    if (grid == 0) {
        if (n_in != 35 || out_size != 2 * TOK * DM || ws_size < WS_END) { fprintf(stderr, "kernel_launch: unexpected shapes (n_in %d out %d ws %zu)\n", n_in, out_size, ws_size); grid = -1; return; }
        int dev = 0, cus = 0, per_cu = 0;
        if (hipGetDevice(&dev) != hipSuccess || hipDeviceGetAttribute(&cus, hipDeviceAttributeMultiprocessorCount, dev) != hipSuccess) { grid = -1; return; }
        if (hipFuncSetAttribute((const void*)hymba_fwd, hipFuncAttributeMaxDynamicSharedMemorySize, LDS_BYTES) != hipSuccess) { fprintf(stderr, "kernel_launch: hipFuncSetAttribute failed\n"); grid = -1; return; }
        if (hipOccupancyMaxActiveBlocksPerMultiprocessor(&per_cu, (const void*)hymba_fwd, NTHR, LDS_BYTES) != hipSuccess || per_cu < 1) { fprintf(stderr, "kernel_launch: occupancy query reports %d\n", per_cu); per_cu = 1; }
        (void)hipGetLastError();
        grid = cus;
    }
    if (grid < 0) return;
    (void)hipMemsetAsync((char*)d_ws + WS_CTL, 0, CTL_ZERO_BYTES, stream);
    Args a{};
    for (int i = 0; i < 35; ++i) a.p[i] = d_in[i];
    a.p[35] = d_out; a.p[36] = d_ws; a.pad = 0;
#if MK_PER_STEP
    for (int s = 0; s < N_STEPS; ++s) { a.s_lo = s; a.s_hi = s + 1; a.li = 0; hipLaunchKernelGGL(hymba_fwd, dim3(grid), dim3(NTHR), LDS_BYTES, stream, a); }
#else
    a.s_lo = 0; a.s_hi = N_STEPS; a.li = 0;
    hipLaunchKernelGGL(hymba_fwd, dim3(grid), dim3(NTHR), LDS_BYTES, stream, a);
#endif
}
```

```cpp
#include <hip/hip_runtime.h>
#include <cstdio>
#include <cstdint>
#define MK_PER_STEP 0
namespace pg8 {
#define PG8_LAS __attribute__((address_space(3)))
typedef unsigned short bf16_t;
typedef short bf16x8 __attribute__((ext_vector_type(8)));
typedef float f32x4 __attribute__((ext_vector_type(4)));
typedef unsigned u32x4 __attribute__((ext_vector_type(4)));
constexpr int BM = 256, BK = 64, HALF = 128, HTB = HALF * BK * 2  , STAGE_BYTES = 8 * HTB, NXCD = 8, WGM = 8;

__host__ __device__ __forceinline__ int lds_byte(int r, int c) { const int st = (r >> 4) * 2 + (c >> 5), rr = r & 15, cc = c & 31, ob = rr * 64 + cc * 2; return st * 1024 + (ob ^ (((ob >> 9) & 1) << 5)); }
__host__ __device__ __forceinline__ void stage_rc(int b, int& R, int& C) { const int st = b / 1024, sb = b % 1024, swz = sb ^ (((sb >> 9) & 1) << 5); R = (st >> 1) * 16 + swz / 64; C = (st & 1) * 32 + (swz % 64) / 2; }
__host__ __device__ __forceinline__ int perm32(int rho) { const int n = rho >> 4, i = rho & 15; return 8 * (i >> 2) + 4 * n + (i & 3); }

struct Unit { int pm, pn; };
struct Gemm { const bf16_t* A; const bf16_t* Bt; int M, N, K; };

struct StaticOrder {
    int nM, nN, nwg, G, c;
    __host__ __device__ void init(int M, int N, int G_, int c_) { nM = M / BM; nN = N / BM; nwg = nM * nN; G = G_; c = c_; }
    __host__ __device__ bool next(int i, Unit& u) const {
        const long L = (long)i * G + c; if (L >= nwg) return false;
        int wgid = (int)L; { const int q = nwg / NXCD, r = nwg % NXCD, xcd = wgid % NXCD, off = wgid / NXCD; wgid = (xcd < r ? xcd * (q + 1) : r * (q + 1) + (xcd - r) * q) + off; }
        const int nig = WGM * nN, gid = wgid / nig, fm = gid * WGM, gsz = (nM - fm) < WGM ? (nM - fm) : WGM;
        u.pm = fm + ((wgid % nig) % gsz); u.pn = (wgid % nig) / gsz; return true;
    }
    __device__ __forceinline__ void a_ready(const Unit&) const {}
    __device__ __forceinline__ void done(const Unit&) const {}
};
struct PanelOrder {
    int nM, nN, G, c; bool tr;
    __host__ __device__ void init(int M, int N, int G_, int c_, bool tr_) { nM = M / BM; nN = N / BM; G = G_; c = c_; tr = tr_; }
    __host__ __device__ bool next(int i, Unit& u) const {
        const int per = tr ? nM : nN, np = tr ? nN : nM; const int pi = i / per, ti = i % per; const int p = c + pi * G; if (p >= np) return false;
        if (tr) { u.pm = ti; u.pn = p; } else { u.pm = p; u.pn = ti; } return true;
    }
    __device__ __forceinline__ void a_ready(const Unit&) const {}
    __device__ __forceinline__ void done(const Unit&) const {}
};
typedef unsigned u32x2 __attribute__((ext_vector_type(2)));
__device__ __forceinline__ unsigned cvt_pk_bf16(float lo, float hi) { unsigned r; asm volatile("v_cvt_pk_bf16_f32 %0, %1, %2" : "=v"(r) : "v"(lo), "v"(hi)); return r; }

struct EpiBf16 {
    static constexpr bool PERM = true, AFTER_DRAIN = false;
    bf16_t* O; int ldc; float scale; const float* rowscale; const float* colscale;
    __device__ __forceinline__ void operator()(const f32x4 (&acc)[2][2][4][2], const Unit& u, int wr, int wc, int fr, int fq) const {
        const int row0 = u.pm * BM + wr * 64 + fr; const int col0 = u.pn * BM + wc * 32 + 8 * fq;
        f32x4 cs[2][2];
#pragma unroll
        for (int bj = 0; bj < 2; ++bj) { if (colscale) { cs[bj][0] = *(const f32x4*)(colscale + col0 + bj * HALF); cs[bj][1] = *(const f32x4*)(colscale + col0 + bj * HALF + 4); }
            else { cs[bj][0] = (f32x4){1.f, 1.f, 1.f, 1.f}; cs[bj][1] = cs[bj][0]; } }
        float rsv[2][4];
#pragma unroll
        for (int ai = 0; ai < 2; ++ai)
#pragma unroll
            for (int m = 0; m < 4; ++m) rsv[ai][m] = rowscale ? scale * rowscale[row0 + ai * HALF + m * 16] : scale;
#pragma unroll
        for (int ai = 0; ai < 2; ++ai)
#pragma unroll
            for (int m = 0; m < 4; ++m) { const int row = row0 + ai * HALF + m * 16; bf16_t* rowp = O + (size_t)row * ldc + col0; const float sc = rsv[ai][m];
#pragma unroll
                for (int bj = 0; bj < 2; ++bj) { const f32x4 v0 = acc[ai][bj][m][0] * cs[bj][0] * sc, v1 = acc[ai][bj][m][1] * cs[bj][1] * sc;
                    u32x4 w; w.x = cvt_pk_bf16(v0[0], v0[1]); w.y = cvt_pk_bf16(v0[2], v0[3]); w.z = cvt_pk_bf16(v1[0], v1[1]); w.w = cvt_pk_bf16(v1[2], v1[3]);
                    *(u32x4*)(rowp + bj * HALF) = w; } }
    }
};
struct EpiRopeQK {
    static constexpr bool PERM = true, AFTER_DRAIN = false;
    bf16_t* O; const float* tab; int lmask; float qscale; const float* rowscale;
    __device__ __forceinline__ void operator()(const f32x4 (&acc)[2][2][4][2], const Unit& u, int wr, int wc, int fr, int fq) const {
        const int row0 = u.pm * BM + wr * 64 + fr; const int col0 = u.pn * BM + wc * 32 + 8 * fq;
        const float sc0 = (u.pn < 2) ? qscale : 1.f;
        const bool ropew = (wc & 1) == 0;
        float scv[2][4];
#pragma unroll
        for (int ai = 0; ai < 2; ++ai)
#pragma unroll
            for (int m = 0; m < 4; ++m) scv[ai][m] = sc0 * rowscale[row0 + ai * HALF + m * 16];
#pragma unroll
        for (int ai = 0; ai < 2; ++ai)
#pragma unroll
          for (int mh = 0; mh < 2; ++mh) {
            f32x4 c0v[2], c1v[2], s0v[2], s1v[2];
#pragma unroll
            for (int mm = 0; mm < 2; ++mm) { const int row = row0 + ai * HALF + (2 * mh + mm) * 16;
                c0v[mm] = (f32x4){1.f, 1.f, 1.f, 1.f}; c1v[mm] = c0v[mm]; s0v[mm] = (f32x4){0.f, 0.f, 0.f, 0.f}; s1v[mm] = s0v[mm];
                if (ropew) { const float* tp = tab + (size_t)(row & lmask) * 16; c0v[mm] = *(const f32x4*)(tp); c1v[mm] = *(const f32x4*)(tp + 4); s0v[mm] = *(const f32x4*)(tp + 8); s1v[mm] = *(const f32x4*)(tp + 12); } }
#pragma unroll
            for (int mm = 0; mm < 2; ++mm) { const int m = 2 * mh + mm; const int row = row0 + ai * HALF + m * 16; bf16_t* rowp = O + (size_t)row * 1024 + col0; const float sc = scv[ai][m];
                f32x4 c0 = c0v[mm], c1 = c1v[mm], s0 = s0v[mm], s1 = s1v[mm];
                if (ropew) {
                    if (fq == 1) { s0 = -s0; s1 = -s1; }
                    if (fq >= 2) { s0 = (f32x4){0.f, 0.f, 0.f, 0.f}; s1 = s0; c0 = (f32x4){1.f, 1.f, 1.f, 1.f}; c1 = c0; } }
#pragma unroll
                for (int bj = 0; bj < 2; ++bj) { f32x4 v0 = acc[ai][bj][m][0], v1 = acc[ai][bj][m][1];
                    if (ropew) { f32x4 p0, p1;
#pragma unroll
                        for (int j = 0; j < 4; ++j) { p0[j] = __shfl_xor(v0[j], 16); p1[j] = __shfl_xor(v1[j], 16); }
                        v0 = v0 * c0 - p0 * s0; v1 = v1 * c1 - p1 * s1; }
                    v0 = v0 * sc; v1 = v1 * sc;
                    u32x4 w; w.x = cvt_pk_bf16(v0[0], v0[1]); w.y = cvt_pk_bf16(v0[2], v0[3]); w.z = cvt_pk_bf16(v1[0], v1[1]); w.w = cvt_pk_bf16(v1[2], v1[3]);
                    *(u32x4*)(rowp + bj * HALF) = w; } }
          }
    }
};
struct EpiSwiGLU {
    static constexpr bool PERM = true, AFTER_DRAIN = false;
    bf16_t* O; int ldc; const float* rowscale;
    __device__ __forceinline__ void operator()(const f32x4 (&acc)[2][2][4][2], const Unit& u, int wr, int wc, int fr, int fq) const {
        const int row0 = u.pm * BM + wr * 64 + fr; const int col0 = (u.pn * BM + wc * 32 + 8 * fq) >> 1;
        float rsv[2][4];
#pragma unroll
        for (int ai = 0; ai < 2; ++ai)
#pragma unroll
            for (int m = 0; m < 4; ++m) rsv[ai][m] = rowscale[row0 + ai * HALF + m * 16];
#pragma unroll
        for (int ai = 0; ai < 2; ++ai)
#pragma unroll
            for (int m = 0; m < 4; ++m) { const int row = row0 + ai * HALF + m * 16; bf16_t* rowp = O + (size_t)row * ldc + col0; const float rsc = rsv[ai][m];
#pragma unroll
                for (int bj = 0; bj < 2; ++bj) { const f32x4 g = acc[ai][bj][m][0] * rsc, up = acc[ai][bj][m][1] * rsc; f32x4 h;
#pragma unroll
                    for (int j = 0; j < 4; ++j) { const float e = __builtin_amdgcn_exp2f(-g[j] * 1.4426950408889634f); h[j] = g[j] * __builtin_amdgcn_rcpf(1.f + e) * up[j]; }
                    u32x2 w; w.x = cvt_pk_bf16(h[0], h[1]); w.y = cvt_pk_bf16(h[2], h[3]);
                    *(u32x2*)(rowp + bj * (HALF / 2)) = w; } }
    }
};
template <class Epi, class Sched, bool ALIGN_EPI = false, bool SP2 = false>
__device__ __forceinline__ void gemm_phase(PG8_LAS unsigned char* lds, const Gemm g, const Sched& S, const Epi& E) {
    int tid_l = threadIdx.x; asm volatile("" : "+v"(tid_l));
    const int tid = tid_l, wid = __builtin_amdgcn_readfirstlane(tid >> 6), lane = tid & 63, wr = wid >> 2, wc = wid & 3, fr = lane & 15, fq = lane >> 4;
    const int K = g.K, nt = K / BK;
    unsigned voffA[2], voffB[2];
#pragma unroll
    for (int i = 0; i < 2; ++i) { int R, C; stage_rc(tid * 16 + i * 8192, R, C); const int Rb = Epi::PERM ? ((R & ~31) + perm32(R & 31)) : R;
        voffA[i] = (unsigned)(R * K + C) * 2u; voffB[i] = (unsigned)(Rb * K + C) * 2u; }
    const size_t kstep = (size_t)(BK * 2);
    const size_t hstep = (size_t)HALF * K * 2;
    const size_t tstep = 2 * hstep;
    const unsigned ldsw = (unsigned)wid * 1024u;
    const int aoff = lds_byte(wr * 64 + fr, fq * 8), boff = lds_byte(wc * 32 + fr, fq * 8);
#define PG8_SA(b, h) (((b) * 2 + (h)) * HTB)
#define PG8_SB(b, h) ((4 + (b) * 2 + (h)) * HTB)
#define PG8_STAGE(bufoff, gbase, voff) do { _Pragma("unroll") for (int _i = 0; _i < 2; ++_i) \
        __builtin_amdgcn_global_load_lds((const unsigned*)((const char*)(gbase) + (voff)[_i]), (PG8_LAS unsigned*)(lds + (bufoff) + ldsw + _i * 8192), 16, 0, 0); } while (0)
#define PG8_LDA(dst, b, h) do { _Pragma("unroll") for (int m = 0; m < 4; ++m) _Pragma("unroll") for (int k = 0; k < 2; ++k) dst[m][k] = *(const PG8_LAS bf16x8*)(lds + PG8_SA(b, h) + aoff + m * 2048 + k * 1024); } while (0)
#define PG8_LDB(dst, b, h) do { _Pragma("unroll") for (int n = 0; n < 2; ++n) _Pragma("unroll") for (int k = 0; k < 2; ++k) dst[n][k] = *(const PG8_LAS bf16x8*)(lds + PG8_SB(b, h) + boff + n * 2048 + k * 1024); } while (0)
#define PG8_MMA(ai, bj, At, Bt) do { __builtin_amdgcn_s_setprio(1); _Pragma("unroll") for (int m = 0; m < 4; ++m) _Pragma("unroll") for (int n = 0; n < 2; ++n) _Pragma("unroll") for (int k = 0; k < 2; ++k) \
        acc[ai][bj][m][n] = __builtin_amdgcn_mfma_f32_16x16x32_bf16(Bt[n][k], At[m][k], acc[ai][bj][m][n], 0, 0, 0); __builtin_amdgcn_s_setprio(0); } while (0)
#define PG8_WAIT_V(n) asm volatile("s_waitcnt vmcnt(" #n ")" ::: "memory")
#define PG8_WAIT_L(n) asm volatile("s_waitcnt lgkmcnt(" #n ")" ::: "memory")
#define PG8_BAR __builtin_amdgcn_s_barrier()
#define PG8_SCHED __builtin_amdgcn_sched_barrier(0)
    Unit cur, nxt; int ui = 0;
    if (!S.next(0, cur)) return;
    f32x4 acc[2][2][4][2];
#pragma unroll
    for (int a = 0; a < 2; ++a)
#pragma unroll
        for (int b = 0; b < 2; ++b)
#pragma unroll
            for (int m = 0; m < 4; ++m)
#pragma unroll
                for (int n = 0; n < 2; ++n) acc[a][b][m][n] = (f32x4){0.f, 0.f, 0.f, 0.f};
    bf16x8 At[4][2], B0[2][2], B1[2][2];
    const char* cA = (const char*)g.A + (size_t)cur.pm * tstep; const char* cB = (const char*)g.Bt + (size_t)cur.pn * tstep;
    S.a_ready(cur);
    if constexpr (SP2) {
        PG8_STAGE(PG8_SB(0, 0), cB, voffB); PG8_STAGE(PG8_SB(0, 1), cB + hstep, voffB); PG8_STAGE(PG8_SA(0, 0), cA, voffA); PG8_STAGE(PG8_SA(0, 1), cA + hstep, voffA);
        if (wr == 1) PG8_BAR;
        PG8_WAIT_V(2); PG8_BAR;
        PG8_STAGE(PG8_SB(1, 0), cB + kstep, voffB); PG8_STAGE(PG8_SA(1, 0), cA + kstep, voffA); PG8_STAGE(PG8_SB(1, 1), cB + hstep + kstep, voffB);
        PG8_WAIT_V(6); PG8_BAR;
    } else {
        PG8_STAGE(PG8_SB(0, 0), cB, voffB); PG8_STAGE(PG8_SA(0, 0), cA, voffA); PG8_STAGE(PG8_SB(0, 1), cB + hstep, voffB); PG8_STAGE(PG8_SA(0, 1), cA + hstep, voffA);
        if (wr == 1) PG8_BAR;
        PG8_WAIT_V(4); PG8_BAR;
        PG8_STAGE(PG8_SB(1, 0), cB + kstep, voffB); PG8_STAGE(PG8_SA(1, 0), cA + kstep, voffA); PG8_STAGE(PG8_SB(1, 1), cB + hstep + kstep, voffB);
        PG8_WAIT_V(6); PG8_BAR;
    }
    for (;;) {
        const bool has_next = S.next(ui + 1, nxt);
        const char* nA = has_next ? (const char*)g.A + (size_t)nxt.pm * tstep : cA; const char* nB = has_next ? (const char*)g.Bt + (size_t)nxt.pn * tstep : cB;
        for (int t = 0; t < nt; t += 2) {
            const bool last = (t == nt - 2);
            const char* a1 = cA + (size_t)(t + 1) * kstep;
            const char* a2 = last ? nA : cA + (size_t)(t + 2) * kstep; const char* b2 = last ? nB : cB + (size_t)(t + 2) * kstep;
            const char* a3 = a2 + kstep; const char* b3 = b2 + kstep;
            if (last && has_next) S.a_ready(nxt);
            if constexpr (SP2) {
            PG8_LDB(B0, 0, 0); PG8_LDB(B1, 0, 1); PG8_SCHED; PG8_LDA(At, 0, 0); PG8_STAGE(PG8_SA(1, 1), a1 + hstep, voffA);
            PG8_WAIT_V(8); PG8_WAIT_L(0); PG8_BAR; PG8_MMA(0, 0, At, B0); PG8_MMA(0, 1, At, B1); PG8_BAR; PG8_SCHED;
            PG8_LDA(At, 0, 1); PG8_STAGE(PG8_SB(0, 0), b2, voffB); PG8_STAGE(PG8_SB(0, 1), b2 + hstep, voffB); PG8_STAGE(PG8_SA(0, 0), a2, voffA);
            PG8_WAIT_V(8); PG8_WAIT_L(0); PG8_BAR; PG8_MMA(1, 0, At, B0); PG8_MMA(1, 1, At, B1); PG8_BAR; PG8_SCHED;
            PG8_LDB(B0, 1, 0); PG8_LDB(B1, 1, 1); PG8_SCHED; PG8_LDA(At, 1, 0); PG8_STAGE(PG8_SA(0, 1), a2 + hstep, voffA);
            PG8_WAIT_V(8); PG8_WAIT_L(0); PG8_BAR; PG8_MMA(0, 0, At, B0); PG8_MMA(0, 1, At, B1); PG8_BAR; PG8_SCHED;
            PG8_LDA(At, 1, 1); PG8_STAGE(PG8_SB(1, 0), b3, voffB); PG8_STAGE(PG8_SB(1, 1), b3 + hstep, voffB); PG8_STAGE(PG8_SA(1, 0), a3, voffA);
            PG8_WAIT_V(8); PG8_WAIT_L(0); PG8_BAR; PG8_MMA(1, 0, At, B0); PG8_MMA(1, 1, At, B1); PG8_BAR; PG8_SCHED;
            } else {
            PG8_LDB(B0, 0, 0); PG8_SCHED; PG8_LDA(At, 0, 0); PG8_STAGE(PG8_SA(1, 1), a1 + hstep, voffA);
            PG8_WAIT_L(8); PG8_BAR; PG8_WAIT_L(0); PG8_MMA(0, 0, At, B0); PG8_BAR; PG8_SCHED;
            PG8_LDB(B1, 0, 1); PG8_STAGE(PG8_SB(0, 0), b2, voffB);
            PG8_BAR; PG8_WAIT_L(0); PG8_MMA(0, 1, At, B1); PG8_BAR;
            PG8_LDA(At, 0, 1); PG8_STAGE(PG8_SA(0, 0), a2, voffA);
            PG8_BAR; PG8_WAIT_L(0); PG8_MMA(1, 0, At, B0); PG8_BAR; PG8_SCHED;
            PG8_STAGE(PG8_SB(0, 1), b2 + hstep, voffB);
            PG8_WAIT_V(6); PG8_BAR; PG8_MMA(1, 1, At, B1); PG8_BAR;
            PG8_LDB(B0, 1, 0); PG8_SCHED; PG8_LDA(At, 1, 0); PG8_STAGE(PG8_SA(0, 1), a2 + hstep, voffA);
            PG8_WAIT_L(8); PG8_BAR; PG8_WAIT_L(0); PG8_MMA(0, 0, At, B0); PG8_BAR; PG8_SCHED;
            PG8_LDB(B1, 1, 1); PG8_STAGE(PG8_SB(1, 0), b3, voffB);
            PG8_BAR; PG8_WAIT_L(0); PG8_MMA(0, 1, At, B1); PG8_BAR;
            PG8_LDA(At, 1, 1); PG8_STAGE(PG8_SA(1, 0), a3, voffA);
            PG8_BAR; PG8_WAIT_L(0); PG8_MMA(1, 0, At, B0); PG8_BAR; PG8_SCHED;
            PG8_STAGE(PG8_SB(1, 1), b3 + hstep, voffB);
            PG8_WAIT_V(6); PG8_BAR; PG8_MMA(1, 1, At, B1); PG8_BAR;
            }
        }
        if constexpr (ALIGN_EPI) { if (wr == 0) PG8_BAR; }
        if constexpr (!Epi::AFTER_DRAIN) { E(acc, cur, wr, wc, fr, fq); S.done(cur); }
        if (!has_next) break;
#pragma unroll
        for (int a = 0; a < 2; ++a)
#pragma unroll
            for (int b = 0; b < 2; ++b)
#pragma unroll
                for (int m = 0; m < 4; ++m)
#pragma unroll
                    for (int n = 0; n < 2; ++n) acc[a][b][m][n] = (f32x4){0.f, 0.f, 0.f, 0.f};
        cur = nxt; cA = nA; cB = nB; ++ui;
        if constexpr (ALIGN_EPI) { if (wr == 1) PG8_BAR; }
    }
    PG8_WAIT_V(0);
    if constexpr (!ALIGN_EPI) { if (wr == 0) PG8_BAR; }
    PG8_BAR;
    if constexpr (Epi::AFTER_DRAIN) { E.fused(acc, cur, wr, wc, fr, fq, lds, wid, lane); S.done(cur); }
#undef PG8_SA
#undef PG8_SB
#undef PG8_STAGE
#undef PG8_LDA
#undef PG8_LDB
#undef PG8_MMA
#undef PG8_WAIT_V
#undef PG8_WAIT_L
#undef PG8_BAR
#undef PG8_SCHED
}
}
#define GAS __attribute__((address_space(1)))
#define LAS __attribute__((address_space(3)))
typedef unsigned short bf16;
typedef float f32x4 __attribute__((ext_vector_type(4)));
typedef float f32x2 __attribute__((ext_vector_type(2)));
typedef float f32x16 __attribute__((ext_vector_type(16)));
typedef short bf16x8 __attribute__((ext_vector_type(8)));
typedef short s16x4 __attribute__((ext_vector_type(4)));
typedef unsigned u32x4 __attribute__((ext_vector_type(4)));
typedef unsigned u32x2 __attribute__((ext_vector_type(2)));

constexpr int DM = 1024, DEPTH = 4, TOK = 65536, NMEMK = 256, DFF = 2816, NWAVES = 8, NTHR = 512;
constexpr float EPS = 1e-6f;
constexpr float LOG2E = 1.4426950408889634f;
constexpr size_t MiB = 1u << 20;
constexpr size_t WS_CTL = 0, CTL_ZERO_BYTES = 2 * MiB;
constexpr size_t WS_TAB = 2 * MiB;
constexpr size_t WS_RS = WS_TAB + 512 * 1024;
constexpr size_t WS_W = 3 * MiB;
constexpr size_t WL_IN = 0, WL_OUT = 3072 * 1024, WL_Q = WL_OUT + 1024 * 1024, WL_K = WL_Q + 1024 * 1024, WL_V = WL_K + 1024 * 1024, WL_O = WL_V + 1024 * 1024,
                 WL_GU = WL_O + 1024 * 1024, WL_D = WL_GU + 5632 * 1024, WL_STRIDE = WL_D + 1024 * 2816;
static_assert(WL_STRIDE * 2 * 4 == 130 * MiB, "weights");
constexpr size_t WS_HN = 133 * MiB;
constexpr size_t WS_QK = 261 * MiB;
constexpr size_t WS_VHT = 389 * MiB;
constexpr size_t WS_MIX = 645 * MiB;
constexpr size_t WS_YT = 773 * MiB;
constexpr size_t WS_KF = 837 * MiB;
constexpr size_t WS_KERNT = 901 * MiB;
constexpr size_t WS_MN = 933 * MiB, WS_KX = 949 * MiB, WS_VXT = 965 * MiB, WS_END = 981 * MiB;
constexpr int N_STEPS = 1 + 2 * 49;
constexpr int LDS_BYTES = 160 * 1024 - 512;
constexpr int LDS_MISC = 144 * 1024;
typedef GAS unsigned gu32;
#define RLX_AGENT __ATOMIC_RELAXED, __HIP_MEMORY_SCOPE_AGENT
#define LDS_WAIT() asm volatile("s_waitcnt lgkmcnt(0)" ::: "memory")
#define VM_WAIT() asm volatile("s_waitcnt vmcnt(0)" ::: "memory")
typedef __bf16 bf16x2_t __attribute__((ext_vector_type(2)));
__device__ __forceinline__ unsigned pkbf(float lo, float hi) { const f32x2 v = {lo, hi}; const bf16x2_t b = __builtin_convertvector(v, bf16x2_t); return __builtin_bit_cast(unsigned, b); }
__device__ __forceinline__ float bf_lo(unsigned w) { return __uint_as_float(w << 16); }
__device__ __forceinline__ float bf_hi(unsigned w) { return __uint_as_float(w & 0xffff0000u); }
__device__ __forceinline__ float bf1(bf16 h) { return __uint_as_float(((unsigned)h) << 16); }
__device__ __forceinline__ float dpp_add(float v, const int ctrl_sel) {
    const int x = __builtin_bit_cast(int, v); int y;
    if (ctrl_sel == 0) y = __builtin_amdgcn_update_dpp(0, x, 0xB1, 0xF, 0xF, true);
    else if (ctrl_sel == 1) y = __builtin_amdgcn_update_dpp(0, x, 0x4E, 0xF, 0xF, true);
    else if (ctrl_sel == 2) y = __builtin_amdgcn_update_dpp(0, x, 0x141, 0xF, 0xF, true);
    else y = __builtin_amdgcn_update_dpp(0, x, 0x140, 0xF, 0xF, true);
    return v + __builtin_bit_cast(float, y);
}
__device__ __forceinline__ float wave_sum(float v) {
    v = dpp_add(v, 0); v = dpp_add(v, 1); v = dpp_add(v, 2); v = dpp_add(v, 3);
    const int x = __builtin_bit_cast(int, v);
    const float r0 = __builtin_bit_cast(float, __builtin_amdgcn_readlane(x, 0)), r1 = __builtin_bit_cast(float, __builtin_amdgcn_readlane(x, 16)),
                r2 = __builtin_bit_cast(float, __builtin_amdgcn_readlane(x, 32)), r3 = __builtin_bit_cast(float, __builtin_amdgcn_readlane(x, 48));
    return (r0 + r1) + (r2 + r3);
}
#define XB_TMO      128
#define XB_XCNT(j)  (256  + 64 * (j))
#define XB_XSUB(j)  (1280 + 64 * (j))
#define XB_XGEN(j)  (2304 + 64 * (j))
#define XB_TOP      3328
#define XB_TOPGEN   3392
#define XCD_BAR_WORDS 3456
#define XB_SPIN_CAP (1u << 18)

__device__ __forceinline__ unsigned xb_ld(unsigned* p)              { return __hip_atomic_load(p, __ATOMIC_RELAXED, __HIP_MEMORY_SCOPE_AGENT); }
__device__ __forceinline__ unsigned xb_add(unsigned* p, unsigned v) { return __hip_atomic_fetch_add(p, v, __ATOMIC_RELAXED, __HIP_MEMORY_SCOPE_AGENT); }
__device__ __forceinline__ unsigned xb_xcc_id() { return (unsigned)__builtin_amdgcn_s_getreg((3 << 11) | 20) & 0xFu; }
#define XB_SPIN(cond, bar) do { unsigned _sp = 0; while (cond) { __builtin_amdgcn_s_sleep(1); \
    if ((++_sp & 255u) == 0u) { if (xb_ld(&(bar)[XB_TMO])) break; if (_sp > XB_SPIN_CAP) { atomicAdd(&(bar)[XB_TMO], 1u); break; } } } } while (0)

struct XcdBarrier {
    unsigned* bar; unsigned x;
    volatile LAS unsigned* st;
};

__device__ __forceinline__ XcdBarrier xcd_barrier_post(unsigned* bar, volatile LAS unsigned* st) {
    XcdBarrier b; b.bar = bar; b.x = xb_xcc_id(); b.st = st;
    if (threadIdx.x == 0) (void)xb_add(&bar[XB_XCNT(b.x)], 1u);
    return b;
}
__device__ __forceinline__ void xcd_barrier_complete(unsigned* bar, unsigned x, unsigned& nloc, unsigned& nx) {
    const unsigned G = gridDim.x * gridDim.y * gridDim.z;
    unsigned sum, cnt, mine, sp = 0u;
    for (;;) {
        sum = 0u; cnt = 0u; mine = 0u;
#pragma unroll
        for (unsigned j = 0; j < 16; ++j) { const unsigned c = xb_ld(&bar[XB_XCNT(j)]); sum += c; cnt += (c > 0u) ? 1u : 0u; mine = (j == x) ? c : mine; }
        if (sum == G) break;
        __builtin_amdgcn_s_sleep(1);
        if ((++sp & 255u) == 0u) { if (xb_ld(&bar[XB_TMO])) break; if (sp > XB_SPIN_CAP) { atomicAdd(&bar[XB_TMO], 1u); break; } }
    }
    nloc = mine > 0u ? mine : 1u; nx = cnt > 0u ? cnt : 1u;
}

__device__ __forceinline__ void xcd_barrier(const XcdBarrier& b) {
    asm volatile("s_waitcnt vmcnt(0)" ::: "memory");
    __syncthreads();
    if (threadIdx.x == 0) {
        unsigned* bar = b.bar;
        __builtin_amdgcn_s_waitcnt(0);
        unsigned nloc = b.st[0], nx = b.st[1];
        if (nloc == 0u) { xcd_barrier_complete(bar, b.x, nloc, nx); b.st[0] = nloc; b.st[1] = nx; }
        const unsigned old = xb_add(&bar[XB_XSUB(b.x)], 1u);
        const unsigned gen = old / nloc;
        if (old + 1u == (gen + 1u) * nloc) {
            __builtin_amdgcn_fence(__ATOMIC_RELEASE, "agent");
            asm volatile("s_waitcnt vmcnt(0)" ::: "memory");
            const unsigned og = xb_add(&bar[XB_TOP], 1u);
            const unsigned tg = og / nx;
            if (og + 1u == (tg + 1u) * nx) xb_add(&bar[XB_TOPGEN], 1u);
            else XB_SPIN(xb_ld(&bar[XB_TOPGEN]) == tg, bar);
            __builtin_amdgcn_fence(__ATOMIC_ACQUIRE, "agent");
            xb_add(&bar[XB_XGEN(b.x)], 1u);
            asm volatile("s_waitcnt vmcnt(0)" ::: "memory");
        } else {
            XB_SPIN(xb_ld(&bar[XB_XGEN(b.x)]) == gen, bar);
            __builtin_amdgcn_fence(__ATOMIC_ACQUIRE, "agent");
            asm volatile("s_waitcnt vmcnt(0)" ::: "memory");
        }
    }
    __syncthreads();
}
struct Args { const void* p[37]; int s_lo, s_hi, li, pad; };
#define AIN(a, k, zs) ((const float*)(a).p[(k) + (zs)])
#define AWS(a, zs) ((unsigned char*)(a).p[36 + (zs)])
#define AOUT(a, zs) ((float*)(a).p[35 + (zs)])
struct Frame {
    LAS unsigned char* lds;
    int tid, lane, wave, vcu, G, zs;
};
__device__ __forceinline__ int grpB(int g) { return g == 0 ? 32 : 8; }
__device__ __forceinline__ int grpL(int g) { return g == 0 ? 2048 : 8192; }
__device__ __forceinline__ int grpMem(int g) { return g == 0 ? 8192 : 2048; }

__device__ __forceinline__ void transpose_item(const float* W, int K, int N, bf16* WT, int mode, LAS float* scr, int item, int lane, const float* gk = nullptr) {
    const int nblk = N / 32, kb = item / nblk, nb = item % nblk, k0 = 64 * kb, n0 = 32 * nb;
#pragma unroll 8
    for (int i = 0; i < 32; ++i) { const int kk = 2 * i + (lane >> 5); scr[kk * 33 + (lane & 31)] = W[(size_t)(k0 + kk) * N + n0 + (lane & 31)]; }
    LDS_WAIT(); asm volatile("" ::: "memory");
    const int c = lane & 7;
    f32x4 g0 = (f32x4){1.f, 1.f, 1.f, 1.f}, g1 = g0;
    if (gk) { g0 = *(const GAS f32x4*)(gk + k0 + 8 * c); g1 = *(const GAS f32x4*)(gk + k0 + 8 * c + 4); }
#pragma unroll
    for (int j = 0; j < 4; ++j) { const int n = (lane >> 3) + 8 * j; const LAS float* s = scr + (8 * c) * 33 + n;
        u32x4 o; o.x = pkbf(s[0 * 33] * g0.x, s[1 * 33] * g0.y); o.y = pkbf(s[2 * 33] * g0.z, s[3 * 33] * g0.w); o.z = pkbf(s[4 * 33] * g1.x, s[5 * 33] * g1.y); o.w = pkbf(s[6 * 33] * g1.z, s[7 * 33] * g1.w);
        const int ng = n0 + n; const int dr = (mode == 0) ? ng : (8 * (ng >> 2) + (ng & 3) + (mode == 2 ? 4 : 0));
        *(GAS u32x4*)(WT + (size_t)dr * K + k0 + 8 * c) = o; }
    LDS_WAIT(); asm volatile("" ::: "memory");
}
__device__ __forceinline__ void phase_prologue(const Frame& F, const Args& a) {
    LAS float* scr = (LAS float*)(F.lds + F.wave * 16384);
    const int gw = F.vcu * NWAVES + F.wave, NGW = F.G * NWAVES;
    bf16* WB = (bf16*)(AWS(a, F.zs) + WS_W);
    constexpr int I_IN = 16 * 96, I_SQ = 16 * 32, I_G = 16 * 88, I_D = 44 * 32;
    constexpr int PER_LAYER = I_IN + 5 * I_SQ + 2 * I_G + I_D;
    for (int it = gw; it < DEPTH * PER_LAYER; it += NGW) {
        const int l = it / PER_LAYER; int r = it % PER_LAYER; bf16* wl = WB + (size_t)l * WL_STRIDE;
        if (r < I_IN) { transpose_item(AIN(a, 6, F.zs) + (size_t)l * 1024 * 3072, 1024, 3072, wl + WL_IN, 0, scr, r, F.lane, AIN(a, 4, F.zs) + l * DM); continue; } r -= I_IN;
        if (r < I_SQ) { transpose_item(AIN(a, 22, F.zs) + (size_t)l * 1024 * 1024, 1024, 1024, wl + WL_OUT, 0, scr, r, F.lane); continue; } r -= I_SQ;
        if (r < I_SQ) { transpose_item(AIN(a, 26, F.zs) + (size_t)l * 1024 * 1024, 1024, 1024, wl + WL_Q, 0, scr, r, F.lane, AIN(a, 23, F.zs) + l * DM); continue; } r -= I_SQ;
        if (r < I_SQ) { transpose_item(AIN(a, 27, F.zs) + (size_t)l * 1024 * 1024, 1024, 1024, wl + WL_K, 0, scr, r, F.lane); continue; } r -= I_SQ;
        if (r < I_SQ) { transpose_item(AIN(a, 28, F.zs) + (size_t)l * 1024 * 1024, 1024, 1024, wl + WL_V, 0, scr, r, F.lane); continue; } r -= I_SQ;
        if (r < I_SQ) { transpose_item(AIN(a, 29, F.zs) + (size_t)l * 1024 * 1024, 1024, 1024, wl + WL_O, 0, scr, r, F.lane); continue; } r -= I_SQ;
        if (r < I_G) { transpose_item(AIN(a, 32, F.zs) + (size_t)l * 1024 * DFF, 1024, DFF, wl + WL_GU, 1, scr, r, F.lane, AIN(a, 30, F.zs) + l * DM); continue; } r -= I_G;
        if (r < I_G) { transpose_item(AIN(a, 33, F.zs) + (size_t)l * 1024 * DFF, 1024, DFF, wl + WL_GU, 2, scr, r, F.lane, AIN(a, 30, F.zs) + l * DM); continue; } r -= I_G;
        transpose_item(AIN(a, 34, F.zs) + (size_t)l * DFF * 1024, DFF, 1024, wl + WL_D, 0, scr, r, F.lane);
    }
    float* tab = (float*)(AWS(a, F.zs) + WS_TAB);
    for (int i = F.vcu * NTHR + F.tid; i < 8192 * 8; i += F.G * NTHR) { const int pos = i >> 3, j = i & 7;
        const float inv = (float)pow(500000.0, -(double)j / 8.0); const float ang = (float)pos * inv;
        tab[pos * 16 + j] = (float)cos((double)ang); tab[pos * 16 + 8 + j] = (float)sin((double)ang); }
}

template <int R> __device__ __forceinline__ void rowop_rows(const float* xin, const bf16* sub, const float* gpost, float* xout, const float* gpre, bf16* hn, int m0, int rstride, int lane) {
    f32x4 v[R][4]; u32x2 sw[R][4];
#pragma unroll
    for (int r = 0; r < R; ++r) { const GAS f32x4* xr = (const GAS f32x4*)(xin + (size_t)(m0 + r * rstride) * DM) + lane;
#pragma unroll
        for (int j = 0; j < 4; ++j) v[r][j] = __builtin_nontemporal_load(xr + 64 * j); }
    if (sub) {
#pragma unroll
        for (int r = 0; r < R; ++r) { const GAS u32x2* sr = (const GAS u32x2*)(sub + (size_t)(m0 + r * rstride) * DM) + lane;
#pragma unroll
            for (int j = 0; j < 4; ++j) sw[r][j] = __builtin_nontemporal_load(sr + 64 * j); }
        f32x4 gp[4];
#pragma unroll
        for (int j = 0; j < 4; ++j) gp[j] = ((const GAS f32x4*)gpost + lane)[64 * j];
        float ss[R];
#pragma unroll
        for (int r = 0; r < R; ++r) { ss[r] = 0.f;
#pragma unroll
            for (int j = 0; j < 4; ++j) { const float a = bf_lo(sw[r][j].x), b = bf_hi(sw[r][j].x), c = bf_lo(sw[r][j].y), d = bf_hi(sw[r][j].y); ss[r] += (a * a + b * b) + (c * c + d * d); } }
#pragma unroll
        for (int r = 0; r < R; ++r) ss[r] = wave_sum(ss[r]);
#pragma unroll
        for (int r = 0; r < R; ++r) { const float rs = 1.0f / sqrtf(ss[r] * (1.f / DM) + EPS); GAS f32x4* xo = (GAS f32x4*)(xout + (size_t)(m0 + r * rstride) * DM) + lane;
#pragma unroll
            for (int j = 0; j < 4; ++j) { const f32x4 sv = (f32x4){bf_lo(sw[r][j].x), bf_hi(sw[r][j].x), bf_lo(sw[r][j].y), bf_hi(sw[r][j].y)};
                v[r][j] = v[r][j] + (sv * rs) * gp[j]; __builtin_nontemporal_store(v[r][j], xo + 64 * j); } }
    }
    if (hn) {
        f32x4 gq[4];
#pragma unroll
        for (int j = 0; j < 4; ++j) gq[j] = ((const GAS f32x4*)gpre + lane)[64 * j];
        float ss[R];
#pragma unroll
        for (int r = 0; r < R; ++r) { ss[r] = 0.f;
#pragma unroll
            for (int j = 0; j < 4; ++j) ss[r] += (v[r][j].x * v[r][j].x + v[r][j].y * v[r][j].y) + (v[r][j].z * v[r][j].z + v[r][j].w * v[r][j].w); }
#pragma unroll
        for (int r = 0; r < R; ++r) ss[r] = wave_sum(ss[r]);
#pragma unroll
        for (int r = 0; r < R; ++r) { const float rs = 1.0f / sqrtf(ss[r] * (1.f / DM) + EPS); GAS u32x2* ho = (GAS u32x2*)(hn + (size_t)(m0 + r * rstride) * DM) + lane;
#pragma unroll
            for (int j = 0; j < 4; ++j) { const f32x4 o = (v[r][j] * rs) * gq[j]; u32x2 w; w.x = pkbf(o.x, o.y); w.y = pkbf(o.z, o.w); ho[64 * j] = w; } }
    }
}

__device__ __forceinline__ void unpack8(const u32x4 w, float (&f)[8]) { f[0] = bf_lo(w.x); f[1] = bf_hi(w.x); f[2] = bf_lo(w.y); f[3] = bf_hi(w.y); f[4] = bf_lo(w.z); f[5] = bf_hi(w.z); f[6] = bf_lo(w.w); f[7] = bf_hi(w.w); }
__device__ __forceinline__ u32x4 pack8(const float (&f)[8]) { return (u32x4){pkbf(f[0], f[1]), pkbf(f[2], f[3]), pkbf(f[4], f[5]), pkbf(f[6], f[7])}; }
template <int MODE, int R> __device__ __forceinline__ void rowop_bf(const float* xf, bf16* xb, const bf16* sub, const float* gpost, float* rsout, float* outf, int m0, int rstride, int lane, bf16* xbo = nullptr) {
    if (!xbo) xbo = xb;
    f32x4 xr[MODE == 0 ? R : 1][4]; u32x4 xw[MODE == 0 ? 1 : R][2], sw[MODE == 0 ? 1 : R][2];
    if (MODE == 0) {
#pragma unroll
        for (int r = 0; r < R; ++r) { const GAS f32x4* p = (const GAS f32x4*)(xf + (size_t)(m0 + r * rstride) * DM) + 2 * lane;
            xr[r][0] = __builtin_nontemporal_load(p); xr[r][1] = __builtin_nontemporal_load(p + 1); xr[r][2] = __builtin_nontemporal_load(p + 128); xr[r][3] = __builtin_nontemporal_load(p + 129); }
    } else {
#pragma unroll
        for (int r = 0; r < R; ++r) { const GAS u32x4* p = (const GAS u32x4*)(xb + (size_t)(m0 + r * rstride) * DM) + lane; xw[r][0] = p[0]; xw[r][1] = p[64];
            const GAS u32x4* q = (const GAS u32x4*)(sub + (size_t)(m0 + r * rstride) * DM) + lane; sw[r][0] = __builtin_nontemporal_load(q); sw[r][1] = __builtin_nontemporal_load(q + 64); }
    }
    float g[16];
    if (MODE != 0) { const GAS f32x4* gp = (const GAS f32x4*)gpost + 2 * lane; const f32x4 a = gp[0], b = gp[1], c = gp[128], d = gp[129];
        g[0] = a.x; g[1] = a.y; g[2] = a.z; g[3] = a.w; g[4] = b.x; g[5] = b.y; g[6] = b.z; g[7] = b.w; g[8] = c.x; g[9] = c.y; g[10] = c.z; g[11] = c.w; g[12] = d.x; g[13] = d.y; g[14] = d.z; g[15] = d.w; }
#pragma unroll
    for (int r = 0; r < R; ++r) {
        const int m = m0 + r * rstride; float x[16];
        if (MODE == 0) {
#pragma unroll
            for (int j = 0; j < 4; ++j) { x[4 * j] = xr[r][j].x; x[4 * j + 1] = xr[r][j].y; x[4 * j + 2] = xr[r][j].z; x[4 * j + 3] = xr[r][j].w; }
        } else {
            float s0[8], s1[8], x0[8], x1[8]; unpack8(sw[r][0], s0); unpack8(sw[r][1], s1); unpack8(xw[r][0], x0); unpack8(xw[r][1], x1);
            float ss = 0.f;
#pragma unroll
            for (int j = 0; j < 8; ++j) ss += s0[j] * s0[j] + s1[j] * s1[j];
            const float rs = 1.0f / sqrtf(wave_sum(ss) * (1.f / DM) + EPS);
#pragma unroll
            for (int j = 0; j < 8; ++j) { x[j] = x0[j] + (s0[j] * rs) * g[j]; x[8 + j] = x1[j] + (s1[j] * rs) * g[8 + j]; }
        }
        if (MODE == 2) {
            GAS f32x4* p = (GAS f32x4*)(outf + (size_t)m * DM) + 2 * lane;
            __builtin_nontemporal_store((f32x4){x[0], x[1], x[2], x[3]}, p); __builtin_nontemporal_store((f32x4){x[4], x[5], x[6], x[7]}, p + 1);
            __builtin_nontemporal_store((f32x4){x[8], x[9], x[10], x[11]}, p + 128); __builtin_nontemporal_store((f32x4){x[12], x[13], x[14], x[15]}, p + 129);
        } else {
            float ss = 0.f;
#pragma unroll
            for (int j = 0; j < 16; ++j) ss += x[j] * x[j];
            ss = wave_sum(ss);
            GAS u32x4* p = (GAS u32x4*)(xbo + (size_t)m * DM) + lane; float a[8], b[8];
#pragma unroll
            for (int j = 0; j < 8; ++j) { a[j] = x[j]; b[j] = x[8 + j]; }
            p[0] = pack8(a); p[64] = pack8(b);
            if (lane == 0) rsout[m] = 1.0f / sqrtf(ss * (1.f / DM) + EPS);
        }
    }
}
__device__ __forceinline__ f32x2 cmul(f32x2 a, f32x2 b) { return (f32x2){a.x * b.x - a.y * b.y, a.x * b.y + a.y * b.x}; }
__device__ __forceinline__ f32x2 twid(float ph) { return (f32x2){__builtin_amdgcn_cosf(ph), -__builtin_amdgcn_sinf(ph)}; }
#define ZI(i) ((i) ^ (((i) >> 4) & 15))
template <bool INV> __device__ __forceinline__ void r4bf(f32x2& a0, f32x2& a1, f32x2& a2, f32x2& a3, float ph) {
    if (!INV) {
        const f32x2 t0 = a0 + a2, t1 = a0 - a2, t2 = a1 + a3, d = a1 - a3; const f32x2 t3 = (f32x2){d.y, -d.x};
        a0 = t0 + t2; a1 = cmul(t1 + t3, twid(ph)); a2 = cmul(t0 - t2, twid(2.f * ph)); a3 = cmul(t1 - t3, twid(3.f * ph));
    } else {
        f32x2 w1 = twid(ph), w2 = twid(2.f * ph), w3 = twid(3.f * ph); w1.y = -w1.y; w2.y = -w2.y; w3.y = -w3.y;
        const f32x2 b1 = cmul(a1, w1), b2 = cmul(a2, w2), b3 = cmul(a3, w3);
        const f32x2 t0 = a0 + b2, t1 = a0 - b2, t2 = b1 + b3, d = b1 - b3; const f32x2 t3 = (f32x2){-d.y, d.x};
        a0 = t0 + t2; a1 = t1 + t3; a2 = t0 - t2; a3 = t1 - t3;
    }
}
template <int LOGN, int NSEQ, int LS, bool INV, bool ZHALF> __device__ __forceinline__ void fft_pass16(LAS f32x2* z, int tid_in) {
    int tid = tid_in; asm volatile("" : "+v"(tid));
    constexpr int N = 1 << LOGN, NB = NSEQ * (N / 16), IT = (NB + NTHR - 1) / NTHR, s = 1 << LS;
#pragma unroll 1
    for (int jb = 0; jb < IT; ++jb) {
        const int j = tid + jb * NTHR;
        if (NB % NTHR == 0 || j < NB) {
            const int q = j >> (LOGN - 4), jj = j & (N / 16 - 1), k = jj & (s - 1), base = ((jj >> LS) << (LS + 4)) + k;
            LAS f32x2* zq = z + q * N;
            f32x2 a[16];
#pragma unroll
            for (int m = 0; m < 16; ++m) { if (ZHALF && !INV && m >= 8) a[m] = (f32x2){0.f, 0.f}; else a[m] = zq[ZI(base + m * s)]; }
            const float phb = (float)k * (1.0f / (float)(4 * s));
            if (!INV) {
#pragma unroll
                for (int r = 0; r < 4; ++r) r4bf<false>(a[r], a[r + 4], a[r + 8], a[r + 12], (float)(k + r * s) * (1.0f / (float)(16 * s)));
#pragma unroll
                for (int p = 0; p < 4; ++p) r4bf<false>(a[4 * p], a[4 * p + 1], a[4 * p + 2], a[4 * p + 3], phb);
            } else {
#pragma unroll
                for (int p = 0; p < 4; ++p) r4bf<true>(a[4 * p], a[4 * p + 1], a[4 * p + 2], a[4 * p + 3], phb);
#pragma unroll
                for (int r = 0; r < 4; ++r) r4bf<true>(a[r], a[r + 4], a[r + 8], a[r + 12], (float)(k + r * s) * (1.0f / (float)(16 * s)));
            }
#pragma unroll
            for (int m = 0; m < 16; ++m) { if (!(ZHALF && INV && m >= 8)) zq[ZI(base + m * s)] = a[m]; }
        }
    }
    __syncthreads();
}
template <int LOGN, int NSEQ, bool INV> __device__ __forceinline__ void fft_pass4s1(LAS f32x2* z, int tid_in) {
    int tid = tid_in; asm volatile("" : "+v"(tid));
    constexpr int N = 1 << LOGN, NB = NSEQ * (N / 4), IT = NB / NTHR, BT = 4;
    static_assert(IT % BT == 0, "span-1 stage: whole batches");
#pragma unroll 1
    for (int jb = 0; jb < IT; jb += BT) {
        f32x2 a[BT][4]; int idx[BT];
#pragma unroll
        for (int b = 0; b < BT; ++b) { const int j = tid + (jb + b) * NTHR; idx[b] = (j >> (LOGN - 2)) * N + 4 * (j & (N / 4 - 1));
#pragma unroll
            for (int qq = 0; qq < 4; ++qq) a[b][qq] = z[(idx[b] & ~(N - 1)) + ZI((idx[b] & (N - 1)) + qq)]; }
#pragma unroll
        for (int b = 0; b < BT; ++b) { r4bf<INV>(a[b][0], a[b][1], a[b][2], a[b][3], 0.f);
#pragma unroll
            for (int qq = 0; qq < 4; ++qq) z[(idx[b] & ~(N - 1)) + ZI((idx[b] & (N - 1)) + qq)] = a[b][qq]; }
    }
    __syncthreads();
}
template <int LOGN, int NSEQ, bool ZPAD> __device__ __forceinline__ void fft_fwd(LAS f32x2* z, int tid) {
    static_assert(LOGN == 12 || LOGN == 14, "sizes in use");
    if constexpr (LOGN == 14) { fft_pass16<14, NSEQ, 10, false, ZPAD>(z, tid); fft_pass16<14, NSEQ, 6, false, false>(z, tid); fft_pass16<14, NSEQ, 2, false, false>(z, tid); fft_pass4s1<14, NSEQ, false>(z, tid); }
    else { fft_pass16<12, NSEQ, 8, false, ZPAD>(z, tid); fft_pass16<12, NSEQ, 4, false, false>(z, tid); fft_pass16<12, NSEQ, 0, false, false>(z, tid); }
}
template <int LOGN, int NSEQ, bool ZPAD> __device__ __forceinline__ void fft_inv(LAS f32x2* z, int tid) {
    if constexpr (LOGN == 14) { fft_pass4s1<14, NSEQ, true>(z, tid); fft_pass16<14, NSEQ, 2, true, false>(z, tid); fft_pass16<14, NSEQ, 6, true, false>(z, tid); fft_pass16<14, NSEQ, 10, true, ZPAD>(z, tid); }
    else { fft_pass16<12, NSEQ, 0, true, false>(z, tid); fft_pass16<12, NSEQ, 4, true, false>(z, tid); fft_pass16<12, NSEQ, 8, true, ZPAD>(z, tid); }
}

__device__ __forceinline__ float sin_rev(float x) { return __builtin_amdgcn_sinf(x * 0.15915494309189535f); }
__device__ __forceinline__ float cos_rev(float x) { return __builtin_amdgcn_cosf(x * 0.15915494309189535f); }
__device__ __forceinline__ void filt_f1_item(const Frame& F, const Args& a, int l, int L, int item) {
    LAS float* zf = (LAS float*)F.lds;
    LAS float* h1 = zf + 33 * 64;
    LAS float* h2 = h1 + 64 * 64;
    LAS float* w3s = h2 + 64 * 64;
    const int jc = item >> 2, ch = item & 3, j0 = jc * 64, tid = F.tid, j = tid & 63, wv = F.wave, lane = F.lane;
    const float* w1 = AIN(a, 14, F.zs) + (size_t)l * 33 * 64; const float* b1 = AIN(a, 15, F.zs) + l * 64; const float* fr1 = AIN(a, 16, F.zs) + l * 64;
    const float* w2 = AIN(a, 17, F.zs) + (size_t)l * 64 * 64; const float* b2 = AIN(a, 18, F.zs) + l * 64; const float* fr2 = AIN(a, 19, F.zs) + l * 64;
    const float* w3 = AIN(a, 20, F.zs) + (size_t)l * 64 * 1024;
    const int jj = j0 + j; const float tj = (float)jj / (float)(L - 1);
    {
        const float w = (6.283185307179586f * (float)jj) / (float)L;
#pragma unroll
        for (int q = 0; q < 2; ++q) { const int m = 2 * wv + q; const float f = 1e-4f + (float)m * ((15.0f - 1e-4f) / 15.0f); const float fw = f * w;
            zf[(1 + m) * 64 + j] = cos_rev(fw); zf[(17 + m) * 64 + j] = -sin_rev(fw); }
        if (wv == 0) zf[j] = tj;
    }
    __syncthreads();
#pragma unroll 1
    for (int q = 0; q < 8; ++q) { const int o = wv * 8 + q; const float wl = (lane < 33) ? w1[lane * 64 + o] : 0.f; float acc = b1[o];
#pragma unroll
        for (int i = 0; i < 33; ++i) { const float wi = __builtin_bit_cast(float, __builtin_amdgcn_readlane(__builtin_bit_cast(int, wl), i)); const float zv = zf[i * 64 + j];
            asm("v_fmac_f32 %0, %1, %2" : "+v"(acc) : "v"(zv), "v"(wi)); }
        h1[o * 64 + j] = sin_rev(fr1[o] * acc); }
    __syncthreads();
#pragma unroll 1
    for (int q = 0; q < 8; ++q) { const int o = wv * 8 + q; const float wl = w2[lane * 64 + o]; float acc = b2[o];
#pragma unroll
        for (int i = 0; i < 64; ++i) { const float wi = __builtin_bit_cast(float, __builtin_amdgcn_readlane(__builtin_bit_cast(int, wl), i)); const float hv = h1[i * 64 + j];
            asm("v_fmac_f32 %0, %1, %2" : "+v"(acc) : "v"(hv), "v"(wi)); if ((i & 7) == 7) __builtin_amdgcn_sched_barrier(0); }
        h2[o * 64 + j] = sin_rev(fr2[o] * acc); }
    __syncthreads();
    float* KT = (float*)(AWS(a, F.zs) + WS_KERNT);
    float hreg[64];
#pragma unroll
    for (int i = 0; i < 64; ++i) hreg[i] = h2[i * 64 + j];
    LAS float* ws_ = w3s + wv * (64 * 16);
#pragma unroll 1
    for (int cc = 0; cc < 2; ++cc) {
        const int col0 = ch * 256 + wv * 32 + cc * 16;
        { const GAS f32x4* src = (const GAS f32x4*)(w3 + (size_t)lane * 1024 + col0);
          const f32x4 a0 = src[0], a1 = src[1], a2 = src[2], a3 = src[3];
          LAS f32x4* dst = (LAS f32x4*)(ws_ + lane * 16); dst[0] = a0; dst[1] = a1; dst[2] = a2; dst[3] = a3; }
        LDS_WAIT(); asm volatile("" ::: "memory");
#pragma unroll 1
        for (int c4 = 0; c4 < 4; ++c4) {
            float acc[4] = {0.f, 0.f, 0.f, 0.f};
#pragma unroll
            for (int kb = 0; kb < 8; ++kb) { f32x4 wv_[8];
#pragma unroll
                for (int u = 0; u < 8; ++u) wv_[u] = *(const LAS f32x4*)(ws_ + (kb * 8 + u) * 16 + c4 * 4);
#pragma unroll
                for (int u = 0; u < 8; ++u) { const float h_ = hreg[kb * 8 + u];
                    asm("v_fmac_f32 %0, %1, %2" : "+v"(acc[0]) : "v"(wv_[u].x), "v"(h_)); asm("v_fmac_f32 %0, %1, %2" : "+v"(acc[1]) : "v"(wv_[u].y), "v"(h_));
                    asm("v_fmac_f32 %0, %1, %2" : "+v"(acc[2]) : "v"(wv_[u].z), "v"(h_)); asm("v_fmac_f32 %0, %1, %2" : "+v"(acc[3]) : "v"(wv_[u].w), "v"(h_)); }
                __builtin_amdgcn_sched_barrier(0); }
#pragma unroll
            for (int e = 0; e < 4; ++e) { const int col = col0 + c4 * 4 + e; const int c = col & 511;
                const float delta = 3.0701134573253944f + (float)c * ((15.350567286626972f - 3.0701134573253944f) / 511.0f);
                KT[(size_t)col * 8192 + jj] = acc[e] * __builtin_amdgcn_exp2f(-tj * delta * 1.4426950408889634f); }
        }
        LDS_WAIT(); asm volatile("" ::: "memory");
    }
    __syncthreads();
}
template <int LOGN> __device__ __forceinline__ void filt_f2_item(const Frame& F, const Args& a, int l, int c) {
    constexpr int N = 1 << LOGN, L = N / 2;
    LAS f32x2* z = (LAS f32x2*)F.lds; LAS float* red = (LAS float*)(F.lds + LDS_MISC + 64);
    const float* KT = (const float*)(AWS(a, F.zs) + WS_KERNT); const float* hf = KT + (size_t)c * 8192; const float* hb = KT + (size_t)(512 + c) * 8192;
    const int tid = F.tid; float asum = 0.f;
    for (int j = tid; j < L; j += NTHR) { const float f = hf[j], b = hb[j];
        if (j == 0) { z[ZI(0)] = (f32x2){f + b, 0.f}; z[ZI(L)] = (f32x2){0.f, 0.f}; asum += fabsf(f + b); }
        else { z[ZI(j)] = (f32x2){f, 0.f}; z[ZI(N - j)] = (f32x2){b, 0.f}; asum += fabsf(f) + fabsf(b); } }
    asum = wave_sum(asum); if (F.lane == 0) red[F.wave] = asum;
    __syncthreads();
    float S = 0.f;
#pragma unroll
    for (int w = 0; w < NWAVES; ++w) S += red[w];
    fft_fwd<LOGN, 1, false>(z, tid);
    const float dsk = AIN(a, 21, F.zs)[l * 512 + c]; const float rS = 1.0f / S, rN = 1.0f / (float)N;
    f32x2* KF = (f32x2*)(AWS(a, F.zs) + WS_KF) + (size_t)c * N;
    for (int i = tid; i < N; i += NTHR) { const f32x2 v = z[i]; KF[i] = (f32x2){(v.x * rS + dsk) * rN, (v.y * rS) * rN}; }
    __syncthreads();
}

struct Chunk8 { u32x4 v; unsigned short pm, pp; };
__device__ __forceinline__ Chunk8 ld_chunk(const bf16* row, int ci, int nch) {
    Chunk8 c; c.v = *(const GAS u32x4*)(row + 8 * ci);
    c.pm = (ci > 0) ? *(const GAS unsigned short*)(row + 8 * ci - 1) : (unsigned short)0;
    c.pp = (ci + 1 < nch) ? *(const GAS unsigned short*)(row + 8 * ci + 8) : (unsigned short)0;
    return c;
}
__device__ __forceinline__ void conv8(const Chunk8& c, float w0, float w1, float w2, float b, float (&o)[8]) {
    float e[10]; e[0] = bf1(c.pm); e[9] = bf1(c.pp);
    e[1] = bf_lo(c.v.x); e[2] = bf_hi(c.v.x); e[3] = bf_lo(c.v.y); e[4] = bf_hi(c.v.y); e[5] = bf_lo(c.v.z); e[6] = bf_hi(c.v.z); e[7] = bf_lo(c.v.w); e[8] = bf_hi(c.v.w);
#pragma unroll
    for (int i = 0; i < 8; ++i) o[i] = w0 * e[i] + w1 * e[i + 1] + w2 * e[i + 2] + b;
}
template <int LOGN, int NSEQ> __device__ __forceinline__ void hyena_unit(const Frame& F, const Args& a, int l, int c, int p0) {
    constexpr int N = 1 << LOGN, L = N / 2, LOGCH = LOGN - 4, NCH = 1 << LOGCH, CPT = (NSEQ * NCH) / NTHR;
    static_assert(CPT * NTHR == NSEQ * NCH, "chunks divide evenly");
    LAS f32x2* z = (LAS f32x2*)F.lds; const int tid = F.tid;
    const bf16* VHT = (const bf16*)(AWS(a, F.zs) + WS_VHT);
    const float* cw = AIN(a, 12, F.zs) + (size_t)l * 3 * 1536; const float* cb = AIN(a, 13, F.zs) + l * 1536;
    const bf16* x0r = VHT + (size_t)(512 + c) * TOK + (size_t)(2 * p0) * L;
    const bf16* x1r = VHT + (size_t)(1024 + c) * TOK + (size_t)(2 * p0) * L;
    const bf16* vhr = VHT + (size_t)(1536 + c) * TOK + (size_t)(2 * p0) * L;
    const float a0 = cw[c], a1 = cw[1536 + c], a2 = cw[3072 + c], ab = cb[c];
    const float b0 = cw[512 + c], b1 = cw[1536 + 512 + c], b2 = cw[3072 + 512 + c], bb = cb[512 + c];
    const float c0 = cw[1024 + c], c1 = cw[1536 + 1024 + c], c2 = cw[3072 + 1024 + c], cbb = cb[1024 + c];
    constexpr int KPT = (N / 2) / NTHR; f32x4 kreg[KPT];
    {
        Chunk8 q1a[CPT], qva[CPT], q1b[CPT], qvb[CPT];
#pragma unroll
        for (int i = 0; i < CPT; ++i) { const int cg = tid + NTHR * i, q = cg >> LOGCH, ci = cg & (NCH - 1); const size_t ro = (size_t)(2 * q) * L;
            q1a[i] = ld_chunk(x1r + ro, ci, NCH); qva[i] = ld_chunk(vhr + ro, ci, NCH); q1b[i] = ld_chunk(x1r + ro + L, ci, NCH); qvb[i] = ld_chunk(vhr + ro + L, ci, NCH); }
#pragma unroll
        for (int i = 0; i < CPT; ++i) { const int cg = tid + NTHR * i, q = cg >> LOGCH, ci = cg & (NCH - 1);
            float xa[8], va[8], xb[8], vb[8]; conv8(q1a[i], b0, b1, b2, bb, xa); conv8(qva[i], c0, c1, c2, cbb, va); conv8(q1b[i], b0, b1, b2, bb, xb); conv8(qvb[i], c0, c1, c2, cbb, vb);
            const bool swp = (ci >> 1) & 1;
#pragma unroll
            for (int j = 0; j < 4; ++j) { const f32x2 e0 = (f32x2){xa[2 * j] * va[2 * j], xb[2 * j] * vb[2 * j]}, e1 = (f32x2){xa[2 * j + 1] * va[2 * j + 1], xb[2 * j + 1] * vb[2 * j + 1]};
                *(LAS f32x4*)(z + q * N + (ZI(8 * ci + 2 * j) & ~1)) = swp ? (f32x4){e1.x, e1.y, e0.x, e0.y} : (f32x4){e0.x, e0.y, e1.x, e1.y}; } }
    }
    __syncthreads();
#define HY_LOADK() do { const f32x2* KF = (const f32x2*)(AWS(a, F.zs) + WS_KF) + (size_t)c * N; \
        _Pragma("unroll") for (int ii = 0; ii < KPT; ++ii) kreg[ii] = *(const GAS f32x4*)(KF + 2 * (tid + NTHR * ii)); } while (0)
    if constexpr (LOGN == 14) { fft_pass16<14, NSEQ, 10, false, true>(z, tid); fft_pass16<14, NSEQ, 6, false, false>(z, tid); fft_pass16<14, NSEQ, 2, false, false>(z, tid); HY_LOADK(); fft_pass4s1<14, NSEQ, false>(z, tid); }
    else { fft_pass16<12, NSEQ, 8, false, true>(z, tid); fft_pass16<12, NSEQ, 4, false, false>(z, tid); HY_LOADK(); fft_pass16<12, NSEQ, 0, false, false>(z, tid); }
#undef HY_LOADK
#pragma unroll
    for (int ii = 0; ii < KPT; ++ii) { const int i = tid + NTHR * ii; const f32x4 k = kreg[ii];
#pragma unroll
        for (int q = 0; q < NSEQ; ++q) { const f32x4 v = *(LAS f32x4*)(z + q * N + 2 * i);
            *(LAS f32x4*)(z + q * N + 2 * i) = (f32x4){v.x * k.x - v.y * k.y, v.x * k.y + v.y * k.x, v.z * k.z - v.w * k.w, v.z * k.w + v.w * k.z}; } }
    __syncthreads();
    Chunk8 q0a[CPT], q0b[CPT];
#define HY_LOADX0() do { _Pragma("unroll") for (int i = 0; i < CPT; ++i) { const int cg = tid + NTHR * i, q = cg >> LOGCH, ci = cg & (NCH - 1); const size_t ro = (size_t)(2 * q) * L; \
        q0a[i] = ld_chunk(x0r + ro, ci, NCH); q0b[i] = ld_chunk(x0r + ro + L, ci, NCH); } } while (0)
    if constexpr (LOGN == 14) { fft_pass4s1<14, NSEQ, true>(z, tid); fft_pass16<14, NSEQ, 2, true, false>(z, tid); fft_pass16<14, NSEQ, 6, true, false>(z, tid); HY_LOADX0(); fft_pass16<14, NSEQ, 10, true, true>(z, tid); }
    else { fft_pass16<12, NSEQ, 0, true, false>(z, tid); fft_pass16<12, NSEQ, 4, true, false>(z, tid); HY_LOADX0(); fft_pass16<12, NSEQ, 8, true, true>(z, tid); }
#undef HY_LOADX0
    bf16* YT = (bf16*)(AWS(a, F.zs) + WS_YT) + (size_t)c * TOK + (size_t)(2 * p0) * L;
    {
#pragma unroll
        for (int i = 0; i < CPT; ++i) { const int cg = tid + NTHR * i, q = cg >> LOGCH, ci = cg & (NCH - 1); const size_t ro = (size_t)(2 * q) * L;
            float ga[8], gb[8]; conv8(q0a[i], a0, a1, a2, ab, ga); conv8(q0b[i], a0, a1, a2, ab, gb);
            float ya[8], yb[8];
            const bool swp = (ci >> 1) & 1;
#pragma unroll
            for (int j = 0; j < 4; ++j) { f32x4 v = *(LAS f32x4*)(z + q * N + (ZI(8 * ci + 2 * j) & ~1)); if (swp) v = (f32x4){v.z, v.w, v.x, v.y};
                ya[2 * j] = v.x * ga[2 * j]; yb[2 * j] = v.y * gb[2 * j]; ya[2 * j + 1] = v.z * ga[2 * j + 1]; yb[2 * j + 1] = v.w * gb[2 * j + 1]; }
            *(GAS u32x4*)(YT + ro + 8 * ci) = (u32x4){pkbf(ya[0], ya[1]), pkbf(ya[2], ya[3]), pkbf(ya[4], ya[5]), pkbf(ya[6], ya[7])};
            *(GAS u32x4*)(YT + ro + L + 8 * ci) = (u32x4){pkbf(yb[0], yb[1]), pkbf(yb[2], yb[3]), pkbf(yb[4], yb[5]), pkbf(yb[6], yb[7])}; }
    }
    __syncthreads();
}
__device__ __forceinline__ void ytrans_tile(const Frame& F, const Args& a, int tile) {
    LAS bf16* sm = (LAS bf16*)F.lds;
    const int cb = tile & 7, tb = tile >> 3, tid = F.tid;
    const bf16* YT = (const bf16*)(AWS(a, F.zs) + WS_YT); bf16* MIX = (bf16*)(AWS(a, F.zs) + WS_MIX);
    { const int c = tid >> 3, ch = tid & 7; const u32x4 v = *(const GAS u32x4*)(YT + (size_t)(cb * 64 + c) * TOK + (size_t)tb * 64 + ch * 8);
      *(LAS u32x4*)(sm + c * 72 + ch * 8) = v; }
    __syncthreads();
    { const int t = tid >> 3, cc = tid & 7; unsigned w[4];
#pragma unroll
      for (int q = 0; q < 4; ++q) { const unsigned lo = sm[(cc * 8 + 2 * q) * 72 + t], hi = sm[(cc * 8 + 2 * q + 1) * 72 + t]; w[q] = lo | (hi << 16); }
      *(GAS u32x4*)(MIX + (size_t)(tb * 64 + t) * 1024 + 512 + cb * 64 + cc * 8) = (u32x4){w[0], w[1], w[2], w[3]}; }
    __syncthreads();
}
__device__ __forceinline__ int crow(int r, int hi) { return (r & 3) + 8 * (r >> 2) + 4 * hi; }
template <bool DIFF> struct AttnCfg {
    static constexpr int DQK = DIFF ? 64 : 256, KW = DIFF ? 128 : 256, VR = DIFF ? 128 : 256;
    static constexpr int KROWB = KW * 2 + 16, VROWB = 136, KBYTES = 64 * KROWB, VBYTES = VR * VROWB, STAGE = KBYTES + VBYTES;
    static constexpr int NKP = 64 * (KW / 8) / NTHR, NVP = VR * 8 / NTHR, NKS = DQK / 16;
};
struct AttnPtrs {
    const bf16* Q; int ldq;
    const bf16* K; int ldk;
    const bf16* VT; size_t ldv;
    int nkeys;
    bf16* O; int ldo;
};
template <bool DIFF> __device__ __forceinline__ void attn_unit(const Frame& F, const AttnPtrs& P, float lam, float outscale, const float* subg) {
    typedef AttnCfg<DIFF> C;
    const int tid = F.tid, lane = F.lane, wid = F.wave, r32 = lane & 31, hi = lane >> 5, qsub = wid >> 1, role = wid & 1;
    LAS unsigned char* lds = F.lds;
#ifndef XQ_REGS
#define XQ_REGS 0
#endif
    constexpr bool QREG = DIFF || XQ_REGS;
    bf16x8 qf[QREG ? C::NKS : 1];
    const bf16* qp = P.Q + (size_t)(qsub * 32 + r32) * P.ldq + (DIFF ? role * 64 : 0) + hi * 8;
    if constexpr (QREG) {
#pragma unroll
      for (int ks = 0; ks < C::NKS; ++ks) qf[ks] = *(const GAS bf16x8*)(qp + ks * 16); }
    u32x4 kst[C::NKP];
    const int NT = P.nkeys / 64;
#define ATT_LOADK(t) do { \
        _Pragma("unroll") for (int i = 0; i < C::NKP; ++i) { const int p = tid + NTHR * i, key = p / (C::KW / 8), ch = p % (C::KW / 8); \
            kst[i] = *(const GAS u32x4*)(P.K + (size_t)((t) * 64 + key) * P.ldk + ch * 8); } } while (0)
#define ATT_LOADV(t) do { \
        _Pragma("unroll") for (int i = 0; i < C::NVP; ++i) { const int p = tid + NTHR * i, row = p >> 3, ch = p & 7; \
            kst[i] = *(const GAS u32x4*)(P.VT + (size_t)row * P.ldv + (size_t)(t) * 64 + ch * 8); } } while (0)
#define ATT_STOREK(buf) do { LAS unsigned char* kb_ = lds + (buf) * C::STAGE; \
        _Pragma("unroll") for (int i = 0; i < C::NKP; ++i) { const int p = tid + NTHR * i, key = p / (C::KW / 8), ch = p % (C::KW / 8); \
            *(LAS u32x4*)(kb_ + key * C::KROWB + ch * 16) = kst[i]; } } while (0)
#define ATT_STOREV(buf) do { LAS unsigned char* vb_ = lds + (buf) * C::STAGE + C::KBYTES; \
        _Pragma("unroll") for (int i = 0; i < C::NVP; ++i) { const int p = tid + NTHR * i, row = p >> 3, ch = p & 7; \
            *(LAS u32x2*)(vb_ + row * C::VROWB + ch * 16) = (u32x2){kst[i].x, kst[i].y}; *(LAS u32x2*)(vb_ + row * C::VROWB + ch * 16 + 8) = (u32x2){kst[i].z, kst[i].w}; } } while (0)
    static_assert(C::NKP == C::NVP, "one staging register set serves K then V");
    ATT_LOADK(0); ATT_STOREK(0); ATT_LOADV(0); ATT_STOREV(0);
    __syncthreads();
    f32x16 o[4];
#pragma unroll
    for (int d = 0; d < 4; ++d) o[d] = (f32x16){0.f, 0.f, 0.f, 0.f, 0.f, 0.f, 0.f, 0.f, 0.f, 0.f, 0.f, 0.f, 0.f, 0.f, 0.f, 0.f};
    float mrun = -INFINITY, lrun = 0.f;
    const int koff = (DIFF ? role * 64 : 0) * 2 + hi * 16, vroff = (DIFF ? 0 : role * 128);
#pragma unroll 1
    for (int t = 0; t < NT; ++t) {
        if (t + 1 < NT) ATT_LOADK(t + 1);
        const LAS unsigned char* kb = lds + (t & 1) * C::STAGE; const LAS unsigned char* vb = kb + C::KBYTES;
        f32x16 s0 = (f32x16){0.f, 0.f, 0.f, 0.f, 0.f, 0.f, 0.f, 0.f, 0.f, 0.f, 0.f, 0.f, 0.f, 0.f, 0.f, 0.f}, s1 = s0;
        int zo = 0; if constexpr (!QREG) asm volatile("" : "+v"(zo));
#pragma unroll
        for (int ks = 0; ks < C::NKS; ++ks) {
            const bf16x8 a0 = *(const LAS bf16x8*)(kb + r32 * C::KROWB + koff + ks * 32);
            const bf16x8 a1 = *(const LAS bf16x8*)(kb + (32 + r32) * C::KROWB + koff + ks * 32);
            bf16x8 qv; if constexpr (QREG) qv = qf[ks]; else qv = *(const GAS bf16x8*)(qp + ks * 16 + zo);
            s0 = __builtin_amdgcn_mfma_f32_32x32x16_bf16(a0, qv, s0, 0, 0, 0);
            s1 = __builtin_amdgcn_mfma_f32_32x32x16_bf16(a1, qv, s1, 0, 0, 0);
        }
        if (t + 1 < NT) { ATT_STOREK((t + 1) & 1); ATT_LOADV(t + 1); }
        float mx = fmaxf(s0[0], s1[0]);
#pragma unroll
        for (int r = 1; r < 16; ++r) mx = fmaxf(mx, fmaxf(s0[r], s1[r]));
        mx = fmaxf(mx, __shfl_xor(mx, 32));
        const float mnew = fmaxf(mrun, mx), alpha = __builtin_amdgcn_exp2f(mrun - mnew); mrun = mnew;
        float rs = 0.f;
#pragma unroll
        for (int r = 0; r < 16; ++r) { s0[r] = __builtin_amdgcn_exp2f(s0[r] - mnew); s1[r] = __builtin_amdgcn_exp2f(s1[r] - mnew); rs += s0[r] + s1[r]; }
        lrun = lrun * alpha + rs;
#pragma unroll
        for (int d = 0; d < 4; ++d)
#pragma unroll
            for (int r = 0; r < 16; ++r) o[d][r] *= alpha;
        bf16x8 pf[2][2];
#pragma unroll
        for (int s = 0; s < 2; ++s) {
            u32x4 w0, w1;
            w0.x = pkbf(s0[8 * s + 0], s0[8 * s + 1]); w0.y = pkbf(s0[8 * s + 2], s0[8 * s + 3]); w0.z = pkbf(s0[8 * s + 4], s0[8 * s + 5]); w0.w = pkbf(s0[8 * s + 6], s0[8 * s + 7]);
            w1.x = pkbf(s1[8 * s + 0], s1[8 * s + 1]); w1.y = pkbf(s1[8 * s + 2], s1[8 * s + 3]); w1.z = pkbf(s1[8 * s + 4], s1[8 * s + 5]); w1.w = pkbf(s1[8 * s + 6], s1[8 * s + 7]);
            pf[0][s] = __builtin_bit_cast(bf16x8, w0); pf[1][s] = __builtin_bit_cast(bf16x8, w1);
        }
#pragma unroll
        for (int d = 0; d < 4; ++d)
#pragma unroll
            for (int kt = 0; kt < 2; ++kt)
#pragma unroll
                for (int s = 0; s < 2; ++s) {
                    const LAS unsigned char* vp = vb + (vroff + 32 * d + r32) * C::VROWB + (32 * kt + 16 * s + 4 * hi) * 2;
                    const s16x4 lo = *(const LAS s16x4*)(vp), hh = *(const LAS s16x4*)(vp + 16);
                    const bf16x8 vf = (bf16x8){lo[0], lo[1], lo[2], lo[3], hh[0], hh[1], hh[2], hh[3]};
                    o[d] = __builtin_amdgcn_mfma_f32_32x32x16_bf16(vf, pf[kt][s], o[d], 0, 0, 0);
                }
        if (t + 1 < NT) ATT_STOREV((t + 1) & 1);
        __syncthreads();
    }
#undef ATT_LOADK
#undef ATT_LOADV
#undef ATT_STOREK
#undef ATT_STOREV
    const float linv = 1.0f / (lrun + __shfl_xor(lrun, 32));
#pragma unroll
    for (int d = 0; d < 4; ++d)
#pragma unroll
        for (int r = 0; r < 16; ++r) o[d][r] *= linv;
    if constexpr (DIFF) {
        LAS float* ex = (LAS float*)lds + (size_t)qsub * 64 * 64 + lane;
        if (role == 1) {
#pragma unroll
            for (int d = 0; d < 4; ++d)
#pragma unroll
                for (int r = 0; r < 16; ++r) ex[(d * 16 + r) * 64] = o[d][r];
        }
        __syncthreads();
        if (role == 0) {
            float ss = 0.f;
#pragma unroll
            for (int d = 0; d < 4; ++d)
#pragma unroll
                for (int r = 0; r < 16; ++r) { const float v = o[d][r] - lam * ex[(d * 16 + r) * 64]; o[d][r] = v; ss += v * v; }
            ss += __shfl_xor(ss, 32);
            const float rstd = outscale / sqrtf(ss * (1.f / 128.f) + EPS);
            bf16* op = P.O + (size_t)(qsub * 32 + r32) * P.ldo;
#pragma unroll
            for (int d = 0; d < 4; ++d)
#pragma unroll
                for (int rg = 0; rg < 4; ++rg) { const int dd = 32 * d + 8 * rg + 4 * hi; const f32x4 g = *(const f32x4*)(subg + dd);
                    u32x2 w; w.x = pkbf(o[d][4 * rg + 0] * rstd * g.x, o[d][4 * rg + 1] * rstd * g.y); w.y = pkbf(o[d][4 * rg + 2] * rstd * g.z, o[d][4 * rg + 3] * rstd * g.w);
                    *(GAS u32x2*)(op + dd) = w; }
        }
        __syncthreads();
    } else {
        bf16* op = P.O + (size_t)(qsub * 32 + r32) * P.ldo + role * 128;
#pragma unroll
        for (int d = 0; d < 4; ++d)
#pragma unroll
            for (int rg = 0; rg < 4; ++rg) { const int dd = 32 * d + 8 * rg + 4 * hi;
                u32x2 w; w.x = pkbf(o[d][4 * rg + 0], o[d][4 * rg + 1]); w.y = pkbf(o[d][4 * rg + 2], o[d][4 * rg + 3]);
                *(GAS u32x2*)(op + dd) = w; }
    }
}
template <bool DIFF> struct PA {
    static constexpr int TK = DIFF ? 64 : 32, NKT = TK / 32, NKS = DIFF ? 4 : 16, KW = DIFF ? 128 : 256, VR = DIFF ? 128 : 256;
    static constexpr int KROWB = KW * 2 + 16, VROWB = TK * 2 + 16, KB = TK * KROWB, VB = VR * VROWB, VOFF = 2 * KB, LDSB = 2 * KB + 3 * VB;
    static constexpr int KCH = KW / 8, VCH = TK / 8;
    static constexpr int NQK = NKS * NKT, NPV = 4 * NKT * 2, EPG = (16 * NKT) / NQK;
    static_assert(TK * KCH == 2 * NTHR && VR * VCH == 2 * NTHR, "two staging pieces per thread for K and for V");
};
#ifndef DTHR_VAL
#define DTHR_VAL 8.0f
#endif
constexpr float DTHR = DTHR_VAL;
__device__ __forceinline__ float half_swap_max(float m) {
    auto rr = __builtin_amdgcn_permlane32_swap(__float_as_uint(m), __float_as_uint(m), false, false);
    return fmaxf(__uint_as_float(rr[0]), __uint_as_float(rr[1]));
}
__device__ __forceinline__ float half_swap_sum(float m) {
    auto rr = __builtin_amdgcn_permlane32_swap(__float_as_uint(m), __float_as_uint(m), false, false);
    return __uint_as_float(rr[0]) + __uint_as_float(rr[1]);
}
__device__ __forceinline__ float max16(const f32x16& a) {
    float x = fmaxf(fmaxf(a[0], a[1]), a[2]), y = fmaxf(fmaxf(a[3], a[4]), a[5]);
    x = fmaxf(fmaxf(x, a[6]), a[7]); y = fmaxf(fmaxf(y, a[8]), a[9]); x = fmaxf(fmaxf(x, a[10]), a[11]); y = fmaxf(fmaxf(y, a[12]), a[13]); x = fmaxf(fmaxf(x, a[14]), a[15]);
    return fmaxf(x, y);
}
template <bool DIFF> __device__ __forceinline__ void pipe_attn_unit(const Frame& F, const AttnPtrs& P, float lam, float outscale, const float* subg) {
    typedef PA<DIFF> C;
    const int tid = F.tid, lane = F.lane, wid = F.wave, r32 = lane & 31, hi = lane >> 5, qsub = wid >> 1, role = wid & 1;
    LAS unsigned char* lds = F.lds;
    bf16x8 qf[C::NKS];
    { const bf16* qp = P.Q + (size_t)(qsub * 32 + r32) * P.ldq + (DIFF ? role * 64 : 0) + hi * 8;
#pragma unroll
      for (int ks = 0; ks < C::NKS; ++ks) qf[ks] = *(const GAS bf16x8*)(qp + ks * 16); }
    u32x4 kst[2], vst[2];
    const int NT = P.nkeys / C::TK;
    const int kkey0 = tid / C::KCH, kch = tid % C::KCH, vrow0 = tid / C::VCH, vch = tid % C::VCH;
    const bf16* kg = P.K + (size_t)kkey0 * P.ldk + kch * 8; const bf16* vg = P.VT + (size_t)vrow0 * P.ldv + vch * 8;
    const int kl = kkey0 * C::KROWB + kch * 16, vl = vrow0 * C::VROWB + (vch >> 1) * 32 + (vch & 1) * 8;
#define DA_LOADK(t) do { kst[0] = *(const GAS u32x4*)(kg + (size_t)(t) * C::TK * P.ldk); kst[1] = *(const GAS u32x4*)(kg + (size_t)((t) * C::TK + C::TK / 2) * P.ldk); } while (0)
#define DA_LOADV(t) do { vst[0] = *(const GAS u32x4*)(vg + (size_t)(t) * C::TK); vst[1] = *(const GAS u32x4*)(vg + (size_t)(C::VR / 2) * P.ldv + (size_t)(t) * C::TK); } while (0)
#define DA_STOREK(b) do { *(LAS u32x4*)(lds + (b) * C::KB + kl) = kst[0]; *(LAS u32x4*)(lds + (b) * C::KB + kl + (C::TK / 2) * C::KROWB) = kst[1]; } while (0)
#define DA_STOREV(off) do { LAS unsigned char* v_ = lds + (off) + vl; *(LAS u32x2*)(v_) = (u32x2){vst[0].x, vst[0].y}; *(LAS u32x2*)(v_ + 16) = (u32x2){vst[0].z, vst[0].w}; \
        *(LAS u32x2*)(v_ + (C::VR / 2) * C::VROWB) = (u32x2){vst[1].x, vst[1].y}; *(LAS u32x2*)(v_ + (C::VR / 2) * C::VROWB + 16) = (u32x2){vst[1].z, vst[1].w}; } while (0)
    const int koff = (DIFF ? role * 128 : 0) + hi * 16, vroff = DIFF ? 0 : role * 128;
    const f32x16 Z16 = (f32x16){0.f, 0.f, 0.f, 0.f, 0.f, 0.f, 0.f, 0.f, 0.f, 0.f, 0.f, 0.f, 0.f, 0.f, 0.f, 0.f};
    f32x16 o[4]; o[0] = Z16; o[1] = Z16; o[2] = Z16; o[3] = Z16;
    f32x16 A[C::NKT], B[C::NKT];
    float mref, lrun = 0.f;
#define DA_PIN(x) asm volatile("" : "+v"(x))
#define DA_SB() __builtin_amdgcn_sched_barrier(0)
#define DA_KFR(i) (*(const LAS bf16x8*)(kb_ + ((i) % C::NKT) * 32 * C::KROWB + ((i) / C::NKT) * 32))
#define DA_VOFS(i) ((32 * ((i) / (2 * C::NKT))) * C::VROWB + (32 * (((i) >> 1) % C::NKT) + 16 * ((i) & 1)) * 2)
#define DA_VFR(i) (*(const LAS bf16x8*)(vb_ + DA_VOFS(i)))
#define DA_PV(i) do { \
        o[(i) / (2 * C::NKT)] = __builtin_amdgcn_mfma_f32_32x32x16_bf16(vfr_[(i) % 3], __builtin_bit_cast(bf16x8, pw_[(((i) >> 1) % C::NKT) * 2 + ((i) & 1)]), o[(i) / (2 * C::NKT)], 0, 0, 0); } while (0)
#define DA_QK0(S, b) do { const LAS unsigned char* kb_ = lds + (b) * C::KB + r32 * C::KROWB + koff; \
        _Pragma("unroll") for (int i = 0; i < C::NQK; ++i) { const bf16x8 a_ = DA_KFR(i); \
            if (i < C::NKT) S[i % C::NKT] = __builtin_amdgcn_mfma_f32_32x32x16_bf16(a_, qf[i / C::NKT], Z16, 0, 0, 0); else S[i % C::NKT] = __builtin_amdgcn_mfma_f32_32x32x16_bf16(a_, qf[i / C::NKT], S[i % C::NKT], 0, 0, 0); } } while (0)
    DA_LOADK(0); DA_STOREK(0); DA_LOADV(0); DA_STOREV(C::VOFF);
    DA_LOADK(1);
    __syncthreads();
    DA_QK0(A, 0);
    DA_STOREK(1); DA_LOADV(1);
    { float mx = max16(A[0]); if (C::NKT == 2) mx = fmaxf(mx, max16(A[C::NKT - 1])); mref = half_swap_max(mx); }
#pragma unroll
    for (int kt = 0; kt < C::NKT; ++kt)
#pragma unroll
        for (int r = 0; r < 16; ++r) A[kt][r] = __builtin_amdgcn_exp2f(A[kt][r] - mref);
    DA_STOREV(C::VOFF + C::VB);
    DA_LOADK(2); DA_LOADV(2);
    __syncthreads();
    int vprev = 0, vcur = C::VB, vnext = 2 * C::VB;
#define DA_STEP(S, Pv, t, KBUF, PF, PF2) do { \
        if (PF) DA_STOREK(1 - (KBUF)); if (PF2) DA_LOADK((t) + 2); \
        const LAS unsigned char* kb_ = lds + (KBUF) * C::KB + r32 * C::KROWB + koff; \
        bf16x8 kf_[3]; kf_[0] = DA_KFR(0); kf_[1] = DA_KFR(1); \
        u32x4 pw_[2 * C::NKT]; float rs_ = 0.f; \
        DA_SB(); \
        _Pragma("unroll") for (int i = 0; i < C::NQK; ++i) { \
            if (i + 2 < C::NQK) kf_[(i + 2) % 3] = DA_KFR(i + 2); \
            if (i < C::NKT) S[i % C::NKT] = __builtin_amdgcn_mfma_f32_32x32x16_bf16(kf_[i % 3], qf[i / C::NKT], Z16, 0, 0, 0); \
            else S[i % C::NKT] = __builtin_amdgcn_mfma_f32_32x32x16_bf16(kf_[i % 3], qf[i / C::NKT], S[i % C::NKT], 0, 0, 0); \
              \
            _Pragma("unroll") for (int e = i * C::EPG; e < (i + 1) * C::EPG; ++e) { rs_ += Pv[e >> 4][e & 15]; \
                if (e & 1) { const int kt_ = e >> 4, r_ = e & 15; pw_[kt_ * 2 + (r_ >> 3)][(r_ & 7) >> 1] = pkbf(Pv[kt_][r_ - 1], Pv[kt_][r_]); } } \
            DA_PIN(rs_); if (((i + 1) * C::EPG) % 8 == 0 || C::EPG >= 2) DA_PIN(pw_[(((i + 1) * C::EPG - 1) >> 4) * 2 + ((((i + 1) * C::EPG - 1) & 15) >> 3)]); \
            DA_SB(); } \
        lrun += rs_; \
        if (PF) DA_STOREV(C::VOFF + vnext); if (PF2) DA_LOADV((t) + 2); \
        float mx_ = max16(S[0]); if (C::NKT == 2) mx_ = fmaxf(mx_, max16(S[C::NKT - 1])); mx_ = half_swap_max(mx_); \
        float dl_ = 0.f; bool resc_ = false; \
        if (__builtin_expect(__any(mx_ > mref + DTHR), 0)) { dl_ = fmaxf(mx_ - mref, 0.f); mref += dl_; resc_ = true; } \
        const LAS unsigned char* vb_ = lds + C::VOFF + vprev + (vroff + r32) * C::VROWB + hi * 16; \
        bf16x8 vfr_[3]; vfr_[0] = DA_VFR(0); vfr_[1] = DA_VFR(1); \
        DA_SB(); \
        _Pragma("unroll") for (int i = 0; i < C::NPV; ++i) { \
            if (i + 2 < C::NPV) vfr_[(i + 2) % 3] = DA_VFR(i + 2); \
            DA_PV(i); \
            { const int e0_ = 2 * i, e1_ = 2 * i + 1; S[e0_ >> 4][e0_ & 15] = __builtin_amdgcn_exp2f(S[e0_ >> 4][e0_ & 15] - mref); S[e1_ >> 4][e1_ & 15] = __builtin_amdgcn_exp2f(S[e1_ >> 4][e1_ & 15] - mref); } \
            DA_PIN(S[(2 * i) >> 4]); DA_SB(); } \
        if (resc_) { const float f_ = __builtin_amdgcn_exp2f(-dl_); lrun *= f_; \
            _Pragma("unroll") for (int d = 0; d < 4; ++d) _Pragma("unroll") for (int r = 0; r < 16; ++r) o[d][r] *= f_; } \
        __syncthreads(); \
        { const int tmp_ = vprev; vprev = vcur; vcur = vnext; vnext = tmp_; } \
    } while (0)
#pragma unroll 1
    for (int t = 1; t < NT - 3; t += 2) {
        DA_STEP(B, A, t, 1, true, true);
        DA_STEP(A, B, t + 1, 0, true, true);
    }
    DA_STEP(B, A, NT - 3, 1, true, true);
    DA_STEP(A, B, NT - 2, 0, true, false);
    DA_STEP(B, A, NT - 1, 1, false, false);
    {
        float rs_ = 0.f; u32x4 pw_[2 * C::NKT];
#pragma unroll
        for (int kt = 0; kt < C::NKT; ++kt) {
#pragma unroll
            for (int r = 0; r < 16; ++r) rs_ += B[kt][r];
#pragma unroll
            for (int s = 0; s < 2; ++s) { pw_[kt * 2 + s].x = pkbf(B[kt][8 * s + 0], B[kt][8 * s + 1]); pw_[kt * 2 + s].y = pkbf(B[kt][8 * s + 2], B[kt][8 * s + 3]); pw_[kt * 2 + s].z = pkbf(B[kt][8 * s + 4], B[kt][8 * s + 5]); pw_[kt * 2 + s].w = pkbf(B[kt][8 * s + 6], B[kt][8 * s + 7]); } }
        lrun += rs_;
        const LAS unsigned char* vb_ = lds + C::VOFF + vprev + (vroff + r32) * C::VROWB + hi * 16;
#pragma unroll
        for (int i = 0; i < C::NPV; ++i) { const bf16x8 vf_ = DA_VFR(i);
            o[i / (2 * C::NKT)] = __builtin_amdgcn_mfma_f32_32x32x16_bf16(vf_, __builtin_bit_cast(bf16x8, pw_[((i >> 1) % C::NKT) * 2 + (i & 1)]), o[i / (2 * C::NKT)], 0, 0, 0); }
    }
#undef DA_STEP
#undef DA_QK0
#undef DA_PIN
#undef DA_SB
#undef DA_KFR
#undef DA_VOFS
#undef DA_VFR
#undef DA_PV
#undef DA_LOADK
#undef DA_LOADV
#undef DA_STOREK
#undef DA_STOREV
    const float linv = 1.0f / half_swap_sum(lrun);
#pragma unroll
    for (int d = 0; d < 4; ++d)
#pragma unroll
        for (int r = 0; r < 16; ++r) o[d][r] *= linv;
    __syncthreads();
    if constexpr (DIFF) {
        LAS float* ex = (LAS float*)lds + (size_t)qsub * 64 * 64 + lane;
        if (role == 1) {
#pragma unroll
            for (int d = 0; d < 4; ++d)
#pragma unroll
                for (int r = 0; r < 16; ++r) ex[(d * 16 + r) * 64] = o[d][r];
        }
        __syncthreads();
        if (role == 0) {
            float ss = 0.f;
#pragma unroll
            for (int d = 0; d < 4; ++d)
#pragma unroll
                for (int r = 0; r < 16; ++r) { const float v = o[d][r] - lam * ex[(d * 16 + r) * 64]; o[d][r] = v; ss += v * v; }
            ss = half_swap_sum(ss);
            const float rstd = outscale / sqrtf(ss * (1.f / 128.f) + EPS);
            bf16* op = P.O + (size_t)(qsub * 32 + r32) * P.ldo;
#pragma unroll
            for (int d = 0; d < 4; ++d)
#pragma unroll
                for (int rg = 0; rg < 4; ++rg) { const int dd = 32 * d + 8 * rg + 4 * hi; const f32x4 g = *(const f32x4*)(subg + dd);
                    u32x2 w; w.x = pkbf(o[d][4 * rg + 0] * rstd * g.x, o[d][4 * rg + 1] * rstd * g.y); w.y = pkbf(o[d][4 * rg + 2] * rstd * g.z, o[d][4 * rg + 3] * rstd * g.w);
                    *(GAS u32x2*)(op + dd) = w; }
        }
        __syncthreads();
    } else {
        bf16* op = P.O + (size_t)(qsub * 32 + r32) * P.ldo + role * 128;
#pragma unroll
        for (int d = 0; d < 4; ++d)
#pragma unroll
            for (int rg = 0; rg < 4; ++rg) { const int dd = 32 * d + 8 * rg + 4 * hi;
                u32x2 w; w.x = pkbf(o[d][4 * rg + 0], o[d][4 * rg + 1]); w.y = pkbf(o[d][4 * rg + 2], o[d][4 * rg + 3]);
                *(GAS u32x2*)(op + dd) = w; }
    }
}
#ifndef MK_PER_STEP
#define MK_PER_STEP 0
#endif
#ifndef PH_MASK
#define PH_MASK 0x1fff
#endif
#ifndef DUP_MASK
#define DUP_MASK 0
#endif
#define REPS(k) ((((DUP_MASK) >> (k)) & 1) ? 2 : 1)
#ifndef SITE_MASK
#define SITE_MASK 7
#endif
#define PFRAME() Frame P = F; { int t_ = F.tid; asm volatile("" : "+v"(t_)); P.tid = t_; P.lane = t_ & 63; P.wave = __builtin_amdgcn_readfirstlane(t_ >> 6); int z_ = 0; asm volatile("" : "+s"(z_)); P.zs = z_; } \
    const int gw = P.vcu * NWAVES + P.wave, NGW = P.G * NWAVES; (void)gw; (void)NGW; unsigned char* const ws = AWS(args, P.zs); (void)ws
#define WSP(off) ((bf16*)(ws + (off)))
#define P_WL()  (WSP(WS_W) + (size_t)l * WL_STRIDE)
#define P_HN()  WSP(WS_HN)
#define P_QK()  WSP(WS_QK)
#define P_VHT() WSP(WS_VHT)
#define P_MIX() WSP(WS_MIX)
#define P_MO()  WSP(WS_QK)
#define P_XO()  WSP(WS_QK)
#define P_HID() WSP(WS_QK)
#define P_QX()  WSP(WS_VHT)
#define P_OX()  (WSP(WS_VHT) + (size_t)TOK * 1024)
#define P_FO()  WSP(WS_MIX)
#define P_MN()  WSP(WS_MN)
#define P_KX()  WSP(WS_KX)
#define P_VXT() WSP(WS_VXT)
#define P_XRES() (AOUT(args, P.zs) + (size_t)g * TOK * DM)
#define P_RS() ((float*)(ws + WS_RS))

__global__ void __launch_bounds__(NTHR, 2) hymba_fwd(Args args) {
    extern __shared__ __attribute__((aligned(16))) unsigned char lds_raw[];
    Frame F;
    F.lds = (LAS unsigned char*)lds_raw;
    F.tid = threadIdx.x; F.lane = F.tid & 63; F.wave = __builtin_amdgcn_readfirstlane(F.tid >> 6); F.zs = 0;
    F.G = gridDim.x; { const int bx = blockIdx.x; F.vcu = (F.G % 8 == 0) ? (bx % 8) * (F.G / 8) + bx / 8 : bx; }
    volatile LAS unsigned* MISC = (volatile LAS unsigned*)(F.lds + LDS_MISC);
    if (F.tid < 64) MISC[F.tid] = 0u;
    __syncthreads();
    XcdBarrier bar = xcd_barrier_post((unsigned*)(AWS(args, 0) + WS_CTL) + 1024 + (size_t)args.li * XCD_BAR_WORDS, MISC);
    const int s_lo = args.s_lo, s_hi = args.s_hi;
#define RUNK(s, k) ((((PH_MASK) >> (k)) & 1) && s_lo <= (s) && (s) < s_hi)
#ifndef GEMM_ALIGN
#define GEMM_ALIGN true
#endif
#ifndef GEMM_SP2
#define GEMM_SP2 true
#endif
#ifndef SEAM_REPS
#define SEAM_REPS 1
#endif
#define SEAM(s) do { if ((s) + 1 < s_hi) { for (int sr_ = 0; sr_ < SEAM_REPS; ++sr_) xcd_barrier(bar); } } while (0)

    if (RUNK(0, 0)) { _Pragma("unroll 1") for (int rep_ = 0; rep_ < REPS(0); ++rep_) { PFRAME(); phase_prologue(P, args); } SEAM(0); }

#pragma unroll 1
    for (int g = 0; g < 2; ++g) {
#pragma unroll 1
        for (int l = 0; l <= DEPTH; ++l) {
            const int sb = 1 + g * 49 + l * 12;
            const int L = grpL(g), NB = grpB(g), MG = grpMem(g);
            if (RUNK(sb + 0, 1)) {
                _Pragma("unroll 1") for (int rep_ = 0; rep_ < REPS(1); ++rep_) {
                { PFRAME();
                bf16* XB = P_HN(); float* RS = P_RS(); const float* gpost = AIN(args, 31, P.zs) + (size_t)(l > 0 ? l - 1 : 0) * DM;
#ifndef SKIP_ROWOPA
                if (l == 0) { const float* xi = AIN(args, g, P.zs); for (int m = gw; m < TOK; m += 4 * NGW) rowop_bf<0, 4>(xi, XB, nullptr, nullptr, RS, nullptr, m, NGW, P.lane); }
                else if (l < DEPTH) { const bf16* FO = P_FO(); for (int m = gw; m < TOK; m += 8 * NGW) rowop_bf<1, 8>(nullptr, XB, FO, gpost, RS, nullptr, m, NGW, P.lane); }
                else { const bf16* FO = P_FO(); float* xres = P_XRES(); for (int m = gw; m < TOK; m += 8 * NGW) rowop_bf<2, 8>(nullptr, XB, FO, gpost, nullptr, xres, m, NGW, P.lane); }
#endif
                if (l < DEPTH) {
                    const float* gm = AIN(args, 25, P.zs) + (size_t)l * DM; const float* memin = AIN(args, 2 + g, P.zs); bf16* MN = P_MN();
                    for (int m = gw; m < MG; m += NGW) rowop_rows<1>(memin, nullptr, nullptr, nullptr, gm, MN, m, 0, P.lane);
                    const int nit = (L / 64) * 4;
                    _Pragma("unroll 1") for (int r2_ = 0; r2_ < REPS(14); ++r2_)
                    for (int it = P.vcu; it < nit; it += P.G) filt_f1_item(P, args, l, L, it);
                } }
                }
                SEAM(sb + 0);
            }
            if (l == DEPTH) continue;
            if (RUNK(sb + 1, 2)) {
                _Pragma("unroll 1") for (int rep_ = 0; rep_ < REPS(2); ++rep_) {
                { PFRAME(); pg8::Gemm gq{P_HN(), P_WL() + WL_IN, TOK, 1024, 1024}; pg8::StaticOrder S; S.init(TOK, 1024, P.G, (int)blockIdx.x);
                  pg8::EpiRopeQK E{P_QK(), (const float*)(ws + WS_TAB), L - 1, 0.125f * LOG2E, P_RS()};
                  pg8::gemm_phase<pg8::EpiRopeQK, pg8::StaticOrder, GEMM_ALIGN, GEMM_SP2>(P.lds, gq, S, E); }
                { PFRAME(); pg8::Gemm gv{P_WL() + WL_IN + (size_t)1024 * 1024, P_HN(), 2048, TOK, 1024}; pg8::StaticOrder S; S.init(2048, TOK, P.G, (int)blockIdx.x);
                  pg8::EpiBf16 E{P_VHT(), TOK, 1.f, nullptr, P_RS()};
                  pg8::gemm_phase<pg8::EpiBf16, pg8::StaticOrder, GEMM_ALIGN, GEMM_SP2>(P.lds, gv, S, E); }
                __syncthreads();
                _Pragma("unroll 1") for (int r2_ = 0; r2_ < REPS(15); ++r2_)
                { PFRAME();
                if (g == 0) { for (int c = P.vcu; c < 512; c += P.G) filt_f2_item<12>(P, args, l, c); }
                else        { for (int c = P.vcu; c < 512; c += P.G) filt_f2_item<14>(P, args, l, c); } }
                }
                SEAM(sb + 1);
            }
            if (RUNK(sb + 2, 3)) {
                _Pragma("unroll 1") for (int rep_ = 0; rep_ < REPS(3); ++rep_) {
                { PFRAME();
                float lam, lam_init;
                { const float p1 = AIN(args, 7, P.zs)[l * 64 + P.lane] * AIN(args, 8, P.zs)[l * 64 + P.lane]; const float p2 = AIN(args, 9, P.zs)[l * 64 + P.lane] * AIN(args, 10, P.zs)[l * 64 + P.lane];
                  lam_init = 0.8f - 0.6f * expf(-0.3f * (float)l); lam = expf(wave_sum(p1)) - expf(wave_sum(p2)) + lam_init; }
                const int nqb = L / 128, nun = NB * 4 * nqb; bf16* QK = P_QK(); bf16* VHT = P_VHT(); bf16* MIX = P_MIX(); const float* sg = AIN(args, 11, P.zs) + l * 128;
#pragma unroll 1
                for (int u = P.vcu; u < nun; u += P.G) {
                    const int qb = u % nqb, bh = u / nqb, h = bh & 3, b = bh >> 2; const size_t t0 = (size_t)b * L;
                    AttnPtrs A; A.Q = QK + (t0 + (size_t)qb * 128) * 1024 + h * 128; A.ldq = 1024;
                    A.K = QK + t0 * 1024 + 512 + h * 128; A.ldk = 1024; A.VT = VHT + (size_t)(h * 128) * TOK + t0; A.ldv = TOK; A.nkeys = L;
                    A.O = MIX + (t0 + (size_t)qb * 128) * 1024 + h * 128; A.ldo = 1024;
#ifndef SKIP_DATTN
                    pipe_attn_unit<true>(P, A, lam, 1.f - lam_init, sg);
#endif
                } } }
                __syncthreads();
                _Pragma("unroll 1") for (int rep_ = 0; rep_ < REPS(13); ++rep_) {
                { PFRAME();
                if (g == 0) { for (int u = P.vcu; u < 512 * 4; u += P.G) hyena_unit<12, 4>(P, args, l, u >> 2, (u & 3) * 4); }
                else        { for (int u = P.vcu; u < 512 * 4; u += P.G) hyena_unit<14, 1>(P, args, l, u >> 2, u & 3); } }
                }
                SEAM(sb + 2);
            }
            if (RUNK(sb + 3, 4)) {
                _Pragma("unroll 1") for (int rep_ = 0; rep_ < REPS(4); ++rep_) { { PFRAME(); for (int t = P.vcu; t < 8 * (TOK / 64); t += P.G) ytrans_tile(P, args, t); } }
                SEAM(sb + 3); }
            if (RUNK(sb + 4, 5)) {
                _Pragma("unroll 1") for (int rep_ = 0; rep_ < REPS(5); ++rep_) {
                { PFRAME(); pg8::Gemm gm{P_MIX(), P_WL() + WL_OUT, TOK, 1024, 1024}; pg8::StaticOrder S; S.init(TOK, 1024, P.G, (int)blockIdx.x);
                  pg8::EpiBf16 E{P_MO(), 1024, 1.f, nullptr, nullptr};
                  pg8::gemm_phase<pg8::EpiBf16, pg8::StaticOrder, GEMM_ALIGN, GEMM_SP2>(P.lds, gm, S, E); }
                }
                SEAM(sb + 4);
            }
            if (RUNK(sb + 5, 6)) {
                _Pragma("unroll 1") for (int rep_ = 0; rep_ < REPS(6); ++rep_) {
                { PFRAME();
                bf16* XB = P_HN(); float* RS = P_RS(); const bf16* MO = P_MO(); const float* gpost = AIN(args, 5, P.zs) + (size_t)l * DM;
                if (rep_ == 0) for (int m = gw; m < TOK; m += 8 * NGW) rowop_bf<1, 8>(nullptr, XB, MO, gpost, RS, nullptr, m, NGW, P.lane);
                else for (int m = gw; m < TOK; m += 8 * NGW) rowop_bf<1, 8>(nullptr, XB, MO, gpost, (float*)(ws + WS_MIX), nullptr, m, NGW, P.lane, WSP(WS_VHT)); }
                }
                SEAM(sb + 5);
            }
            if (RUNK(sb + 6, 7)) {
                _Pragma("unroll 1") for (int rep_ = 0; rep_ < REPS(7); ++rep_) {
                if (SITE_MASK & 1) { PFRAME(); pg8::Gemm gq{P_HN(), P_WL() + WL_Q, TOK, 1024, 1024}; pg8::StaticOrder S; S.init(TOK, 1024, P.G, (int)blockIdx.x);
                  pg8::EpiBf16 E{P_QX(), 1024, 0.0625f * LOG2E, P_RS(), nullptr};
                  pg8::gemm_phase<pg8::EpiBf16, pg8::StaticOrder, GEMM_ALIGN, GEMM_SP2>(P.lds, gq, S, E); }
                if (SITE_MASK & 2) { PFRAME(); pg8::Gemm gk{P_MN(), P_WL() + WL_K, MG, 1024, 1024}; pg8::StaticOrder S; S.init(MG, 1024, P.G, (int)blockIdx.x);
                  pg8::EpiBf16 E{P_KX(), 1024, 1.f, nullptr, nullptr};
                  pg8::gemm_phase<pg8::EpiBf16, pg8::StaticOrder, GEMM_ALIGN, GEMM_SP2>(P.lds, gk, S, E); }
                if (SITE_MASK & 4) { PFRAME(); pg8::Gemm gv{P_WL() + WL_V, P_MN(), 1024, MG, 1024}; pg8::StaticOrder S; S.init(1024, MG, P.G, (int)((blockIdx.x + P.G / 2) % P.G));
                  pg8::EpiBf16 E{P_VXT(), MG, 1.f, nullptr, nullptr};
                  pg8::gemm_phase<pg8::EpiBf16, pg8::StaticOrder, GEMM_ALIGN, GEMM_SP2>(P.lds, gv, S, E); }
                }
                SEAM(sb + 6);
            }
            if (RUNK(sb + 7, 8)) {
                _Pragma("unroll 1") for (int rep_ = 0; rep_ < REPS(8); ++rep_) {
                { PFRAME();
                const int nqb = L / 128, nun = NB * 4 * nqb; bf16* QX = P_QX(); bf16* KX = P_KX(); bf16* VXT = P_VXT(); bf16* OX = P_OX();
#pragma unroll 1
                for (int u = P.vcu; u < nun; u += P.G) {
                    const int qb = u % nqb, bh = u / nqb, h = bh & 3, b = bh >> 2; const size_t t0 = (size_t)b * L;
                    AttnPtrs A; A.Q = QX + (t0 + (size_t)qb * 128) * 1024 + h * 256; A.ldq = 1024;
                    A.K = KX + (size_t)(b * NMEMK) * 1024 + h * 256; A.ldk = 1024; A.VT = VXT + (size_t)(h * 256) * MG + (size_t)b * NMEMK; A.ldv = MG; A.nkeys = NMEMK;
                    A.O = OX + (t0 + (size_t)qb * 128) * 1024 + h * 256; A.ldo = 1024;
                    pipe_attn_unit<false>(P, A, 0.f, 1.f, nullptr);
                } }
                }
                SEAM(sb + 7);
            }
            if (RUNK(sb + 8, 9)) {
                _Pragma("unroll 1") for (int rep_ = 0; rep_ < REPS(9); ++rep_) {
                { PFRAME(); pg8::Gemm gm{P_OX(), P_WL() + WL_O, TOK, 1024, 1024}; pg8::StaticOrder S; S.init(TOK, 1024, P.G, (int)blockIdx.x);
                  pg8::EpiBf16 E{P_XO(), 1024, 1.f, nullptr, nullptr};
                  pg8::gemm_phase<pg8::EpiBf16, pg8::StaticOrder, GEMM_ALIGN, GEMM_SP2>(P.lds, gm, S, E); }
                }
                SEAM(sb + 8);
            }
            if (RUNK(sb + 9, 10)) {
                _Pragma("unroll 1") for (int rep_ = 0; rep_ < REPS(10); ++rep_) {
                { PFRAME();
                bf16* XB = P_HN(); float* RS = P_RS(); const bf16* XO = P_XO(); const float* gpost = AIN(args, 24, P.zs) + (size_t)l * DM;
                if (rep_ == 0) for (int m = gw; m < TOK; m += 8 * NGW) rowop_bf<1, 8>(nullptr, XB, XO, gpost, RS, nullptr, m, NGW, P.lane);
                else for (int m = gw; m < TOK; m += 8 * NGW) rowop_bf<1, 8>(nullptr, XB, XO, gpost, (float*)(ws + WS_MIX), nullptr, m, NGW, P.lane, WSP(WS_VHT)); }
                }
                SEAM(sb + 9);
            }
            if (RUNK(sb + 10, 11)) {
                _Pragma("unroll 1") for (int rep_ = 0; rep_ < REPS(11); ++rep_) {
#ifdef PANEL_GU
                { PFRAME(); pg8::Gemm gm{P_HN(), P_WL() + WL_GU, TOK, 2 * DFF, 1024}; pg8::PanelOrder S; S.init(TOK, 2 * DFF, P.G, P.vcu, false);
                  pg8::EpiSwiGLU E{P_HID(), DFF, P_RS()};
                  pg8::gemm_phase<pg8::EpiSwiGLU, pg8::PanelOrder, true, true>(P.lds, gm, S, E); }
#else
                { PFRAME(); pg8::Gemm gm{P_HN(), P_WL() + WL_GU, TOK, 2 * DFF, 1024}; pg8::StaticOrder S; S.init(TOK, 2 * DFF, P.G, (int)blockIdx.x);
                  pg8::EpiSwiGLU E{P_HID(), DFF, P_RS()};
                  pg8::gemm_phase<pg8::EpiSwiGLU, pg8::StaticOrder, GEMM_ALIGN, GEMM_SP2>(P.lds, gm, S, E); }
#endif
                }
                SEAM(sb + 10);
            }
            if (RUNK(sb + 11, 12)) {
                _Pragma("unroll 1") for (int rep_ = 0; rep_ < REPS(12); ++rep_) {
                { PFRAME(); pg8::Gemm gm{P_HID(), P_WL() + WL_D, TOK, 1024, DFF}; pg8::StaticOrder S; S.init(TOK, 1024, P.G, (int)blockIdx.x);
                  pg8::EpiBf16 E{P_FO(), 1024, 1.f, nullptr, nullptr};
                  pg8::gemm_phase<pg8::EpiBf16, pg8::StaticOrder, GEMM_ALIGN, GEMM_SP2>(P.lds, gm, S, E); }
                }
                SEAM(sb + 11);
            }
        }
    }
#undef RUNK
#undef SEAM
}

extern "C" void kernel_launch(void* const* d_in, const int* in_sizes, int n_in, void* d_out, int out_size, void* d_ws, size_t ws_size, hipStream_t stream) {
    static int grid = 0;
    if (grid == 0) {
        if (n_in != 35 || out_size != 2 * TOK * DM || ws_size < WS_END) { fprintf(stderr, "kernel_launch: unexpected shapes (n_in %d out %d ws %zu)\n", n_in, out_size, ws_size); grid = -1; return; }
        int dev = 0, cus = 0, per_cu = 0;
        if (hipGetDevice(&dev) != hipSuccess || hipDeviceGetAttribute(&cus, hipDeviceAttributeMultiprocessorCount, dev) != hipSuccess) { grid = -1; return; }
        if (hipFuncSetAttribute((const void*)hymba_fwd, hipFuncAttributeMaxDynamicSharedMemorySize, LDS_BYTES) != hipSuccess) { fprintf(stderr, "kernel_launch: hipFuncSetAttribute failed\n"); grid = -1; return; }
        if (hipOccupancyMaxActiveBlocksPerMultiprocessor(&per_cu, (const void*)hymba_fwd, NTHR, LDS_BYTES) != hipSuccess || per_cu < 1) { fprintf(stderr, "kernel_launch: occupancy query reports %d\n", per_cu); per_cu = 1; }
        (void)hipGetLastError();
        grid = cus;
    }
    if (grid < 0) return;
    (void)hipMemsetAsync((char*)d_ws + WS_CTL, 0, CTL_ZERO_BYTES, stream);
    Args a{};
    for (int i = 0; i < 35; ++i) a.p[i] = d_in[i];
    a.p[35] = d_out; a.p[36] = d_ws; a.pad = 0;
#if MK_PER_STEP
    for (int s = 0; s < N_STEPS; ++s) { a.s_lo = s; a.s_hi = s + 1; a.li = 0; hipLaunchKernelGGL(hymba_fwd, dim3(grid), dim3(NTHR), LDS_BYTES, stream, a); }
#else
    a.s_lo = 0; a.s_hi = N_STEPS; a.li = 0;
    hipLaunchKernelGGL(hymba_fwd, dim3(grid), dim3(NTHR), LDS_BYTES, stream, a);
#endif
}
```

```cpp
#include <hip/hip_runtime.h>
#include <cstdio>
#include <cstdint>
#define MK_PER_STEP 0
namespace pg8 {
#define PG8_LAS __attribute__((address_space(3)))
typedef unsigned short bf16_t;
typedef short bf16x8 __attribute__((ext_vector_type(8)));
typedef float f32x4 __attribute__((ext_vector_type(4)));
typedef unsigned u32x4 __attribute__((ext_vector_type(4)));
constexpr int BM = 256, BK = 64, HALF = 128, HTB = HALF * BK * 2  , STAGE_BYTES = 8 * HTB, NXCD = 8, WGM = 8;

__host__ __device__ __forceinline__ int lds_byte(int r, int c) { const int st = (r >> 4) * 2 + (c >> 5), rr = r & 15, cc = c & 31, ob = rr * 64 + cc * 2; return st * 1024 + (ob ^ (((ob >> 9) & 1) << 5)); }
__host__ __device__ __forceinline__ void stage_rc(int b, int& R, int& C) { const int st = b / 1024, sb = b % 1024, swz = sb ^ (((sb >> 9) & 1) << 5); R = (st >> 1) * 16 + swz / 64; C = (st & 1) * 32 + (swz % 64) / 2; }
__host__ __device__ __forceinline__ int perm32(int rho) { const int n = rho >> 4, i = rho & 15; return 8 * (i >> 2) + 4 * n + (i & 3); }

struct Unit { int pm, pn; };
struct Gemm { const bf16_t* A; const bf16_t* Bt; int M, N, K; };

struct StaticOrder {
    int nM, nN, nwg, G, c;
    __host__ __device__ void init(int M, int N, int G_, int c_) { nM = M / BM; nN = N / BM; nwg = nM * nN; G = G_; c = c_; }
    __host__ __device__ bool next(int i, Unit& u) const {
        const long L = (long)i * G + c; if (L >= nwg) return false;
        int wgid = (int)L; { const int q = nwg / NXCD, r = nwg % NXCD, xcd = wgid % NXCD, off = wgid / NXCD; wgid = (xcd < r ? xcd * (q + 1) : r * (q + 1) + (xcd - r) * q) + off; }
        const int nig = WGM * nN, gid = wgid / nig, fm = gid * WGM, gsz = (nM - fm) < WGM ? (nM - fm) : WGM;
        u.pm = fm + ((wgid % nig) % gsz); u.pn = (wgid % nig) / gsz; return true;
    }
    __device__ __forceinline__ void a_ready(const Unit&) const {}
    __device__ __forceinline__ void done(const Unit&) const {}
};
struct PanelOrder {
    int nM, nN, G, c; bool tr;
    __host__ __device__ void init(int M, int N, int G_, int c_, bool tr_) { nM = M / BM; nN = N / BM; G = G_; c = c_; tr = tr_; }
    __host__ __device__ bool next(int i, Unit& u) const {
        const int per = tr ? nM : nN, np = tr ? nN : nM; const int pi = i / per, ti = i % per; const int p = c + pi * G; if (p >= np) return false;
        if (tr) { u.pm = ti; u.pn = p; } else { u.pm = p; u.pn = ti; } return true;
    }
    __device__ __forceinline__ void a_ready(const Unit&) const {}
    __device__ __forceinline__ void done(const Unit&) const {}
};
typedef unsigned u32x2 __attribute__((ext_vector_type(2)));
__device__ __forceinline__ unsigned cvt_pk_bf16(float lo, float hi) { unsigned r; asm volatile("v_cvt_pk_bf16_f32 %0, %1, %2" : "=v"(r) : "v"(lo), "v"(hi)); return r; }

struct EpiBf16 {
    static constexpr bool PERM = true, AFTER_DRAIN = false;
    bf16_t* O; int ldc; float scale; const float* rowscale; const float* colscale;
    __device__ __forceinline__ void operator()(const f32x4 (&acc)[2][2][4][2], const Unit& u, int wr, int wc, int fr, int fq) const {
        const int row0 = u.pm * BM + wr * 64 + fr; const int col0 = u.pn * BM + wc * 32 + 8 * fq;
        f32x4 cs[2][2];
#pragma unroll
        for (int bj = 0; bj < 2; ++bj) { if (colscale) { cs[bj][0] = *(const f32x4*)(colscale + col0 + bj * HALF); cs[bj][1] = *(const f32x4*)(colscale + col0 + bj * HALF + 4); }
            else { cs[bj][0] = (f32x4){1.f, 1.f, 1.f, 1.f}; cs[bj][1] = cs[bj][0]; } }
        float rsv[2][4];
#pragma unroll
        for (int ai = 0; ai < 2; ++ai)
#pragma unroll
            for (int m = 0; m < 4; ++m) rsv[ai][m] = rowscale ? scale * rowscale[row0 + ai * HALF + m * 16] : scale;
#pragma unroll
        for (int ai = 0; ai < 2; ++ai)
#pragma unroll
            for (int m = 0; m < 4; ++m) { const int row = row0 + ai * HALF + m * 16; bf16_t* rowp = O + (size_t)row * ldc + col0; const float sc = rsv[ai][m];
#pragma unroll
                for (int bj = 0; bj < 2; ++bj) { const f32x4 v0 = acc[ai][bj][m][0] * cs[bj][0] * sc, v1 = acc[ai][bj][m][1] * cs[bj][1] * sc;
                    u32x4 w; w.x = cvt_pk_bf16(v0[0], v0[1]); w.y = cvt_pk_bf16(v0[2], v0[3]); w.z = cvt_pk_bf16(v1[0], v1[1]); w.w = cvt_pk_bf16(v1[2], v1[3]);
                    *(u32x4*)(rowp + bj * HALF) = w; } }
    }
};
struct EpiRopeQK {
    static constexpr bool PERM = true, AFTER_DRAIN = false;
    bf16_t* O; const float* tab; int lmask; float qscale; const float* rowscale;
    __device__ __forceinline__ void operator()(const f32x4 (&acc)[2][2][4][2], const Unit& u, int wr, int wc, int fr, int fq) const {
        const int row0 = u.pm * BM + wr * 64 + fr; const int col0 = u.pn * BM + wc * 32 + 8 * fq;
        const float sc0 = (u.pn < 2) ? qscale : 1.f;
        const bool ropew = (wc & 1) == 0;
        float scv[2][4];
#pragma unroll
        for (int ai = 0; ai < 2; ++ai)
#pragma unroll
            for (int m = 0; m < 4; ++m) scv[ai][m] = sc0 * rowscale[row0 + ai * HALF + m * 16];
#pragma unroll
        for (int ai = 0; ai < 2; ++ai)
#pragma unroll
          for (int mh = 0; mh < 2; ++mh) {
            f32x4 c0v[2], c1v[2], s0v[2], s1v[2];
#pragma unroll
            for (int mm = 0; mm < 2; ++mm) { const int row = row0 + ai * HALF + (2 * mh + mm) * 16;
                c0v[mm] = (f32x4){1.f, 1.f, 1.f, 1.f}; c1v[mm] = c0v[mm]; s0v[mm] = (f32x4){0.f, 0.f, 0.f, 0.f}; s1v[mm] = s0v[mm];
                if (ropew) { const float* tp = tab + (size_t)(row & lmask) * 16; c0v[mm] = *(const f32x4*)(tp); c1v[mm] = *(const f32x4*)(tp + 4); s0v[mm] = *(const f32x4*)(tp + 8); s1v[mm] = *(const f32x4*)(tp + 12); } }
#pragma unroll
            for (int mm = 0; mm < 2; ++mm) { const int m = 2 * mh + mm; const int row = row0 + ai * HALF + m * 16; bf16_t* rowp = O + (size_t)row * 1024 + col0; const float sc = scv[ai][m];
                f32x4 c0 = c0v[mm], c1 = c1v[mm], s0 = s0v[mm], s1 = s1v[mm];
                if (ropew) {
                    if (fq == 1) { s0 = -s0; s1 = -s1; }
                    if (fq >= 2) { s0 = (f32x4){0.f, 0.f, 0.f, 0.f}; s1 = s0; c0 = (f32x4){1.f, 1.f, 1.f, 1.f}; c1 = c0; } }
#pragma unroll
                for (int bj = 0; bj < 2; ++bj) { f32x4 v0 = acc[ai][bj][m][0], v1 = acc[ai][bj][m][1];
                    if (ropew) { f32x4 p0, p1;
#pragma unroll
                        for (int j = 0; j < 4; ++j) { p0[j] = __shfl_xor(v0[j], 16); p1[j] = __shfl_xor(v1[j], 16); }
                        v0 = v0 * c0 - p0 * s0; v1 = v1 * c1 - p1 * s1; }
                    v0 = v0 * sc; v1 = v1 * sc;
                    u32x4 w; w.x = cvt_pk_bf16(v0[0], v0[1]); w.y = cvt_pk_bf16(v0[2], v0[3]); w.z = cvt_pk_bf16(v1[0], v1[1]); w.w = cvt_pk_bf16(v1[2], v1[3]);
                    *(u32x4*)(rowp + bj * HALF) = w; } }
          }
    }
};
struct EpiSwiGLU {
    static constexpr bool PERM = true, AFTER_DRAIN = false;
    bf16_t* O; int ldc; const float* rowscale;
    __device__ __forceinline__ void operator()(const f32x4 (&acc)[2][2][4][2], const Unit& u, int wr, int wc, int fr, int fq) const {
        const int row0 = u.pm * BM + wr * 64 + fr; const int col0 = (u.pn * BM + wc * 32 + 8 * fq) >> 1;
        float rsv[2][4];
#pragma unroll
        for (int ai = 0; ai < 2; ++ai)
#pragma unroll
            for (int m = 0; m < 4; ++m) rsv[ai][m] = rowscale[row0 + ai * HALF + m * 16];
#pragma unroll
        for (int ai = 0; ai < 2; ++ai)
#pragma unroll
            for (int m = 0; m < 4; ++m) { const int row = row0 + ai * HALF + m * 16; bf16_t* rowp = O + (size_t)row * ldc + col0; const float rsc = rsv[ai][m];
#pragma unroll
                for (int bj = 0; bj < 2; ++bj) { const f32x4 g = acc[ai][bj][m][0] * rsc, up = acc[ai][bj][m][1] * rsc; f32x4 h;
#pragma unroll
                    for (int j = 0; j < 4; ++j) { const float e = __builtin_amdgcn_exp2f(-g[j] * 1.4426950408889634f); h[j] = g[j] * __builtin_amdgcn_rcpf(1.f + e) * up[j]; }
                    u32x2 w; w.x = cvt_pk_bf16(h[0], h[1]); w.y = cvt_pk_bf16(h[2], h[3]);
                    *(u32x2*)(rowp + bj * (HALF / 2)) = w; } }
    }
};
template <class Epi, class Sched, bool ALIGN_EPI = false, bool SP2 = false>
__device__ __forceinline__ void gemm_phase(PG8_LAS unsigned char* lds, const Gemm g, const Sched& S, const Epi& E) {
    int tid_l = threadIdx.x; asm volatile("" : "+v"(tid_l));
    const int tid = tid_l, wid = __builtin_amdgcn_readfirstlane(tid >> 6), lane = tid & 63, wr = wid >> 2, wc = wid & 3, fr = lane & 15, fq = lane >> 4;
    const int K = g.K, nt = K / BK;
    unsigned voffA[2], voffB[2];
#pragma unroll
    for (int i = 0; i < 2; ++i) { int R, C; stage_rc(tid * 16 + i * 8192, R, C); const int Rb = Epi::PERM ? ((R & ~31) + perm32(R & 31)) : R;
        voffA[i] = (unsigned)(R * K + C) * 2u; voffB[i] = (unsigned)(Rb * K + C) * 2u; }
    const size_t kstep = (size_t)(BK * 2);
    const size_t hstep = (size_t)HALF * K * 2;
    const size_t tstep = 2 * hstep;
    const unsigned ldsw = (unsigned)wid * 1024u;
    const int aoff = lds_byte(wr * 64 + fr, fq * 8), boff = lds_byte(wc * 32 + fr, fq * 8);
#define PG8_SA(b, h) (((b) * 2 + (h)) * HTB)
#define PG8_SB(b, h) ((4 + (b) * 2 + (h)) * HTB)
#define PG8_STAGE(bufoff, gbase, voff) do { _Pragma("unroll") for (int _i = 0; _i < 2; ++_i) \
        __builtin_amdgcn_global_load_lds((const unsigned*)((const char*)(gbase) + (voff)[_i]), (PG8_LAS unsigned*)(lds + (bufoff) + ldsw + _i * 8192), 16, 0, 0); } while (0)
#define PG8_LDA(dst, b, h) do { _Pragma("unroll") for (int m = 0; m < 4; ++m) _Pragma("unroll") for (int k = 0; k < 2; ++k) dst[m][k] = *(const PG8_LAS bf16x8*)(lds + PG8_SA(b, h) + aoff + m * 2048 + k * 1024); } while (0)
#define PG8_LDB(dst, b, h) do { _Pragma("unroll") for (int n = 0; n < 2; ++n) _Pragma("unroll") for (int k = 0; k < 2; ++k) dst[n][k] = *(const PG8_LAS bf16x8*)(lds + PG8_SB(b, h) + boff + n * 2048 + k * 1024); } while (0)
#define PG8_MMA(ai, bj, At, Bt) do { __builtin_amdgcn_s_setprio(1); _Pragma("unroll") for (int m = 0; m < 4; ++m) _Pragma("unroll") for (int n = 0; n < 2; ++n) _Pragma("unroll") for (int k = 0; k < 2; ++k) \
        acc[ai][bj][m][n] = __builtin_amdgcn_mfma_f32_16x16x32_bf16(Bt[n][k], At[m][k], acc[ai][bj][m][n], 0, 0, 0); __builtin_amdgcn_s_setprio(0); } while (0)
#define PG8_WAIT_V(n) asm volatile("s_waitcnt vmcnt(" #n ")" ::: "memory")
#define PG8_WAIT_L(n) asm volatile("s_waitcnt lgkmcnt(" #n ")" ::: "memory")
#define PG8_BAR __builtin_amdgcn_s_barrier()
#define PG8_SCHED __builtin_amdgcn_sched_barrier(0)
    Unit cur, nxt; int ui = 0;
    if (!S.next(0, cur)) return;
    f32x4 acc[2][2][4][2];
#pragma unroll
    for (int a = 0; a < 2; ++a)
#pragma unroll
        for (int b = 0; b < 2; ++b)
#pragma unroll
            for (int m = 0; m < 4; ++m)
#pragma unroll
                for (int n = 0; n < 2; ++n) acc[a][b][m][n] = (f32x4){0.f, 0.f, 0.f, 0.f};
    bf16x8 At[4][2], B0[2][2], B1[2][2];
    const char* cA = (const char*)g.A + (size_t)cur.pm * tstep; const char* cB = (const char*)g.Bt + (size_t)cur.pn * tstep;
    S.a_ready(cur);
    if constexpr (SP2) {
        PG8_STAGE(PG8_SB(0, 0), cB, voffB); PG8_STAGE(PG8_SB(0, 1), cB + hstep, voffB); PG8_STAGE(PG8_SA(0, 0), cA, voffA); PG8_STAGE(PG8_SA(0, 1), cA + hstep, voffA);
        if (wr == 1) PG8_BAR;
        PG8_WAIT_V(2); PG8_BAR;
        PG8_STAGE(PG8_SB(1, 0), cB + kstep, voffB); PG8_STAGE(PG8_SA(1, 0), cA + kstep, voffA); PG8_STAGE(PG8_SB(1, 1), cB + hstep + kstep, voffB);
        PG8_WAIT_V(6); PG8_BAR;
    } else {
        PG8_STAGE(PG8_SB(0, 0), cB, voffB); PG8_STAGE(PG8_SA(0, 0), cA, voffA); PG8_STAGE(PG8_SB(0, 1), cB + hstep, voffB); PG8_STAGE(PG8_SA(0, 1), cA + hstep, voffA);
        if (wr == 1) PG8_BAR;
        PG8_WAIT_V(4); PG8_BAR;
        PG8_STAGE(PG8_SB(1, 0), cB + kstep, voffB); PG8_STAGE(PG8_SA(1, 0), cA + kstep, voffA); PG8_STAGE(PG8_SB(1, 1), cB + hstep + kstep, voffB);
        PG8_WAIT_V(6); PG8_BAR;
    }
    for (;;) {
        const bool has_next = S.next(ui + 1, nxt);
        const char* nA = has_next ? (const char*)g.A + (size_t)nxt.pm * tstep : cA; const char* nB = has_next ? (const char*)g.Bt + (size_t)nxt.pn * tstep : cB;
        for (int t = 0; t < nt; t += 2) {
            const bool last = (t == nt - 2);
            const char* a1 = cA + (size_t)(t + 1) * kstep;
            const char* a2 = last ? nA : cA + (size_t)(t + 2) * kstep; const char* b2 = last ? nB : cB + (size_t)(t + 2) * kstep;
            const char* a3 = a2 + kstep; const char* b3 = b2 + kstep;
            if (last && has_next) S.a_ready(nxt);
            if constexpr (SP2) {
            PG8_LDB(B0, 0, 0); PG8_LDB(B1, 0, 1); PG8_SCHED; PG8_LDA(At, 0, 0); PG8_STAGE(PG8_SA(1, 1), a1 + hstep, voffA);
            PG8_WAIT_V(8); PG8_WAIT_L(0); PG8_BAR; PG8_MMA(0, 0, At, B0); PG8_MMA(0, 1, At, B1); PG8_BAR; PG8_SCHED;
            PG8_LDA(At, 0, 1); PG8_STAGE(PG8_SB(0, 0), b2, voffB); PG8_STAGE(PG8_SB(0, 1), b2 + hstep, voffB); PG8_STAGE(PG8_SA(0, 0), a2, voffA);
            PG8_WAIT_V(8); PG8_WAIT_L(0); PG8_BAR; PG8_MMA(1, 0, At, B0); PG8_MMA(1, 1, At, B1); PG8_BAR; PG8_SCHED;
            PG8_LDB(B0, 1, 0); PG8_LDB(B1, 1, 1); PG8_SCHED; PG8_LDA(At, 1, 0); PG8_STAGE(PG8_SA(0, 1), a2 + hstep, voffA);
            PG8_WAIT_V(8); PG8_WAIT_L(0); PG8_BAR; PG8_MMA(0, 0, At, B0); PG8_MMA(0, 1, At, B1); PG8_BAR; PG8_SCHED;
            PG8_LDA(At, 1, 1); PG8_STAGE(PG8_SB(1, 0), b3, voffB); PG8_STAGE(PG8_SB(1, 1), b3 + hstep, voffB); PG8_STAGE(PG8_SA(1, 0), a3, voffA);
            PG8_WAIT_V(8); PG8_WAIT_L(0); PG8_BAR; PG8_MMA(1, 0, At, B0); PG8_MMA(1, 1, At, B1); PG8_BAR; PG8_SCHED;
            } else {
            PG8_LDB(B0, 0, 0); PG8_SCHED; PG8_LDA(At, 0, 0); PG8_STAGE(PG8_SA(1, 1), a1 + hstep, voffA);
            PG8_WAIT_L(8); PG8_BAR; PG8_WAIT_L(0); PG8_MMA(0, 0, At, B0); PG8_BAR; PG8_SCHED;
            PG8_LDB(B1, 0, 1); PG8_STAGE(PG8_SB(0, 0), b2, voffB);
            PG8_BAR; PG8_WAIT_L(0); PG8_MMA(0, 1, At, B1); PG8_BAR;
            PG8_LDA(At, 0, 1); PG8_STAGE(PG8_SA(0, 0), a2, voffA);
            PG8_BAR; PG8_WAIT_L(0); PG8_MMA(1, 0, At, B0); PG8_BAR; PG8_SCHED;
            PG8_STAGE(PG8_SB(0, 1), b2 + hstep, voffB);
            PG8_WAIT_V(6); PG8_BAR; PG8_MMA(1, 1, At, B1); PG8_BAR;
            PG8_LDB(B0, 1, 0); PG8_SCHED; PG8_LDA(At, 1, 0); PG8_STAGE(PG8_SA(0, 1), a2 + hstep, voffA);
            PG8_WAIT_L(8); PG8_BAR; PG8_WAIT_L(0); PG8_MMA(0, 0, At, B0); PG8_BAR; PG8_SCHED;
            PG8_LDB(B1, 1, 1); PG8_STAGE(PG8_SB(1, 0), b3, voffB);
            PG8_BAR; PG8_WAIT_L(0); PG8_MMA(0, 1, At, B1); PG8_BAR;
            PG8_LDA(At, 1, 1); PG8_STAGE(PG8_SA(1, 0), a3, voffA);
            PG8_BAR; PG8_WAIT_L(0); PG8_MMA(1, 0, At, B0); PG8_BAR; PG8_SCHED;
            PG8_STAGE(PG8_SB(1, 1), b3 + hstep, voffB);
            PG8_WAIT_V(6); PG8_BAR; PG8_MMA(1, 1, At, B1); PG8_BAR;
            }
        }
        if constexpr (ALIGN_EPI) { if (wr == 0) PG8_BAR; }
        if constexpr (!Epi::AFTER_DRAIN) { E(acc, cur, wr, wc, fr, fq); S.done(cur); }
        if (!has_next) break;
#pragma unroll
        for (int a = 0; a < 2; ++a)
#pragma unroll
            for (int b = 0; b < 2; ++b)
#pragma unroll
                for (int m = 0; m < 4; ++m)
#pragma unroll
                    for (int n = 0; n < 2; ++n) acc[a][b][m][n] = (f32x4){0.f, 0.f, 0.f, 0.f};
        cur = nxt; cA = nA; cB = nB; ++ui;
        if constexpr (ALIGN_EPI) { if (wr == 1) PG8_BAR; }
    }
    PG8_WAIT_V(0);
    if constexpr (!ALIGN_EPI) { if (wr == 0) PG8_BAR; }
    PG8_BAR;
    if constexpr (Epi::AFTER_DRAIN) { E.fused(acc, cur, wr, wc, fr, fq, lds, wid, lane); S.done(cur); }
#undef PG8_SA
#undef PG8_SB
#undef PG8_STAGE
#undef PG8_LDA
#undef PG8_LDB
#undef PG8_MMA
#undef PG8_WAIT_V
#undef PG8_WAIT_L
#undef PG8_BAR
#undef PG8_SCHED
}
}
#define GAS __attribute__((address_space(1)))
#define LAS __attribute__((address_space(3)))
typedef unsigned short bf16;
typedef float f32x4 __attribute__((ext_vector_type(4)));
typedef float f32x2 __attribute__((ext_vector_type(2)));
typedef float f32x16 __attribute__((ext_vector_type(16)));
typedef short bf16x8 __attribute__((ext_vector_type(8)));
typedef short s16x4 __attribute__((ext_vector_type(4)));
typedef unsigned u32x4 __attribute__((ext_vector_type(4)));
typedef unsigned u32x2 __attribute__((ext_vector_type(2)));

constexpr int DM = 1024, DEPTH = 4, TOK = 65536, NMEMK = 256, DFF = 2816, NWAVES = 8, NTHR = 512;
constexpr float EPS = 1e-6f;
constexpr float LOG2E = 1.4426950408889634f;
constexpr size_t MiB = 1u << 20;
constexpr size_t WS_CTL = 0, CTL_ZERO_BYTES = 2 * MiB;
constexpr size_t WS_TAB = 2 * MiB;
constexpr size_t WS_RS = WS_TAB + 512 * 1024;
constexpr size_t WS_W = 3 * MiB;
constexpr size_t WL_IN = 0, WL_OUT = 3072 * 1024, WL_Q = WL_OUT + 1024 * 1024, WL_K = WL_Q + 1024 * 1024, WL_V = WL_K + 1024 * 1024, WL_O = WL_V + 1024 * 1024,
                 WL_GU = WL_O + 1024 * 1024, WL_D = WL_GU + 5632 * 1024, WL_STRIDE = WL_D + 1024 * 2816;
static_assert(WL_STRIDE * 2 * 4 == 130 * MiB, "weights");
constexpr size_t WS_HN = 133 * MiB;
constexpr size_t WS_QK = 261 * MiB;
constexpr size_t WS_VHT = 389 * MiB;
constexpr size_t WS_MIX = 645 * MiB;
constexpr size_t WS_YT = 773 * MiB;
constexpr size_t WS_KF = 837 * MiB;
constexpr size_t WS_KERNT = 901 * MiB;
constexpr size_t WS_MN = 933 * MiB, WS_KX = 949 * MiB, WS_VXT = 965 * MiB, WS_END = 981 * MiB;
constexpr int N_STEPS = 1 + 2 * 49;
constexpr int LDS_BYTES = 160 * 1024 - 512;
constexpr int LDS_MISC = 144 * 1024;
typedef GAS unsigned gu32;
#define RLX_AGENT __ATOMIC_RELAXED, __HIP_MEMORY_SCOPE_AGENT
#define LDS_WAIT() asm volatile("s_waitcnt lgkmcnt(0)" ::: "memory")
#define VM_WAIT() asm volatile("s_waitcnt vmcnt(0)" ::: "memory")
typedef __bf16 bf16x2_t __attribute__((ext_vector_type(2)));
__device__ __forceinline__ unsigned pkbf(float lo, float hi) { const f32x2 v = {lo, hi}; const bf16x2_t b = __builtin_convertvector(v, bf16x2_t); return __builtin_bit_cast(unsigned, b); }
__device__ __forceinline__ float bf_lo(unsigned w) { return __uint_as_float(w << 16); }
__device__ __forceinline__ float bf_hi(unsigned w) { return __uint_as_float(w & 0xffff0000u); }
__device__ __forceinline__ float bf1(bf16 h) { return __uint_as_float(((unsigned)h) << 16); }
__device__ __forceinline__ float dpp_add(float v, const int ctrl_sel) {
    const int x = __builtin_bit_cast(int, v); int y;
    if (ctrl_sel == 0) y = __builtin_amdgcn_update_dpp(0, x, 0xB1, 0xF, 0xF, true);
    else if (ctrl_sel == 1) y = __builtin_amdgcn_update_dpp(0, x, 0x4E, 0xF, 0xF, true);
    else if (ctrl_sel == 2) y = __builtin_amdgcn_update_dpp(0, x, 0x141, 0xF, 0xF, true);
    else y = __builtin_amdgcn_update_dpp(0, x, 0x140, 0xF, 0xF, true);
    return v + __builtin_bit_cast(float, y);
}
__device__ __forceinline__ float wave_sum(float v) {
    v = dpp_add(v, 0); v = dpp_add(v, 1); v = dpp_add(v, 2); v = dpp_add(v, 3);
    const int x = __builtin_bit_cast(int, v);
    const float r0 = __builtin_bit_cast(float, __builtin_amdgcn_readlane(x, 0)), r1 = __builtin_bit_cast(float, __builtin_amdgcn_readlane(x, 16)),
                r2 = __builtin_bit_cast(float, __builtin_amdgcn_readlane(x, 32)), r3 = __builtin_bit_cast(float, __builtin_amdgcn_readlane(x, 48));
    return (r0 + r1) + (r2 + r3);
}
#define XB_TMO      128
#define XB_XCNT(j)  (256  + 64 * (j))
#define XB_XSUB(j)  (1280 + 64 * (j))
#define XB_XGEN(j)  (2304 + 64 * (j))
#define XB_TOP      3328
#define XB_TOPGEN   3392
#define XCD_BAR_WORDS 3456
#define XB_SPIN_CAP (1u << 18)

__device__ __forceinline__ unsigned xb_ld(unsigned* p)              { return __hip_atomic_load(p, __ATOMIC_RELAXED, __HIP_MEMORY_SCOPE_AGENT); }
__device__ __forceinline__ unsigned xb_add(unsigned* p, unsigned v) { return __hip_atomic_fetch_add(p, v, __ATOMIC_RELAXED, __HIP_MEMORY_SCOPE_AGENT); }
__device__ __forceinline__ unsigned xb_xcc_id() { return (unsigned)__builtin_amdgcn_s_getreg((3 << 11) | 20) & 0xFu; }
#define XB_SPIN(cond, bar) do { unsigned _sp = 0; while (cond) { __builtin_amdgcn_s_sleep(1); \
    if ((++_sp & 255u) == 0u) { if (xb_ld(&(bar)[XB_TMO])) break; if (_sp > XB_SPIN_CAP) { atomicAdd(&(bar)[XB_TMO], 1u); break; } } } } while (0)

struct XcdBarrier {
    unsigned* bar; unsigned x;
    volatile LAS unsigned* st;
};

__device__ __forceinline__ XcdBarrier xcd_barrier_post(unsigned* bar, volatile LAS unsigned* st) {
    XcdBarrier b; b.bar = bar; b.x = xb_xcc_id(); b.st = st;
    if (threadIdx.x == 0) (void)xb_add(&bar[XB_XCNT(b.x)], 1u);
    return b;
}
__device__ __forceinline__ void xcd_barrier_complete(unsigned* bar, unsigned x, unsigned& nloc, unsigned& nx) {
    const unsigned G = gridDim.x * gridDim.y * gridDim.z;
    unsigned sum, cnt, mine, sp = 0u;
    for (;;) {
        sum = 0u; cnt = 0u; mine = 0u;
#pragma unroll
        for (unsigned j = 0; j < 16; ++j) { const unsigned c = xb_ld(&bar[XB_XCNT(j)]); sum += c; cnt += (c > 0u) ? 1u : 0u; mine = (j == x) ? c : mine; }
        if (sum == G) break;
        __builtin_amdgcn_s_sleep(1);
        if ((++sp & 255u) == 0u) { if (xb_ld(&bar[XB_TMO])) break; if (sp > XB_SPIN_CAP) { atomicAdd(&bar[XB_TMO], 1u); break; } }
    }
    nloc = mine > 0u ? mine : 1u; nx = cnt > 0u ? cnt : 1u;
}

__device__ __forceinline__ void xcd_barrier(const XcdBarrier& b) {
    asm volatile("s_waitcnt vmcnt(0)" ::: "memory");
    __syncthreads();
    if (threadIdx.x == 0) {
        unsigned* bar = b.bar;
        __builtin_amdgcn_s_waitcnt(0);
        unsigned nloc = b.st[0], nx = b.st[1];
        if (nloc == 0u) { xcd_barrier_complete(bar, b.x, nloc, nx); b.st[0] = nloc; b.st[1] = nx; }
        const unsigned old = xb_add(&bar[XB_XSUB(b.x)], 1u);
        const unsigned gen = old / nloc;
        if (old + 1u == (gen + 1u) * nloc) {
            __builtin_amdgcn_fence(__ATOMIC_RELEASE, "agent");
            asm volatile("s_waitcnt vmcnt(0)" ::: "memory");
            const unsigned og = xb_add(&bar[XB_TOP], 1u);
            const unsigned tg = og / nx;
            if (og + 1u == (tg + 1u) * nx) xb_add(&bar[XB_TOPGEN], 1u);
            else XB_SPIN(xb_ld(&bar[XB_TOPGEN]) == tg, bar);
            __builtin_amdgcn_fence(__ATOMIC_ACQUIRE, "agent");
            xb_add(&bar[XB_XGEN(b.x)], 1u);
            asm volatile("s_waitcnt vmcnt(0)" ::: "memory");
        } else {
            XB_SPIN(xb_ld(&bar[XB_XGEN(b.x)]) == gen, bar);
            __builtin_amdgcn_fence(__ATOMIC_ACQUIRE, "agent");
            asm volatile("s_waitcnt vmcnt(0)" ::: "memory");
        }
    }
    __syncthreads();
}
struct Args { const void* p[37]; int s_lo, s_hi, li, pad; };
#define AIN(a, k, zs) ((const float*)(a).p[(k) + (zs)])
#define AWS(a, zs) ((unsigned char*)(a).p[36 + (zs)])
#define AOUT(a, zs) ((float*)(a).p[35 + (zs)])
struct Frame {
    LAS unsigned char* lds;
    int tid, lane, wave, vcu, G, zs;
};
__device__ __forceinline__ int grpB(int g) { return g == 0 ? 32 : 8; }
__device__ __forceinline__ int grpL(int g) { return g == 0 ? 2048 : 8192; }
__device__ __forceinline__ int grpMem(int g) { return g == 0 ? 8192 : 2048; }

__device__ __forceinline__ void transpose_item(const float* W, int K, int N, bf16* WT, int mode, LAS float* scr, int item, int lane, const float* gk = nullptr) {
    const int nblk = N / 32, kb = item / nblk, nb = item % nblk, k0 = 64 * kb, n0 = 32 * nb;
#pragma unroll 8
    for (int i = 0; i < 32; ++i) { const int kk = 2 * i + (lane >> 5); scr[kk * 33 + (lane & 31)] = W[(size_t)(k0 + kk) * N + n0 + (lane & 31)]; }
    LDS_WAIT(); asm volatile("" ::: "memory");
    const int c = lane & 7;
    f32x4 g0 = (f32x4){1.f, 1.f, 1.f, 1.f}, g1 = g0;
    if (gk) { g0 = *(const GAS f32x4*)(gk + k0 + 8 * c); g1 = *(const GAS f32x4*)(gk + k0 + 8 * c + 4); }
#pragma unroll
    for (int j = 0; j < 4; ++j) { const int n = (lane >> 3) + 8 * j; const LAS float* s = scr + (8 * c) * 33 + n;
        u32x4 o; o.x = pkbf(s[0 * 33] * g0.x, s[1 * 33] * g0.y); o.y = pkbf(s[2 * 33] * g0.z, s[3 * 33] * g0.w); o.z = pkbf(s[4 * 33] * g1.x, s[5 * 33] * g1.y); o.w = pkbf(s[6 * 33] * g1.z, s[7 * 33] * g1.w);
        const int ng = n0 + n; const int dr = (mode == 0) ? ng : (8 * (ng >> 2) + (ng & 3) + (mode == 2 ? 4 : 0));
        *(GAS u32x4*)(WT + (size_t)dr * K + k0 + 8 * c) = o; }
    LDS_WAIT(); asm volatile("" ::: "memory");
}
__device__ __forceinline__ void phase_prologue(const Frame& F, const Args& a) {
    LAS float* scr = (LAS float*)(F.lds + F.wave * 16384);
    const int gw = F.vcu * NWAVES + F.wave, NGW = F.G * NWAVES;
    bf16* WB = (bf16*)(AWS(a, F.zs) + WS_W);
    constexpr int I_IN = 16 * 96, I_SQ = 16 * 32, I_G = 16 * 88, I_D = 44 * 32;
    constexpr int PER_LAYER = I_IN + 5 * I_SQ + 2 * I_G + I_D;
    for (int it = gw; it < DEPTH * PER_LAYER; it += NGW) {
        const int l = it / PER_LAYER; int r = it % PER_LAYER; bf16* wl = WB + (size_t)l * WL_STRIDE;
        if (r < I_IN) { transpose_item(AIN(a, 6, F.zs) + (size_t)l * 1024 * 3072, 1024, 3072, wl + WL_IN, 0, scr, r, F.lane, AIN(a, 4, F.zs) + l * DM); continue; } r -= I_IN;
        if (r < I_SQ) { transpose_item(AIN(a, 22, F.zs) + (size_t)l * 1024 * 1024, 1024, 1024, wl + WL_OUT, 0, scr, r, F.lane); continue; } r -= I_SQ;
        if (r < I_SQ) { transpose_item(AIN(a, 26, F.zs) + (size_t)l * 1024 * 1024, 1024, 1024, wl + WL_Q, 0, scr, r, F.lane, AIN(a, 23, F.zs) + l * DM); continue; } r -= I_SQ;
        if (r < I_SQ) { transpose_item(AIN(a, 27, F.zs) + (size_t)l * 1024 * 1024, 1024, 1024, wl + WL_K, 0, scr, r, F.lane); continue; } r -= I_SQ;
        if (r < I_SQ) { transpose_item(AIN(a, 28, F.zs) + (size_t)l * 1024 * 1024, 1024, 1024, wl + WL_V, 0, scr, r, F.lane); continue; } r -= I_SQ;
        if (r < I_SQ) { transpose_item(AIN(a, 29, F.zs) + (size_t)l * 1024 * 1024, 1024, 1024, wl + WL_O, 0, scr, r, F.lane); continue; } r -= I_SQ;
        if (r < I_G) { transpose_item(AIN(a, 32, F.zs) + (size_t)l * 1024 * DFF, 1024, DFF, wl + WL_GU, 1, scr, r, F.lane, AIN(a, 30, F.zs) + l * DM); continue; } r -= I_G;
        if (r < I_G) { transpose_item(AIN(a, 33, F.zs) + (size_t)l * 1024 * DFF, 1024, DFF, wl + WL_GU, 2, scr, r, F.lane, AIN(a, 30, F.zs) + l * DM); continue; } r -= I_G;
        transpose_item(AIN(a, 34, F.zs) + (size_t)l * DFF * 1024, DFF, 1024, wl + WL_D, 0, scr, r, F.lane);
    }
    float* tab = (float*)(AWS(a, F.zs) + WS_TAB);
    for (int i = F.vcu * NTHR + F.tid; i < 8192 * 8; i += F.G * NTHR) { const int pos = i >> 3, j = i & 7;
        const float inv = (float)pow(500000.0, -(double)j / 8.0); const float ang = (float)pos * inv;
        tab[pos * 16 + j] = (float)cos((double)ang); tab[pos * 16 + 8 + j] = (float)sin((double)ang); }
}

template <int R> __device__ __forceinline__ void rowop_rows(const float* xin, const bf16* sub, const float* gpost, float* xout, const float* gpre, bf16* hn, int m0, int rstride, int lane) {
    f32x4 v[R][4]; u32x2 sw[R][4];
#pragma unroll
    for (int r = 0; r < R; ++r) { const GAS f32x4* xr = (const GAS f32x4*)(xin + (size_t)(m0 + r * rstride) * DM) + lane;
#pragma unroll
        for (int j = 0; j < 4; ++j) v[r][j] = __builtin_nontemporal_load(xr + 64 * j); }
    if (sub) {
#pragma unroll
        for (int r = 0; r < R; ++r) { const GAS u32x2* sr = (const GAS u32x2*)(sub + (size_t)(m0 + r * rstride) * DM) + lane;
#pragma unroll
            for (int j = 0; j < 4; ++j) sw[r][j] = __builtin_nontemporal_load(sr + 64 * j); }
        f32x4 gp[4];
#pragma unroll
        for (int j = 0; j < 4; ++j) gp[j] = ((const GAS f32x4*)gpost + lane)[64 * j];
        float ss[R];
#pragma unroll
        for (int r = 0; r < R; ++r) { ss[r] = 0.f;
#pragma unroll
            for (int j = 0; j < 4; ++j) { const float a = bf_lo(sw[r][j].x), b = bf_hi(sw[r][j].x), c = bf_lo(sw[r][j].y), d = bf_hi(sw[r][j].y); ss[r] += (a * a + b * b) + (c * c + d * d); } }
#pragma unroll
        for (int r = 0; r < R; ++r) ss[r] = wave_sum(ss[r]);
#pragma unroll
        for (int r = 0; r < R; ++r) { const float rs = 1.0f / sqrtf(ss[r] * (1.f / DM) + EPS); GAS f32x4* xo = (GAS f32x4*)(xout + (size_t)(m0 + r * rstride) * DM) + lane;
#pragma unroll
            for (int j = 0; j < 4; ++j) { const f32x4 sv = (f32x4){bf_lo(sw[r][j].x), bf_hi(sw[r][j].x), bf_lo(sw[r][j].y), bf_hi(sw[r][j].y)};
                v[r][j] = v[r][j] + (sv * rs) * gp[j]; __builtin_nontemporal_store(v[r][j], xo + 64 * j); } }
    }
    if (hn) {
        f32x4 gq[4];
#pragma unroll
        for (int j = 0; j < 4; ++j) gq[j] = ((const GAS f32x4*)gpre + lane)[64 * j];
        float ss[R];
#pragma unroll
        for (int r = 0; r < R; ++r) { ss[r] = 0.f;
#pragma unroll
            for (int j = 0; j < 4; ++j) ss[r] += (v[r][j].x * v[r][j].x + v[r][j].y * v[r][j].y) + (v[r][j].z * v[r][j].z + v[r][j].w * v[r][j].w); }
#pragma unroll
        for (int r = 0; r < R; ++r) ss[r] = wave_sum(ss[r]);
#pragma unroll
        for (int r = 0; r < R; ++r) { const float rs = 1.0f / sqrtf(ss[r] * (1.f / DM) + EPS); GAS u32x2* ho = (GAS u32x2*)(hn + (size_t)(m0 + r * rstride) * DM) + lane;
#pragma unroll
            for (int j = 0; j < 4; ++j) { const f32x4 o = (v[r][j] * rs) * gq[j]; u32x2 w; w.x = pkbf(o.x, o.y); w.y = pkbf(o.z, o.w); ho[64 * j] = w; } }
    }
}

__device__ __forceinline__ void unpack8(const u32x4 w, float (&f)[8]) { f[0] = bf_lo(w.x); f[1] = bf_hi(w.x); f[2] = bf_lo(w.y); f[3] = bf_hi(w.y); f[4] = bf_lo(w.z); f[5] = bf_hi(w.z); f[6] = bf_lo(w.w); f[7] = bf_hi(w.w); }
__device__ __forceinline__ u32x4 pack8(const float (&f)[8]) { return (u32x4){pkbf(f[0], f[1]), pkbf(f[2], f[3]), pkbf(f[4], f[5]), pkbf(f[6], f[7])}; }
template <int MODE, int R> __device__ __forceinline__ void rowop_bf(const float* xf, bf16* xb, const bf16* sub, const float* gpost, float* rsout, float* outf, int m0, int rstride, int lane, bf16* xbo = nullptr) {
    if (!xbo) xbo = xb;
    f32x4 xr[MODE == 0 ? R : 1][4]; u32x4 xw[MODE == 0 ? 1 : R][2], sw[MODE == 0 ? 1 : R][2];
    if (MODE == 0) {
#pragma unroll
        for (int r = 0; r < R; ++r) { const GAS f32x4* p = (const GAS f32x4*)(xf + (size_t)(m0 + r * rstride) * DM) + 2 * lane;
            xr[r][0] = __builtin_nontemporal_load(p); xr[r][1] = __builtin_nontemporal_load(p + 1); xr[r][2] = __builtin_nontemporal_load(p + 128); xr[r][3] = __builtin_nontemporal_load(p + 129); }
    } else {
#pragma unroll
        for (int r = 0; r < R; ++r) { const GAS u32x4* p = (const GAS u32x4*)(xb + (size_t)(m0 + r * rstride) * DM) + lane; xw[r][0] = p[0]; xw[r][1] = p[64];
            const GAS u32x4* q = (const GAS u32x4*)(sub + (size_t)(m0 + r * rstride) * DM) + lane; sw[r][0] = __builtin_nontemporal_load(q); sw[r][1] = __builtin_nontemporal_load(q + 64); }
    }
    float g[16];
    if (MODE != 0) { const GAS f32x4* gp = (const GAS f32x4*)gpost + 2 * lane; const f32x4 a = gp[0], b = gp[1], c = gp[128], d = gp[129];
        g[0] = a.x; g[1] = a.y; g[2] = a.z; g[3] = a.w; g[4] = b.x; g[5] = b.y; g[6] = b.z; g[7] = b.w; g[8] = c.x; g[9] = c.y; g[10] = c.z; g[11] = c.w; g[12] = d.x; g[13] = d.y; g[14] = d.z; g[15] = d.w; }
#pragma unroll
    for (int r = 0; r < R; ++r) {
        const int m = m0 + r * rstride; float x[16];
        if (MODE == 0) {
#pragma unroll
            for (int j = 0; j < 4; ++j) { x[4 * j] = xr[r][j].x; x[4 * j + 1] = xr[r][j].y; x[4 * j + 2] = xr[r][j].z; x[4 * j + 3] = xr[r][j].w; }
        } else {
            float s0[8], s1[8], x0[8], x1[8]; unpack8(sw[r][0], s0); unpack8(sw[r][1], s1); unpack8(xw[r][0], x0); unpack8(xw[r][1], x1);
            float ss = 0.f;
#pragma unroll
            for (int j = 0; j < 8; ++j) ss += s0[j] * s0[j] + s1[j] * s1[j];
            const float rs = 1.0f / sqrtf(wave_sum(ss) * (1.f / DM) + EPS);
#pragma unroll
            for (int j = 0; j < 8; ++j) { x[j] = x0[j] + (s0[j] * rs) * g[j]; x[8 + j] = x1[j] + (s1[j] * rs) * g[8 + j]; }
        }
        if (MODE == 2) {
            GAS f32x4* p = (GAS f32x4*)(outf + (size_t)m * DM) + 2 * lane;
            __builtin_nontemporal_store((f32x4){x[0], x[1], x[2], x[3]}, p); __builtin_nontemporal_store((f32x4){x[4], x[5], x[6], x[7]}, p + 1);
            __builtin_nontemporal_store((f32x4){x[8], x[9], x[10], x[11]}, p + 128); __builtin_nontemporal_store((f32x4){x[12], x[13], x[14], x[15]}, p + 129);
        } else {
            float ss = 0.f;
#pragma unroll
            for (int j = 0; j < 16; ++j) ss += x[j] * x[j];
            ss = wave_sum(ss);
            GAS u32x4* p = (GAS u32x4*)(xbo + (size_t)m * DM) + lane; float a[8], b[8];
#pragma unroll
            for (int j = 0; j < 8; ++j) { a[j] = x[j]; b[j] = x[8 + j]; }
            p[0] = pack8(a); p[64] = pack8(b);
            if (lane == 0) rsout[m] = 1.0f / sqrtf(ss * (1.f / DM) + EPS);
        }
    }
}
__device__ __forceinline__ f32x2 cmul(f32x2 a, f32x2 b) { return (f32x2){a.x * b.x - a.y * b.y, a.x * b.y + a.y * b.x}; }
__device__ __forceinline__ f32x2 twid(float ph) { return (f32x2){__builtin_amdgcn_cosf(ph), -__builtin_amdgcn_sinf(ph)}; }
#define ZI(i) ((i) ^ (((i) >> 4) & 15))
template <bool INV> __device__ __forceinline__ void r4bf(f32x2& a0, f32x2& a1, f32x2& a2, f32x2& a3, float ph) {
    if (!INV) {
        const f32x2 t0 = a0 + a2, t1 = a0 - a2, t2 = a1 + a3, d = a1 - a3; const f32x2 t3 = (f32x2){d.y, -d.x};
        a0 = t0 + t2; a1 = cmul(t1 + t3, twid(ph)); a2 = cmul(t0 - t2, twid(2.f * ph)); a3 = cmul(t1 - t3, twid(3.f * ph));
    } else {
        f32x2 w1 = twid(ph), w2 = twid(2.f * ph), w3 = twid(3.f * ph); w1.y = -w1.y; w2.y = -w2.y; w3.y = -w3.y;
        const f32x2 b1 = cmul(a1, w1), b2 = cmul(a2, w2), b3 = cmul(a3, w3);
        const f32x2 t0 = a0 + b2, t1 = a0 - b2, t2 = b1 + b3, d = b1 - b3; const f32x2 t3 = (f32x2){-d.y, d.x};
        a0 = t0 + t2; a1 = t1 + t3; a2 = t0 - t2; a3 = t1 - t3;
    }
}
template <int LOGN, int NSEQ, int LS, bool INV, bool ZHALF> __device__ __forceinline__ void fft_pass16(LAS f32x2* z, int tid_in) {
    int tid = tid_in; asm volatile("" : "+v"(tid));
    constexpr int N = 1 << LOGN, NB = NSEQ * (N / 16), IT = (NB + NTHR - 1) / NTHR, s = 1 << LS;
#pragma unroll 1
    for (int jb = 0; jb < IT; ++jb) {
        const int j = tid + jb * NTHR;
        if (NB % NTHR == 0 || j < NB) {
            const int q = j >> (LOGN - 4), jj = j & (N / 16 - 1), k = jj & (s - 1), base = ((jj >> LS) << (LS + 4)) + k;
            LAS f32x2* zq = z + q * N;
            f32x2 a[16];
#pragma unroll
            for (int m = 0; m < 16; ++m) { if (ZHALF && !INV && m >= 8) a[m] = (f32x2){0.f, 0.f}; else a[m] = zq[ZI(base + m * s)]; }
            const float phb = (float)k * (1.0f / (float)(4 * s));
            if (!INV) {
#pragma unroll
                for (int r = 0; r < 4; ++r) r4bf<false>(a[r], a[r + 4], a[r + 8], a[r + 12], (float)(k + r * s) * (1.0f / (float)(16 * s)));
#pragma unroll
                for (int p = 0; p < 4; ++p) r4bf<false>(a[4 * p], a[4 * p + 1], a[4 * p + 2], a[4 * p + 3], phb);
            } else {
#pragma unroll
                for (int p = 0; p < 4; ++p) r4bf<true>(a[4 * p], a[4 * p + 1], a[4 * p + 2], a[4 * p + 3], phb);
#pragma unroll
                for (int r = 0; r < 4; ++r) r4bf<true>(a[r], a[r + 4], a[r + 8], a[r + 12], (float)(k + r * s) * (1.0f / (float)(16 * s)));
            }
#pragma unroll
            for (int m = 0; m < 16; ++m) { if (!(ZHALF && INV && m >= 8)) zq[ZI(base + m * s)] = a[m]; }
        }
    }
    __syncthreads();
}
template <int LOGN, int NSEQ, bool INV> __device__ __forceinline__ void fft_pass4s1(LAS f32x2* z, int tid_in) {
    int tid = tid_in; asm volatile("" : "+v"(tid));
    constexpr int N = 1 << LOGN, NB = NSEQ * (N / 4), IT = NB / NTHR, BT = 4;
    static_assert(IT % BT == 0, "span-1 stage: whole batches");
#pragma unroll 1
    for (int jb = 0; jb < IT; jb += BT) {
        f32x2 a[BT][4]; int idx[BT];
#pragma unroll
        for (int b = 0; b < BT; ++b) { const int j = tid + (jb + b) * NTHR; idx[b] = (j >> (LOGN - 2)) * N + 4 * (j & (N / 4 - 1));
#pragma unroll
            for (int qq = 0; qq < 4; ++qq) a[b][qq] = z[(idx[b] & ~(N - 1)) + ZI((idx[b] & (N - 1)) + qq)]; }
#pragma unroll
        for (int b = 0; b < BT; ++b) { r4bf<INV>(a[b][0], a[b][1], a[b][2], a[b][3], 0.f);
#pragma unroll
            for (int qq = 0; qq < 4; ++qq) z[(idx[b] & ~(N - 1)) + ZI((idx[b] & (N - 1)) + qq)] = a[b][qq]; }
    }
    __syncthreads();
}
template <int LOGN, int NSEQ, bool ZPAD> __device__ __forceinline__ void fft_fwd(LAS f32x2* z, int tid) {
    static_assert(LOGN == 12 || LOGN == 14, "sizes in use");
    if constexpr (LOGN == 14) { fft_pass16<14, NSEQ, 10, false, ZPAD>(z, tid); fft_pass16<14, NSEQ, 6, false, false>(z, tid); fft_pass16<14, NSEQ, 2, false, false>(z, tid); fft_pass4s1<14, NSEQ, false>(z, tid); }
    else { fft_pass16<12, NSEQ, 8, false, ZPAD>(z, tid); fft_pass16<12, NSEQ, 4, false, false>(z, tid); fft_pass16<12, NSEQ, 0, false, false>(z, tid); }
}
template <int LOGN, int NSEQ, bool ZPAD> __device__ __forceinline__ void fft_inv(LAS f32x2* z, int tid) {
    if constexpr (LOGN == 14) { fft_pass4s1<14, NSEQ, true>(z, tid); fft_pass16<14, NSEQ, 2, true, false>(z, tid); fft_pass16<14, NSEQ, 6, true, false>(z, tid); fft_pass16<14, NSEQ, 10, true, ZPAD>(z, tid); }
    else { fft_pass16<12, NSEQ, 0, true, false>(z, tid); fft_pass16<12, NSEQ, 4, true, false>(z, tid); fft_pass16<12, NSEQ, 8, true, ZPAD>(z, tid); }
}

__device__ __forceinline__ float sin_rev(float x) { return __builtin_amdgcn_sinf(x * 0.15915494309189535f); }
__device__ __forceinline__ float cos_rev(float x) { return __builtin_amdgcn_cosf(x * 0.15915494309189535f); }
__device__ __forceinline__ void filt_f1_item(const Frame& F, const Args& a, int l, int L, int item) {
    LAS float* zf = (LAS float*)F.lds;
    LAS float* h1 = zf + 33 * 64;
    LAS float* h2 = h1 + 64 * 64;
    LAS float* w3s = h2 + 64 * 64;
    const int jc = item >> 2, ch = item & 3, j0 = jc * 64, tid = F.tid, j = tid & 63, wv = F.wave, lane = F.lane;
    const float* w1 = AIN(a, 14, F.zs) + (size_t)l * 33 * 64; const float* b1 = AIN(a, 15, F.zs) + l * 64; const float* fr1 = AIN(a, 16, F.zs) + l * 64;
    const float* w2 = AIN(a, 17, F.zs) + (size_t)l * 64 * 64; const float* b2 = AIN(a, 18, F.zs) + l * 64; const float* fr2 = AIN(a, 19, F.zs) + l * 64;
    const float* w3 = AIN(a, 20, F.zs) + (size_t)l * 64 * 1024;
    const int jj = j0 + j; const float tj = (float)jj / (float)(L - 1);
    {
        const float w = (6.283185307179586f * (float)jj) / (float)L;
#pragma unroll
        for (int q = 0; q < 2; ++q) { const int m = 2 * wv + q; const float f = 1e-4f + (float)m * ((15.0f - 1e-4f) / 15.0f); const float fw = f * w;
            zf[(1 + m) * 64 + j] = cos_rev(fw); zf[(17 + m) * 64 + j] = -sin_rev(fw); }
        if (wv == 0) zf[j] = tj;
    }
    __syncthreads();
#pragma unroll 1
    for (int q = 0; q < 8; ++q) { const int o = wv * 8 + q; const float wl = (lane < 33) ? w1[lane * 64 + o] : 0.f; float acc = b1[o];
#pragma unroll
        for (int i = 0; i < 33; ++i) { const float wi = __builtin_bit_cast(float, __builtin_amdgcn_readlane(__builtin_bit_cast(int, wl), i)); const float zv = zf[i * 64 + j];
            asm("v_fmac_f32 %0, %1, %2" : "+v"(acc) : "v"(zv), "v"(wi)); }
        h1[o * 64 + j] = sin_rev(fr1[o] * acc); }
    __syncthreads();
#pragma unroll 1
    for (int q = 0; q < 8; ++q) { const int o = wv * 8 + q; const float wl = w2[lane * 64 + o]; float acc = b2[o];
#pragma unroll
        for (int i = 0; i < 64; ++i) { const float wi = __builtin_bit_cast(float, __builtin_amdgcn_readlane(__builtin_bit_cast(int, wl), i)); const float hv = h1[i * 64 + j];
            asm("v_fmac_f32 %0, %1, %2" : "+v"(acc) : "v"(hv), "v"(wi)); if ((i & 7) == 7) __builtin_amdgcn_sched_barrier(0); }
        h2[o * 64 + j] = sin_rev(fr2[o] * acc); }
    __syncthreads();
    float* KT = (float*)(AWS(a, F.zs) + WS_KERNT);
    float hreg[64];
#pragma unroll
    for (int i = 0; i < 64; ++i) hreg[i] = h2[i * 64 + j];
    LAS float* ws_ = w3s + wv * (64 * 16);
#pragma unroll 1
    for (int cc = 0; cc < 2; ++cc) {
        const int col0 = ch * 256 + wv * 32 + cc * 16;
        { const GAS f32x4* src = (const GAS f32x4*)(w3 + (size_t)lane * 1024 + col0);
          const f32x4 a0 = src[0], a1 = src[1], a2 = src[2], a3 = src[3];
          LAS f32x4* dst = (LAS f32x4*)(ws_ + lane * 16); dst[0] = a0; dst[1] = a1; dst[2] = a2; dst[3] = a3; }
        LDS_WAIT(); asm volatile("" ::: "memory");
#pragma unroll 1
        for (int c4 = 0; c4 < 4; ++c4) {
            float acc[4] = {0.f, 0.f, 0.f, 0.f};
#pragma unroll
            for (int kb = 0; kb < 8; ++kb) { f32x4 wv_[8];
#pragma unroll
                for (int u = 0; u < 8; ++u) wv_[u] = *(const LAS f32x4*)(ws_ + (kb * 8 + u) * 16 + c4 * 4);
#pragma unroll
                for (int u = 0; u < 8; ++u) { const float h_ = hreg[kb * 8 + u];
                    asm("v_fmac_f32 %0, %1, %2" : "+v"(acc[0]) : "v"(wv_[u].x), "v"(h_)); asm("v_fmac_f32 %0, %1, %2" : "+v"(acc[1]) : "v"(wv_[u].y), "v"(h_));
                    asm("v_fmac_f32 %0, %1, %2" : "+v"(acc[2]) : "v"(wv_[u].z), "v"(h_)); asm("v_fmac_f32 %0, %1, %2" : "+v"(acc[3]) : "v"(wv_[u].w), "v"(h_)); }
                __builtin_amdgcn_sched_barrier(0); }
#pragma unroll
            for (int e = 0; e < 4; ++e) { const int col = col0 + c4 * 4 + e; const int c = col & 511;
                const float delta = 3.0701134573253944f + (float)c * ((15.350567286626972f - 3.0701134573253944f) / 511.0f);
                KT[(size_t)col * 8192 + jj] = acc[e] * __builtin_amdgcn_exp2f(-tj * delta * 1.4426950408889634f); }
        }
        LDS_WAIT(); asm volatile("" ::: "memory");
    }
    __syncthreads();
}
template <int LOGN> __device__ __forceinline__ void filt_f2_item(const Frame& F, const Args& a, int l, int c) {
    constexpr int N = 1 << LOGN, L = N / 2;
    LAS f32x2* z = (LAS f32x2*)F.lds; LAS float* red = (LAS float*)(F.lds + LDS_MISC + 64);
    const float* KT = (const float*)(AWS(a, F.zs) + WS_KERNT); const float* hf = KT + (size_t)c * 8192; const float* hb = KT + (size_t)(512 + c) * 8192;
    const int tid = F.tid; float asum = 0.f;
    for (int j = tid; j < L; j += NTHR) { const float f = hf[j], b = hb[j];
        if (j == 0) { z[ZI(0)] = (f32x2){f + b, 0.f}; z[ZI(L)] = (f32x2){0.f, 0.f}; asum += fabsf(f + b); }
        else { z[ZI(j)] = (f32x2){f, 0.f}; z[ZI(N - j)] = (f32x2){b, 0.f}; asum += fabsf(f) + fabsf(b); } }
    asum = wave_sum(asum); if (F.lane == 0) red[F.wave] = asum;
    __syncthreads();
    float S = 0.f;
#pragma unroll
    for (int w = 0; w < NWAVES; ++w) S += red[w];
    fft_fwd<LOGN, 1, false>(z, tid);
    const float dsk = AIN(a, 21, F.zs)[l * 512 + c]; const float rS = 1.0f / S, rN = 1.0f / (float)N;
    f32x2* KF = (f32x2*)(AWS(a, F.zs) + WS_KF) + (size_t)c * N;
    for (int i = tid; i < N; i += NTHR) { const f32x2 v = z[i]; KF[i] = (f32x2){(v.x * rS + dsk) * rN, (v.y * rS) * rN}; }
    __syncthreads();
}

struct Chunk8 { u32x4 v; unsigned short pm, pp; };
__device__ __forceinline__ Chunk8 ld_chunk(const bf16* row, int ci, int nch) {
    Chunk8 c; c.v = *(const GAS u32x4*)(row + 8 * ci);
    c.pm = (ci > 0) ? *(const GAS unsigned short*)(row + 8 * ci - 1) : (unsigned short)0;
    c.pp = (ci + 1 < nch) ? *(const GAS unsigned short*)(row + 8 * ci + 8) : (unsigned short)0;
    return c;
}
__device__ __forceinline__ void conv8(const Chunk8& c, float w0, float w1, float w2, float b, float (&o)[8]) {
    float e[10]; e[0] = bf1(c.pm); e[9] = bf1(c.pp);
    e[1] = bf_lo(c.v.x); e[2] = bf_hi(c.v.x); e[3] = bf_lo(c.v.y); e[4] = bf_hi(c.v.y); e[5] = bf_lo(c.v.z); e[6] = bf_hi(c.v.z); e[7] = bf_lo(c.v.w); e[8] = bf_hi(c.v.w);
#pragma unroll
    for (int i = 0; i < 8; ++i) o[i] = w0 * e[i] + w1 * e[i + 1] + w2 * e[i + 2] + b;
}
template <int LOGN, int NSEQ> __device__ __forceinline__ void hyena_unit(const Frame& F, const Args& a, int l, int c, int p0) {
    constexpr int N = 1 << LOGN, L = N / 2, LOGCH = LOGN - 4, NCH = 1 << LOGCH, CPT = (NSEQ * NCH) / NTHR;
    static_assert(CPT * NTHR == NSEQ * NCH, "chunks divide evenly");
    LAS f32x2* z = (LAS f32x2*)F.lds; const int tid = F.tid;
    const bf16* VHT = (const bf16*)(AWS(a, F.zs) + WS_VHT);
    const float* cw = AIN(a, 12, F.zs) + (size_t)l * 3 * 1536; const float* cb = AIN(a, 13, F.zs) + l * 1536;
    const bf16* x0r = VHT + (size_t)(512 + c) * TOK + (size_t)(2 * p0) * L;
    const bf16* x1r = VHT + (size_t)(1024 + c) * TOK + (size_t)(2 * p0) * L;
    const bf16* vhr = VHT + (size_t)(1536 + c) * TOK + (size_t)(2 * p0) * L;
    const float a0 = cw[c], a1 = cw[1536 + c], a2 = cw[3072 + c], ab = cb[c];
    const float b0 = cw[512 + c], b1 = cw[1536 + 512 + c], b2 = cw[3072 + 512 + c], bb = cb[512 + c];
    const float c0 = cw[1024 + c], c1 = cw[1536 + 1024 + c], c2 = cw[3072 + 1024 + c], cbb = cb[1024 + c];
    constexpr int KPT = (N / 2) / NTHR; f32x4 kreg[KPT];
    {
        Chunk8 q1a[CPT], qva[CPT], q1b[CPT], qvb[CPT];
#pragma unroll
        for (int i = 0; i < CPT; ++i) { const int cg = tid + NTHR * i, q = cg >> LOGCH, ci = cg & (NCH - 1); const size_t ro = (size_t)(2 * q) * L;
            q1a[i] = ld_chunk(x1r + ro, ci, NCH); qva[i] = ld_chunk(vhr + ro, ci, NCH); q1b[i] = ld_chunk(x1r + ro + L, ci, NCH); qvb[i] = ld_chunk(vhr + ro + L, ci, NCH); }
#pragma unroll
        for (int i = 0; i < CPT; ++i) { const int cg = tid + NTHR * i, q = cg >> LOGCH, ci = cg & (NCH - 1);
            float xa[8], va[8], xb[8], vb[8]; conv8(q1a[i], b0, b1, b2, bb, xa); conv8(qva[i], c0, c1, c2, cbb, va); conv8(q1b[i], b0, b1, b2, bb, xb); conv8(qvb[i], c0, c1, c2, cbb, vb);
            const bool swp = (ci >> 1) & 1;
#pragma unroll
            for (int j = 0; j < 4; ++j) { const f32x2 e0 = (f32x2){xa[2 * j] * va[2 * j], xb[2 * j] * vb[2 * j]}, e1 = (f32x2){xa[2 * j + 1] * va[2 * j + 1], xb[2 * j + 1] * vb[2 * j + 1]};
                *(LAS f32x4*)(z + q * N + (ZI(8 * ci + 2 * j) & ~1)) = swp ? (f32x4){e1.x, e1.y, e0.x, e0.y} : (f32x4){e0.x, e0.y, e1.x, e1.y}; } }
    }
    __syncthreads();
#define HY_LOADK() do { const f32x2* KF = (const f32x2*)(AWS(a, F.zs) + WS_KF) + (size_t)c * N; \
        _Pragma("unroll") for (int ii = 0; ii < KPT; ++ii) kreg[ii] = *(const GAS f32x4*)(KF + 2 * (tid + NTHR * ii)); } while (0)
    if constexpr (LOGN == 14) { fft_pass16<14, NSEQ, 10, false, true>(z, tid); fft_pass16<14, NSEQ, 6, false, false>(z, tid); fft_pass16<14, NSEQ, 2, false, false>(z, tid); HY_LOADK(); fft_pass4s1<14, NSEQ, false>(z, tid); }
    else { fft_pass16<12, NSEQ, 8, false, true>(z, tid); fft_pass16<12, NSEQ, 4, false, false>(z, tid); HY_LOADK(); fft_pass16<12, NSEQ, 0, false, false>(z, tid); }
#undef HY_LOADK
#pragma unroll
    for (int ii = 0; ii < KPT; ++ii) { const int i = tid + NTHR * ii; const f32x4 k = kreg[ii];
#pragma unroll
        for (int q = 0; q < NSEQ; ++q) { const f32x4 v = *(LAS f32x4*)(z + q * N + 2 * i);
            *(LAS f32x4*)(z + q * N + 2 * i) = (f32x4){v.x * k.x - v.y * k.y, v.x * k.y + v.y * k.x, v.z * k.z - v.w * k.w, v.z * k.w + v.w * k.z}; } }
    __syncthreads();
    Chunk8 q0a[CPT], q0b[CPT];
#define HY_LOADX0() do { _Pragma("unroll") for (int i = 0; i < CPT; ++i) { const int cg = tid + NTHR * i, q = cg >> LOGCH, ci = cg & (NCH - 1); const size_t ro = (size_t)(2 * q) * L; \
        q0a[i] = ld_chunk(x0r + ro, ci, NCH); q0b[i] = ld_chunk(x0r + ro + L, ci, NCH); } } while (0)
    if constexpr (LOGN == 14) { fft_pass4s1<14, NSEQ, true>(z, tid); fft_pass16<14, NSEQ, 2, true, false>(z, tid); fft_pass16<14, NSEQ, 6, true, false>(z, tid); HY_LOADX0(); fft_pass16<14, NSEQ, 10, true, true>(z, tid); }
    else { fft_pass16<12, NSEQ, 0, true, false>(z, tid); fft_pass16<12, NSEQ, 4, true, false>(z, tid); HY_LOADX0(); fft_pass16<12, NSEQ, 8, true, true>(z, tid); }
#undef HY_LOADX0
    bf16* YT = (bf16*)(AWS(a, F.zs) + WS_YT) + (size_t)c * TOK + (size_t)(2 * p0) * L;
    {
#pragma unroll
        for (int i = 0; i < CPT; ++i) { const int cg = tid + NTHR * i, q = cg >> LOGCH, ci = cg & (NCH - 1); const size_t ro = (size_t)(2 * q) * L;
            float ga[8], gb[8]; conv8(q0a[i], a0, a1, a2, ab, ga); conv8(q0b[i], a0, a1, a2, ab, gb);
            float ya[8], yb[8];
            const bool swp = (ci >> 1) & 1;
#pragma unroll
            for (int j = 0; j < 4; ++j) { f32x4 v = *(LAS f32x4*)(z + q * N + (ZI(8 * ci + 2 * j) & ~1)); if (swp) v = (f32x4){v.z, v.w, v.x, v.y};
                ya[2 * j] = v.x * ga[2 * j]; yb[2 * j] = v.y * gb[2 * j]; ya[2 * j + 1] = v.z * ga[2 * j + 1]; yb[2 * j + 1] = v.w * gb[2 * j + 1]; }
            *(GAS u32x4*)(YT + ro + 8 * ci) = (u32x4){pkbf(ya[0], ya[1]), pkbf(ya[2], ya[3]), pkbf(ya[4], ya[5]), pkbf(ya[6], ya[7])};
            *(GAS u32x4*)(YT + ro + L + 8 * ci) = (u32x4){pkbf(yb[0], yb[1]), pkbf(yb[2], yb[3]), pkbf(yb[4], yb[5]), pkbf(yb[6], yb[7])}; }
    }
    __syncthreads();
}
__device__ __forceinline__ void ytrans_tile(const Frame& F, const Args& a, int tile) {
    LAS bf16* sm = (LAS bf16*)F.lds;
    const int cb = tile & 7, tb = tile >> 3, tid = F.tid;
    const bf16* YT = (const bf16*)(AWS(a, F.zs) + WS_YT); bf16* MIX = (bf16*)(AWS(a, F.zs) + WS_MIX);
    { const int c = tid >> 3, ch = tid & 7; const u32x4 v = *(const GAS u32x4*)(YT + (size_t)(cb * 64 + c) * TOK + (size_t)tb * 64 + ch * 8);
      *(LAS u32x4*)(sm + c * 72 + ch * 8) = v; }
    __syncthreads();
    { const int t = tid >> 3, cc = tid & 7; unsigned w[4];
#pragma unroll
      for (int q = 0; q < 4; ++q) { const unsigned lo = sm[(cc * 8 + 2 * q) * 72 + t], hi = sm[(cc * 8 + 2 * q + 1) * 72 + t]; w[q] = lo | (hi << 16); }
      *(GAS u32x4*)(MIX + (size_t)(tb * 64 + t) * 1024 + 512 + cb * 64 + cc * 8) = (u32x4){w[0], w[1], w[2], w[3]}; }
    __syncthreads();
}
__device__ __forceinline__ int crow(int r, int hi) { return (r & 3) + 8 * (r >> 2) + 4 * hi; }
template <bool DIFF> struct AttnCfg {
    static constexpr int DQK = DIFF ? 64 : 256, KW = DIFF ? 128 : 256, VR = DIFF ? 128 : 256;
    static constexpr int KROWB = KW * 2 + 16, VROWB = 136, KBYTES = 64 * KROWB, VBYTES = VR * VROWB, STAGE = KBYTES + VBYTES;
    static constexpr int NKP = 64 * (KW / 8) / NTHR, NVP = VR * 8 / NTHR, NKS = DQK / 16;
};
struct AttnPtrs {
    const bf16* Q; int ldq;
    const bf16* K; int ldk;
    const bf16* VT; size_t ldv;
    int nkeys;
    bf16* O; int ldo;
};
template <bool DIFF> __device__ __forceinline__ void attn_unit(const Frame& F, const AttnPtrs& P, float lam, float outscale, const float* subg) {
    typedef AttnCfg<DIFF> C;
    const int tid = F.tid, lane = F.lane, wid = F.wave, r32 = lane & 31, hi = lane >> 5, qsub = wid >> 1, role = wid & 1;
    LAS unsigned char* lds = F.lds;
#ifndef XQ_REGS
#define XQ_REGS 0
#endif
    constexpr bool QREG = DIFF || XQ_REGS;
    bf16x8 qf[QREG ? C::NKS : 1];
    const bf16* qp = P.Q + (size_t)(qsub * 32 + r32) * P.ldq + (DIFF ? role * 64 : 0) + hi * 8;
    if constexpr (QREG) {
#pragma unroll
      for (int ks = 0; ks < C::NKS; ++ks) qf[ks] = *(const GAS bf16x8*)(qp + ks * 16); }
    u32x4 kst[C::NKP];
    const int NT = P.nkeys / 64;
#define ATT_LOADK(t) do { \
        _Pragma("unroll") for (int i = 0; i < C::NKP; ++i) { const int p = tid + NTHR * i, key = p / (C::KW / 8), ch = p % (C::KW / 8); \
            kst[i] = *(const GAS u32x4*)(P.K + (size_t)((t) * 64 + key) * P.ldk + ch * 8); } } while (0)
#define ATT_LOADV(t) do { \
        _Pragma("unroll") for (int i = 0; i < C::NVP; ++i) { const int p = tid + NTHR * i, row = p >> 3, ch = p & 7; \
            kst[i] = *(const GAS u32x4*)(P.VT + (size_t)row * P.ldv + (size_t)(t) * 64 + ch * 8); } } while (0)
#define ATT_STOREK(buf) do { LAS unsigned char* kb_ = lds + (buf) * C::STAGE; \
        _Pragma("unroll") for (int i = 0; i < C::NKP; ++i) { const int p = tid + NTHR * i, key = p / (C::KW / 8), ch = p % (C::KW / 8); \
            *(LAS u32x4*)(kb_ + key * C::KROWB + ch * 16) = kst[i]; } } while (0)
#define ATT_STOREV(buf) do { LAS unsigned char* vb_ = lds + (buf) * C::STAGE + C::KBYTES; \
        _Pragma("unroll") for (int i = 0; i < C::NVP; ++i) { const int p = tid + NTHR * i, row = p >> 3, ch = p & 7; \
            *(LAS u32x2*)(vb_ + row * C::VROWB + ch * 16) = (u32x2){kst[i].x, kst[i].y}; *(LAS u32x2*)(vb_ + row * C::VROWB + ch * 16 + 8) = (u32x2){kst[i].z, kst[i].w}; } } while (0)
    static_assert(C::NKP == C::NVP, "one staging register set serves K then V");
    ATT_LOADK(0); ATT_STOREK(0); ATT_LOADV(0); ATT_STOREV(0);
    __syncthreads();
    f32x16 o[4];
#pragma unroll
    for (int d = 0; d < 4; ++d) o[d] = (f32x16){0.f, 0.f, 0.f, 0.f, 0.f, 0.f, 0.f, 0.f, 0.f, 0.f, 0.f, 0.f, 0.f, 0.f, 0.f, 0.f};
    float mrun = -INFINITY, lrun = 0.f;
    const int koff = (DIFF ? role * 64 : 0) * 2 + hi * 16, vroff = (DIFF ? 0 : role * 128);
#pragma unroll 1
    for (int t = 0; t < NT; ++t) {
        if (t + 1 < NT) ATT_LOADK(t + 1);
        const LAS unsigned char* kb = lds + (t & 1) * C::STAGE; const LAS unsigned char* vb = kb + C::KBYTES;
        f32x16 s0 = (f32x16){0.f, 0.f, 0.f, 0.f, 0.f, 0.f, 0.f, 0.f, 0.f, 0.f, 0.f, 0.f, 0.f, 0.f, 0.f, 0.f}, s1 = s0;
        int zo = 0; if constexpr (!QREG) asm volatile("" : "+v"(zo));
#pragma unroll
        for (int ks = 0; ks < C::NKS; ++ks) {
            const bf16x8 a0 = *(const LAS bf16x8*)(kb + r32 * C::KROWB + koff + ks * 32);
            const bf16x8 a1 = *(const LAS bf16x8*)(kb + (32 + r32) * C::KROWB + koff + ks * 32);
            bf16x8 qv; if constexpr (QREG) qv = qf[ks]; else qv = *(const GAS bf16x8*)(qp + ks * 16 + zo);
            s0 = __builtin_amdgcn_mfma_f32_32x32x16_bf16(a0, qv, s0, 0, 0, 0);
            s1 = __builtin_amdgcn_mfma_f32_32x32x16_bf16(a1, qv, s1, 0, 0, 0);
        }
        if (t + 1 < NT) { ATT_STOREK((t + 1) & 1); ATT_LOADV(t + 1); }
        float mx = fmaxf(s0[0], s1[0]);
#pragma unroll
        for (int r = 1; r < 16; ++r) mx = fmaxf(mx, fmaxf(s0[r], s1[r]));
        mx = fmaxf(mx, __shfl_xor(mx, 32));
        const float mnew = fmaxf(mrun, mx), alpha = __builtin_amdgcn_exp2f(mrun - mnew); mrun = mnew;
        float rs = 0.f;
#pragma unroll
        for (int r = 0; r < 16; ++r) { s0[r] = __builtin_amdgcn_exp2f(s0[r] - mnew); s1[r] = __builtin_amdgcn_exp2f(s1[r] - mnew); rs += s0[r] + s1[r]; }
        lrun = lrun * alpha + rs;
#pragma unroll
        for (int d = 0; d < 4; ++d)
#pragma unroll
            for (int r = 0; r < 16; ++r) o[d][r] *= alpha;
        bf16x8 pf[2][2];
#pragma unroll
        for (int s = 0; s < 2; ++s) {
            u32x4 w0, w1;
            w0.x = pkbf(s0[8 * s + 0], s0[8 * s + 1]); w0.y = pkbf(s0[8 * s + 2], s0[8 * s + 3]); w0.z = pkbf(s0[8 * s + 4], s0[8 * s + 5]); w0.w = pkbf(s0[8 * s + 6], s0[8 * s + 7]);
            w1.x = pkbf(s1[8 * s + 0], s1[8 * s + 1]); w1.y = pkbf(s1[8 * s + 2], s1[8 * s + 3]); w1.z = pkbf(s1[8 * s + 4], s1[8 * s + 5]); w1.w = pkbf(s1[8 * s + 6], s1[8 * s + 7]);
            pf[0][s] = __builtin_bit_cast(bf16x8, w0); pf[1][s] = __builtin_bit_cast(bf16x8, w1);
        }
#pragma unroll
        for (int d = 0; d < 4; ++d)
#pragma unroll
            for (int kt = 0; kt < 2; ++kt)
#pragma unroll
                for (int s = 0; s < 2; ++s) {
                    const LAS unsigned char* vp = vb + (vroff + 32 * d + r32) * C::VROWB + (32 * kt + 16 * s + 4 * hi) * 2;
                    const s16x4 lo = *(const LAS s16x4*)(vp), hh = *(const LAS s16x4*)(vp + 16);
                    const bf16x8 vf = (bf16x8){lo[0], lo[1], lo[2], lo[3], hh[0], hh[1], hh[2], hh[3]};
                    o[d] = __builtin_amdgcn_mfma_f32_32x32x16_bf16(vf, pf[kt][s], o[d], 0, 0, 0);
                }
        if (t + 1 < NT) ATT_STOREV((t + 1) & 1);
        __syncthreads();
    }
#undef ATT_LOADK
#undef ATT_LOADV
#undef ATT_STOREK
#undef ATT_STOREV
    const float linv = 1.0f / (lrun + __shfl_xor(lrun, 32));
#pragma unroll
    for (int d = 0; d < 4; ++d)
#pragma unroll
        for (int r = 0; r < 16; ++r) o[d][r] *= linv;
    if constexpr (DIFF) {
        LAS float* ex = (LAS float*)lds + (size_t)qsub * 64 * 64 + lane;
        if (role == 1) {
#pragma unroll
            for (int d = 0; d < 4; ++d)
#pragma unroll
                for (int r = 0; r < 16; ++r) ex[(d * 16 + r) * 64] = o[d][r];
        }
        __syncthreads();
        if (role == 0) {
            float ss = 0.f;
#pragma unroll
            for (int d = 0; d < 4; ++d)
#pragma unroll
                for (int r = 0; r < 16; ++r) { const float v = o[d][r] - lam * ex[(d * 16 + r) * 64]; o[d][r] = v; ss += v * v; }
            ss += __shfl_xor(ss, 32);
            const float rstd = outscale / sqrtf(ss * (1.f / 128.f) + EPS);
            bf16* op = P.O + (size_t)(qsub * 32 + r32) * P.ldo;
#pragma unroll
            for (int d = 0; d < 4; ++d)
#pragma unroll
                for (int rg = 0; rg < 4; ++rg) { const int dd = 32 * d + 8 * rg + 4 * hi; const f32x4 g = *(const f32x4*)(subg + dd);
                    u32x2 w; w.x = pkbf(o[d][4 * rg + 0] * rstd * g.x, o[d][4 * rg + 1] * rstd * g.y); w.y = pkbf(o[d][4 * rg + 2] * rstd * g.z, o[d][4 * rg + 3] * rstd * g.w);
                    *(GAS u32x2*)(op + dd) = w; }
        }
        __syncthreads();
    } else {
        bf16* op = P.O + (size_t)(qsub * 32 + r32) * P.ldo + role * 128;
#pragma unroll
        for (int d = 0; d < 4; ++d)
#pragma unroll
            for (int rg = 0; rg < 4; ++rg) { const int dd = 32 * d + 8 * rg + 4 * hi;
                u32x2 w; w.x = pkbf(o[d][4 * rg + 0], o[d][4 * rg + 1]); w.y = pkbf(o[d][4 * rg + 2], o[d][4 * rg + 3]);
                *(GAS u32x2*)(op + dd) = w; }
    }
}
template <bool DIFF> struct PA {
    static constexpr int TK = DIFF ? 64 : 32, NKT = TK / 32, NKS = DIFF ? 4 : 16, KW = DIFF ? 128 : 256, VR = DIFF ? 128 : 256;
    static constexpr int KROWB = KW * 2 + 16, VROWB = TK * 2 + 16, KB = TK * KROWB, VB = VR * VROWB, VOFF = 2 * KB, LDSB = 2 * KB + 3 * VB;
    static constexpr int KCH = KW / 8, VCH = TK / 8;
    static constexpr int NQK = NKS * NKT, NPV = 4 * NKT * 2, EPG = (16 * NKT) / NQK;
    static_assert(TK * KCH == 2 * NTHR && VR * VCH == 2 * NTHR, "two staging pieces per thread for K and for V");
};
#ifndef DTHR_VAL
#define DTHR_VAL 8.0f
#endif
constexpr float DTHR = DTHR_VAL;
__device__ __forceinline__ float half_swap_max(float m) {
    auto rr = __builtin_amdgcn_permlane32_swap(__float_as_uint(m), __float_as_uint(m), false, false);
    return fmaxf(__uint_as_float(rr[0]), __uint_as_float(rr[1]));
}
__device__ __forceinline__ float half_swap_sum(float m) {
    auto rr = __builtin_amdgcn_permlane32_swap(__float_as_uint(m), __float_as_uint(m), false, false);
    return __uint_as_float(rr[0]) + __uint_as_float(rr[1]);
}
__device__ __forceinline__ float max16(const f32x16& a) {
    float x = fmaxf(fmaxf(a[0], a[1]), a[2]), y = fmaxf(fmaxf(a[3], a[4]), a[5]);
    x = fmaxf(fmaxf(x, a[6]), a[7]); y = fmaxf(fmaxf(y, a[8]), a[9]); x = fmaxf(fmaxf(x, a[10]), a[11]); y = fmaxf(fmaxf(y, a[12]), a[13]); x = fmaxf(fmaxf(x, a[14]), a[15]);
    return fmaxf(x, y);
}
template <bool DIFF> __device__ __forceinline__ void pipe_attn_unit(const Frame& F, const AttnPtrs& P, float lam, float outscale, const float* subg) {
    typedef PA<DIFF> C;
    const int tid = F.tid, lane = F.lane, wid = F.wave, r32 = lane & 31, hi = lane >> 5, qsub = wid >> 1, role = wid & 1;
    LAS unsigned char* lds = F.lds;
    bf16x8 qf[C::NKS];
    { const bf16* qp = P.Q + (size_t)(qsub * 32 + r32) * P.ldq + (DIFF ? role * 64 : 0) + hi * 8;
#pragma unroll
      for (int ks = 0; ks < C::NKS; ++ks) qf[ks] = *(const GAS bf16x8*)(qp + ks * 16); }
    u32x4 kst[2], vst[2];
    const int NT = P.nkeys / C::TK;
    const int kkey0 = tid / C::KCH, kch = tid % C::KCH, vrow0 = tid / C::VCH, vch = tid % C::VCH;
    const bf16* kg = P.K + (size_t)kkey0 * P.ldk + kch * 8; const bf16* vg = P.VT + (size_t)vrow0 * P.ldv + vch * 8;
    const int kl = kkey0 * C::KROWB + kch * 16, vl = vrow0 * C::VROWB + (vch >> 1) * 32 + (vch & 1) * 8;
#define DA_LOADK(t) do { kst[0] = *(const GAS u32x4*)(kg + (size_t)(t) * C::TK * P.ldk); kst[1] = *(const GAS u32x4*)(kg + (size_t)((t) * C::TK + C::TK / 2) * P.ldk); } while (0)
#define DA_LOADV(t) do { vst[0] = *(const GAS u32x4*)(vg + (size_t)(t) * C::TK); vst[1] = *(const GAS u32x4*)(vg + (size_t)(C::VR / 2) * P.ldv + (size_t)(t) * C::TK); } while (0)
#define DA_STOREK(b) do { *(LAS u32x4*)(lds + (b) * C::KB + kl) = kst[0]; *(LAS u32x4*)(lds + (b) * C::KB + kl + (C::TK / 2) * C::KROWB) = kst[1]; } while (0)
#define DA_STOREV(off) do { LAS unsigned char* v_ = lds + (off) + vl; *(LAS u32x2*)(v_) = (u32x2){vst[0].x, vst[0].y}; *(LAS u32x2*)(v_ + 16) = (u32x2){vst[0].z, vst[0].w}; \
        *(LAS u32x2*)(v_ + (C::VR / 2) * C::VROWB) = (u32x2){vst[1].x, vst[1].y}; *(LAS u32x2*)(v_ + (C::VR / 2) * C::VROWB + 16) = (u32x2){vst[1].z, vst[1].w}; } while (0)
    const int koff = (DIFF ? role * 128 : 0) + hi * 16, vroff = DIFF ? 0 : role * 128;
    const f32x16 Z16 = (f32x16){0.f, 0.f, 0.f, 0.f, 0.f, 0.f, 0.f, 0.f, 0.f, 0.f, 0.f, 0.f, 0.f, 0.f, 0.f, 0.f};
    f32x16 o[4]; o[0] = Z16; o[1] = Z16; o[2] = Z16; o[3] = Z16;
    f32x16 A[C::NKT], B[C::NKT];
    float mref, lrun = 0.f;
#define DA_PIN(x) asm volatile("" : "+v"(x))
#define DA_SB() __builtin_amdgcn_sched_barrier(0)
#define DA_KFR(i) (*(const LAS bf16x8*)(kb_ + ((i) % C::NKT) * 32 * C::KROWB + ((i) / C::NKT) * 32))
#define DA_VOFS(i) ((32 * ((i) / (2 * C::NKT))) * C::VROWB + (32 * (((i) >> 1) % C::NKT) + 16 * ((i) & 1)) * 2)
#define DA_VFR(i) (*(const LAS bf16x8*)(vb_ + DA_VOFS(i)))
#define DA_PV(i) do { \
        o[(i) / (2 * C::NKT)] = __builtin_amdgcn_mfma_f32_32x32x16_bf16(vfr_[(i) % 3], __builtin_bit_cast(bf16x8, pw_[(((i) >> 1) % C::NKT) * 2 + ((i) & 1)]), o[(i) / (2 * C::NKT)], 0, 0, 0); } while (0)
#define DA_QK0(S, b) do { const LAS unsigned char* kb_ = lds + (b) * C::KB + r32 * C::KROWB + koff; \
        _Pragma("unroll") for (int i = 0; i < C::NQK; ++i) { const bf16x8 a_ = DA_KFR(i); \
            if (i < C::NKT) S[i % C::NKT] = __builtin_amdgcn_mfma_f32_32x32x16_bf16(a_, qf[i / C::NKT], Z16, 0, 0, 0); else S[i % C::NKT] = __builtin_amdgcn_mfma_f32_32x32x16_bf16(a_, qf[i / C::NKT], S[i % C::NKT], 0, 0, 0); } } while (0)
    DA_LOADK(0); DA_LOADV(0);
    DA_STOREK(0); DA_LOADK(1); DA_STOREV(C::VOFF);
    __syncthreads();
    DA_QK0(A, 0);
    DA_STOREK(1); DA_LOADV(1);
    { float mx = max16(A[0]); if (C::NKT == 2) mx = fmaxf(mx, max16(A[C::NKT - 1])); mref = half_swap_max(mx); }
#pragma unroll
    for (int kt = 0; kt < C::NKT; ++kt)
#pragma unroll
        for (int r = 0; r < 16; ++r) A[kt][r] = __builtin_amdgcn_exp2f(A[kt][r] - mref);
    DA_STOREV(C::VOFF + C::VB);
    DA_LOADK(2); DA_LOADV(2);
    __syncthreads();
    int vprev = 0, vcur = C::VB, vnext = 2 * C::VB;
#define DA_STEP(S, Pv, t, KBUF, PF, PF2) do { \
        if (PF) DA_STOREK(1 - (KBUF)); if (PF2) DA_LOADK((t) + 2); \
        const LAS unsigned char* kb_ = lds + (KBUF) * C::KB + r32 * C::KROWB + koff; \
        bf16x8 kf_[3]; kf_[0] = DA_KFR(0); kf_[1] = DA_KFR(1); \
        u32x4 pw_[2 * C::NKT]; float rs_ = 0.f; \
        DA_SB(); \
        _Pragma("unroll") for (int i = 0; i < C::NQK; ++i) { \
            if (i + 2 < C::NQK) kf_[(i + 2) % 3] = DA_KFR(i + 2); \
            if (i < C::NKT) S[i % C::NKT] = __builtin_amdgcn_mfma_f32_32x32x16_bf16(kf_[i % 3], qf[i / C::NKT], Z16, 0, 0, 0); \
            else S[i % C::NKT] = __builtin_amdgcn_mfma_f32_32x32x16_bf16(kf_[i % 3], qf[i / C::NKT], S[i % C::NKT], 0, 0, 0); \
              \
            _Pragma("unroll") for (int e = i * C::EPG; e < (i + 1) * C::EPG; ++e) { rs_ += Pv[e >> 4][e & 15]; \
                if (e & 1) { const int kt_ = e >> 4, r_ = e & 15; pw_[kt_ * 2 + (r_ >> 3)][(r_ & 7) >> 1] = pkbf(Pv[kt_][r_ - 1], Pv[kt_][r_]); } } \
            DA_PIN(rs_); if (((i + 1) * C::EPG) % 8 == 0 || C::EPG >= 2) DA_PIN(pw_[(((i + 1) * C::EPG - 1) >> 4) * 2 + ((((i + 1) * C::EPG - 1) & 15) >> 3)]); \
            DA_SB(); } \
        lrun += rs_; \
        if (PF) DA_STOREV(C::VOFF + vnext); if (PF2) DA_LOADV((t) + 2); \
        float mx_ = max16(S[0]); if (C::NKT == 2) mx_ = fmaxf(mx_, max16(S[C::NKT - 1])); mx_ = half_swap_max(mx_); \
        float dl_ = 0.f; bool resc_ = false; \
        if (__builtin_expect(__any(mx_ > mref + DTHR), 0)) { dl_ = fmaxf(mx_ - mref, 0.f); mref += dl_; resc_ = true; } \
        const LAS unsigned char* vb_ = lds + C::VOFF + vprev + (vroff + r32) * C::VROWB + hi * 16; \
        bf16x8 vfr_[3]; vfr_[0] = DA_VFR(0); vfr_[1] = DA_VFR(1); \
        DA_SB(); \
        _Pragma("unroll") for (int i = 0; i < C::NPV; ++i) { \
            if (i + 2 < C::NPV) vfr_[(i + 2) % 3] = DA_VFR(i + 2); \
            DA_PV(i); \
            { const int e0_ = 2 * i, e1_ = 2 * i + 1; S[e0_ >> 4][e0_ & 15] = __builtin_amdgcn_exp2f(S[e0_ >> 4][e0_ & 15] - mref); S[e1_ >> 4][e1_ & 15] = __builtin_amdgcn_exp2f(S[e1_ >> 4][e1_ & 15] - mref); } \
            DA_PIN(S[(2 * i) >> 4]); DA_SB(); } \
        if (resc_) { const float f_ = __builtin_amdgcn_exp2f(-dl_); lrun *= f_; \
            _Pragma("unroll") for (int d = 0; d < 4; ++d) _Pragma("unroll") for (int r = 0; r < 16; ++r) o[d][r] *= f_; } \
        __syncthreads(); \
        { const int tmp_ = vprev; vprev = vcur; vcur = vnext; vnext = tmp_; } \
    } while (0)
#pragma unroll 1
    for (int t = 1; t < NT - 3; t += 2) {
        DA_STEP(B, A, t, 1, true, true);
        DA_STEP(A, B, t + 1, 0, true, true);
    }
    DA_STEP(B, A, NT - 3, 1, true, true);
    DA_STEP(A, B, NT - 2, 0, true, false);
    DA_STEP(B, A, NT - 1, 1, false, false);
    {
        float rs_ = 0.f; u32x4 pw_[2 * C::NKT];
#pragma unroll
        for (int kt = 0; kt < C::NKT; ++kt) {
#pragma unroll
            for (int r = 0; r < 16; ++r) rs_ += B[kt][r];
#pragma unroll
            for (int s = 0; s < 2; ++s) { pw_[kt * 2 + s].x = pkbf(B[kt][8 * s + 0], B[kt][8 * s + 1]); pw_[kt * 2 + s].y = pkbf(B[kt][8 * s + 2], B[kt][8 * s + 3]); pw_[kt * 2 + s].z = pkbf(B[kt][8 * s + 4], B[kt][8 * s + 5]); pw_[kt * 2 + s].w = pkbf(B[kt][8 * s + 6], B[kt][8 * s + 7]); } }
        lrun += rs_;
        const LAS unsigned char* vb_ = lds + C::VOFF + vprev + (vroff + r32) * C::VROWB + hi * 16;
#pragma unroll
        for (int i = 0; i < C::NPV; ++i) { const bf16x8 vf_ = DA_VFR(i);
            o[i / (2 * C::NKT)] = __builtin_amdgcn_mfma_f32_32x32x16_bf16(vf_, __builtin_bit_cast(bf16x8, pw_[((i >> 1) % C::NKT) * 2 + (i & 1)]), o[i / (2 * C::NKT)], 0, 0, 0); }
    }
#undef DA_STEP
#undef DA_QK0
#undef DA_PIN
#undef DA_SB
#undef DA_KFR
#undef DA_VOFS
#undef DA_VFR
#undef DA_PV
#undef DA_LOADK
#undef DA_LOADV
#undef DA_STOREK
#undef DA_STOREV
    const float linv = 1.0f / half_swap_sum(lrun);
#pragma unroll
    for (int d = 0; d < 4; ++d)
#pragma unroll
        for (int r = 0; r < 16; ++r) o[d][r] *= linv;
    __syncthreads();
    if constexpr (DIFF) {
        LAS float* ex = (LAS float*)lds + (size_t)qsub * 64 * 64 + lane;
        if (role == 1) {
#pragma unroll
            for (int d = 0; d < 4; ++d)
#pragma unroll
                for (int r = 0; r < 16; ++r) ex[(d * 16 + r) * 64] = o[d][r];
        }
        __syncthreads();
        if (role == 0) {
            float ss = 0.f;
#pragma unroll
            for (int d = 0; d < 4; ++d)
#pragma unroll
                for (int r = 0; r < 16; ++r) { const float v = o[d][r] - lam * ex[(d * 16 + r) * 64]; o[d][r] = v; ss += v * v; }
            ss = half_swap_sum(ss);
            const float rstd = outscale / sqrtf(ss * (1.f / 128.f) + EPS);
            bf16* op = P.O + (size_t)(qsub * 32 + r32) * P.ldo;
#pragma unroll
            for (int d = 0; d < 4; ++d)
#pragma unroll
                for (int rg = 0; rg < 4; ++rg) { const int dd = 32 * d + 8 * rg + 4 * hi; const f32x4 g = *(const f32x4*)(subg + dd);
                    u32x2 w; w.x = pkbf(o[d][4 * rg + 0] * rstd * g.x, o[d][4 * rg + 1] * rstd * g.y); w.y = pkbf(o[d][4 * rg + 2] * rstd * g.z, o[d][4 * rg + 3] * rstd * g.w);
                    *(GAS u32x2*)(op + dd) = w; }
        }
        __syncthreads();
    } else {
        bf16* op = P.O + (size_t)(qsub * 32 + r32) * P.ldo + role * 128;
#pragma unroll
        for (int d = 0; d < 4; ++d)
#pragma unroll
            for (int rg = 0; rg < 4; ++rg) { const int dd = 32 * d + 8 * rg + 4 * hi;
                u32x2 w; w.x = pkbf(o[d][4 * rg + 0], o[d][4 * rg + 1]); w.y = pkbf(o[d][4 * rg + 2], o[d][4 * rg + 3]);
                *(GAS u32x2*)(op + dd) = w; }
    }
}
#ifndef MK_PER_STEP
#define MK_PER_STEP 0
#endif
#ifndef PH_MASK
#define PH_MASK 0x1fff
#endif
#ifndef DUP_MASK
#define DUP_MASK 0
#endif
#define REPS(k) ((((DUP_MASK) >> (k)) & 1) ? 2 : 1)
#ifndef SITE_MASK
#define SITE_MASK 7
#endif
#define PFRAME() Frame P = F; { int t_ = F.tid; asm volatile("" : "+v"(t_)); P.tid = t_; P.lane = t_ & 63; P.wave = __builtin_amdgcn_readfirstlane(t_ >> 6); int z_ = 0; asm volatile("" : "+s"(z_)); P.zs = z_; } \
    const int gw = P.vcu * NWAVES + P.wave, NGW = P.G * NWAVES; (void)gw; (void)NGW; unsigned char* const ws = AWS(args, P.zs); (void)ws
#define WSP(off) ((bf16*)(ws + (off)))
#define P_WL()  (WSP(WS_W) + (size_t)l * WL_STRIDE)
#define P_HN()  WSP(WS_HN)
#define P_QK()  WSP(WS_QK)
#define P_VHT() WSP(WS_VHT)
#define P_MIX() WSP(WS_MIX)
#define P_MO()  WSP(WS_QK)
#define P_XO()  WSP(WS_QK)
#define P_HID() WSP(WS_QK)
#define P_QX()  WSP(WS_VHT)
#define P_OX()  (WSP(WS_VHT) + (size_t)TOK * 1024)
#define P_FO()  WSP(WS_MIX)
#define P_MN()  WSP(WS_MN)
#define P_KX()  WSP(WS_KX)
#define P_VXT() WSP(WS_VXT)
#define P_XRES() (AOUT(args, P.zs) + (size_t)g * TOK * DM)
#define P_RS() ((float*)(ws + WS_RS))

__global__ void __launch_bounds__(NTHR, 2) hymba_fwd(Args args) {
    extern __shared__ __attribute__((aligned(16))) unsigned char lds_raw[];
    Frame F;
    F.lds = (LAS unsigned char*)lds_raw;
    F.tid = threadIdx.x; F.lane = F.tid & 63; F.wave = __builtin_amdgcn_readfirstlane(F.tid >> 6); F.zs = 0;
    F.G = gridDim.x; { const int bx = blockIdx.x; F.vcu = (F.G % 8 == 0) ? (bx % 8) * (F.G / 8) + bx / 8 : bx; }
    volatile LAS unsigned* MISC = (volatile LAS unsigned*)(F.lds + LDS_MISC);
    if (F.tid < 64) MISC[F.tid] = 0u;
    __syncthreads();
    XcdBarrier bar = xcd_barrier_post((unsigned*)(AWS(args, 0) + WS_CTL) + 1024 + (size_t)args.li * XCD_BAR_WORDS, MISC);
    const int s_lo = args.s_lo, s_hi = args.s_hi;
#define RUNK(s, k) ((((PH_MASK) >> (k)) & 1) && s_lo <= (s) && (s) < s_hi)
#ifndef GEMM_ALIGN
#define GEMM_ALIGN true
#endif
#ifndef GEMM_SP2
#define GEMM_SP2 true
#endif
#ifndef SEAM_REPS
#define SEAM_REPS 1
#endif
#define SEAM(s) do { if ((s) + 1 < s_hi) { for (int sr_ = 0; sr_ < SEAM_REPS; ++sr_) xcd_barrier(bar); } } while (0)

    if (RUNK(0, 0)) { _Pragma("unroll 1") for (int rep_ = 0; rep_ < REPS(0); ++rep_) { PFRAME(); phase_prologue(P, args); } SEAM(0); }

#pragma unroll 1
    for (int g = 0; g < 2; ++g) {
#pragma unroll 1
        for (int l = 0; l <= DEPTH; ++l) {
            const int sb = 1 + g * 49 + l * 12;
            const int L = grpL(g), NB = grpB(g), MG = grpMem(g);
            if (RUNK(sb + 0, 1)) {
                _Pragma("unroll 1") for (int rep_ = 0; rep_ < REPS(1); ++rep_) {
                { PFRAME();
                bf16* XB = P_HN(); float* RS = P_RS(); const float* gpost = AIN(args, 31, P.zs) + (size_t)(l > 0 ? l - 1 : 0) * DM;
#ifndef SKIP_ROWOPA
                if (l == 0) { const float* xi = AIN(args, g, P.zs); for (int m = gw; m < TOK; m += 4 * NGW) rowop_bf<0, 4>(xi, XB, nullptr, nullptr, RS, nullptr, m, NGW, P.lane); }
                else if (l < DEPTH) { const bf16* FO = P_FO(); for (int m = gw; m < TOK; m += 8 * NGW) rowop_bf<1, 8>(nullptr, XB, FO, gpost, RS, nullptr, m, NGW, P.lane); }
                else { const bf16* FO = P_FO(); float* xres = P_XRES(); for (int m = gw; m < TOK; m += 8 * NGW) rowop_bf<2, 8>(nullptr, XB, FO, gpost, nullptr, xres, m, NGW, P.lane); }
#endif
                if (l < DEPTH) {
                    const float* gm = AIN(args, 25, P.zs) + (size_t)l * DM; const float* memin = AIN(args, 2 + g, P.zs); bf16* MN = P_MN();
                    for (int m = gw; m < MG; m += NGW) rowop_rows<1>(memin, nullptr, nullptr, nullptr, gm, MN, m, 0, P.lane);
                    const int nit = (L / 64) * 4;
                    _Pragma("unroll 1") for (int r2_ = 0; r2_ < REPS(14); ++r2_)
                    for (int it = P.vcu; it < nit; it += P.G) filt_f1_item(P, args, l, L, it);
                } }
                }
                SEAM(sb + 0);
            }
            if (l == DEPTH) continue;
            if (RUNK(sb + 1, 2)) {
                _Pragma("unroll 1") for (int rep_ = 0; rep_ < REPS(2); ++rep_) {
                { PFRAME(); pg8::Gemm gq{P_HN(), P_WL() + WL_IN, TOK, 1024, 1024}; pg8::StaticOrder S; S.init(TOK, 1024, P.G, (int)blockIdx.x);
                  pg8::EpiRopeQK E{P_QK(), (const float*)(ws + WS_TAB), L - 1, 0.125f * LOG2E, P_RS()};
                  pg8::gemm_phase<pg8::EpiRopeQK, pg8::StaticOrder, GEMM_ALIGN, GEMM_SP2>(P.lds, gq, S, E); }
                { PFRAME(); pg8::Gemm gv{P_WL() + WL_IN + (size_t)1024 * 1024, P_HN(), 2048, TOK, 1024}; pg8::StaticOrder S; S.init(2048, TOK, P.G, (int)blockIdx.x);
                  pg8::EpiBf16 E{P_VHT(), TOK, 1.f, nullptr, P_RS()};
                  pg8::gemm_phase<pg8::EpiBf16, pg8::StaticOrder, GEMM_ALIGN, GEMM_SP2>(P.lds, gv, S, E); }
                __syncthreads();
                _Pragma("unroll 1") for (int r2_ = 0; r2_ < REPS(15); ++r2_)
                { PFRAME();
                if (g == 0) { for (int c = P.vcu; c < 512; c += P.G) filt_f2_item<12>(P, args, l, c); }
                else        { for (int c = P.vcu; c < 512; c += P.G) filt_f2_item<14>(P, args, l, c); } }
                }
                SEAM(sb + 1);
            }
            if (RUNK(sb + 2, 3)) {
                _Pragma("unroll 1") for (int rep_ = 0; rep_ < REPS(3); ++rep_) {
                { PFRAME();
                float lam, lam_init;
                { const float p1 = AIN(args, 7, P.zs)[l * 64 + P.lane] * AIN(args, 8, P.zs)[l * 64 + P.lane]; const float p2 = AIN(args, 9, P.zs)[l * 64 + P.lane] * AIN(args, 10, P.zs)[l * 64 + P.lane];
                  lam_init = 0.8f - 0.6f * expf(-0.3f * (float)l); lam = expf(wave_sum(p1)) - expf(wave_sum(p2)) + lam_init; }
                const int nqb = L / 128, nun = NB * 4 * nqb; bf16* QK = P_QK(); bf16* VHT = P_VHT(); bf16* MIX = P_MIX(); const float* sg = AIN(args, 11, P.zs) + l * 128;
#pragma unroll 1
                for (int u = P.vcu; u < nun; u += P.G) {
                    const int qb = u % nqb, bh = u / nqb, h = bh & 3, b = bh >> 2; const size_t t0 = (size_t)b * L;
                    AttnPtrs A; A.Q = QK + (t0 + (size_t)qb * 128) * 1024 + h * 128; A.ldq = 1024;
                    A.K = QK + t0 * 1024 + 512 + h * 128; A.ldk = 1024; A.VT = VHT + (size_t)(h * 128) * TOK + t0; A.ldv = TOK; A.nkeys = L;
                    A.O = MIX + (t0 + (size_t)qb * 128) * 1024 + h * 128; A.ldo = 1024;
#ifndef SKIP_DATTN
                    pipe_attn_unit<true>(P, A, lam, 1.f - lam_init, sg);
#endif
                } } }
                __syncthreads();
                _Pragma("unroll 1") for (int rep_ = 0; rep_ < REPS(13); ++rep_) {
                { PFRAME();
                if (g == 0) { for (int u = P.vcu; u < 512 * 4; u += P.G) hyena_unit<12, 4>(P, args, l, u >> 2, (u & 3) * 4); }
                else        { for (int u = P.vcu; u < 512 * 4; u += P.G) hyena_unit<14, 1>(P, args, l, u >> 2, u & 3); } }
                }
                SEAM(sb + 2);
            }
            if (RUNK(sb + 3, 4)) {
                _Pragma("unroll 1") for (int rep_ = 0; rep_ < REPS(4); ++rep_) { { PFRAME(); for (int t = P.vcu; t < 8 * (TOK / 64); t += P.G) ytrans_tile(P, args, t); } }
                SEAM(sb + 3); }
            if (RUNK(sb + 4, 5)) {
                _Pragma("unroll 1") for (int rep_ = 0; rep_ < REPS(5); ++rep_) {
                { PFRAME(); pg8::Gemm gm{P_MIX(), P_WL() + WL_OUT, TOK, 1024, 1024}; pg8::StaticOrder S; S.init(TOK, 1024, P.G, (int)blockIdx.x);
                  pg8::EpiBf16 E{P_MO(), 1024, 1.f, nullptr, nullptr};
                  pg8::gemm_phase<pg8::EpiBf16, pg8::StaticOrder, GEMM_ALIGN, GEMM_SP2>(P.lds, gm, S, E); }
                }
                SEAM(sb + 4);
            }
            if (RUNK(sb + 5, 6)) {
                _Pragma("unroll 1") for (int rep_ = 0; rep_ < REPS(6); ++rep_) {
                { PFRAME();
                bf16* XB = P_HN(); float* RS = P_RS(); const bf16* MO = P_MO(); const float* gpost = AIN(args, 5, P.zs) + (size_t)l * DM;
                if (rep_ == 0) for (int m = gw; m < TOK; m += 8 * NGW) rowop_bf<1, 8>(nullptr, XB, MO, gpost, RS, nullptr, m, NGW, P.lane);
                else for (int m = gw; m < TOK; m += 8 * NGW) rowop_bf<1, 8>(nullptr, XB, MO, gpost, (float*)(ws + WS_MIX), nullptr, m, NGW, P.lane, WSP(WS_VHT)); }
                }
                SEAM(sb + 5);
            }
            if (RUNK(sb + 6, 7)) {
                _Pragma("unroll 1") for (int rep_ = 0; rep_ < REPS(7); ++rep_) {
                if (SITE_MASK & 1) { PFRAME(); pg8::Gemm gq{P_HN(), P_WL() + WL_Q, TOK, 1024, 1024}; pg8::StaticOrder S; S.init(TOK, 1024, P.G, (int)blockIdx.x);
                  pg8::EpiBf16 E{P_QX(), 1024, 0.0625f * LOG2E, P_RS(), nullptr};
                  pg8::gemm_phase<pg8::EpiBf16, pg8::StaticOrder, GEMM_ALIGN, GEMM_SP2>(P.lds, gq, S, E); }
                if (SITE_MASK & 2) { PFRAME(); pg8::Gemm gk{P_MN(), P_WL() + WL_K, MG, 1024, 1024}; pg8::StaticOrder S; S.init(MG, 1024, P.G, (int)blockIdx.x);
                  pg8::EpiBf16 E{P_KX(), 1024, 1.f, nullptr, nullptr};
                  pg8::gemm_phase<pg8::EpiBf16, pg8::StaticOrder, GEMM_ALIGN, GEMM_SP2>(P.lds, gk, S, E); }
                if (SITE_MASK & 4) { PFRAME(); pg8::Gemm gv{P_WL() + WL_V, P_MN(), 1024, MG, 1024}; pg8::StaticOrder S; S.init(1024, MG, P.G, (int)((blockIdx.x + P.G / 2) % P.G));
                  pg8::EpiBf16 E{P_VXT(), MG, 1.f, nullptr, nullptr};
                  pg8::gemm_phase<pg8::EpiBf16, pg8::StaticOrder, GEMM_ALIGN, GEMM_SP2>(P.lds, gv, S, E); }
                }
                SEAM(sb + 6);
            }
            if (RUNK(sb + 7, 8)) {
                _Pragma("unroll 1") for (int rep_ = 0; rep_ < REPS(8); ++rep_) {
                { PFRAME();
                const int nqb = L / 128, nun = NB * 4 * nqb; bf16* QX = P_QX(); bf16* KX = P_KX(); bf16* VXT = P_VXT(); bf16* OX = P_OX();
#pragma unroll 1
                for (int u = P.vcu; u < nun; u += P.G) {
                    const int qb = u % nqb, bh = u / nqb, h = bh & 3, b = bh >> 2; const size_t t0 = (size_t)b * L;
                    AttnPtrs A; A.Q = QX + (t0 + (size_t)qb * 128) * 1024 + h * 256; A.ldq = 1024;
                    A.K = KX + (size_t)(b * NMEMK) * 1024 + h * 256; A.ldk = 1024; A.VT = VXT + (size_t)(h * 256) * MG + (size_t)b * NMEMK; A.ldv = MG; A.nkeys = NMEMK;
                    A.O = OX + (t0 + (size_t)qb * 128) * 1024 + h * 256; A.ldo = 1024;
                    pipe_attn_unit<false>(P, A, 0.f, 1.f, nullptr);
                } }
                }
                SEAM(sb + 7);
            }
            if (RUNK(sb + 8, 9)) {
                _Pragma("unroll 1") for (int rep_ = 0; rep_ < REPS(9); ++rep_) {
                { PFRAME(); pg8::Gemm gm{P_OX(), P_WL() + WL_O, TOK, 1024, 1024}; pg8::StaticOrder S; S.init(TOK, 1024, P.G, (int)blockIdx.x);
                  pg8::EpiBf16 E{P_XO(), 1024, 1.f, nullptr, nullptr};
                  pg8::gemm_phase<pg8::EpiBf16, pg8::StaticOrder, GEMM_ALIGN, GEMM_SP2>(P.lds, gm, S, E); }
                }
                SEAM(sb + 8);
            }
            if (RUNK(sb + 9, 10)) {
                _Pragma("unroll 1") for (int rep_ = 0; rep_ < REPS(10); ++rep_) {
                { PFRAME();
                bf16* XB = P_HN(); float* RS = P_RS(); const bf16* XO = P_XO(); const float* gpost = AIN(args, 24, P.zs) + (size_t)l * DM;
                if (rep_ == 0) for (int m = gw; m < TOK; m += 8 * NGW) rowop_bf<1, 8>(nullptr, XB, XO, gpost, RS, nullptr, m, NGW, P.lane);
                else for (int m = gw; m < TOK; m += 8 * NGW) rowop_bf<1, 8>(nullptr, XB, XO, gpost, (float*)(ws + WS_MIX), nullptr, m, NGW, P.lane, WSP(WS_VHT)); }
                }
                SEAM(sb + 9);
            }
            if (RUNK(sb + 10, 11)) {
                _Pragma("unroll 1") for (int rep_ = 0; rep_ < REPS(11); ++rep_) {
#ifdef PANEL_GU
                { PFRAME(); pg8::Gemm gm{P_HN(), P_WL() + WL_GU, TOK, 2 * DFF, 1024}; pg8::PanelOrder S; S.init(TOK, 2 * DFF, P.G, P.vcu, false);
                  pg8::EpiSwiGLU E{P_HID(), DFF, P_RS()};
                  pg8::gemm_phase<pg8::EpiSwiGLU, pg8::PanelOrder, true, true>(P.lds, gm, S, E); }
#else
                { PFRAME(); pg8::Gemm gm{P_HN(), P_WL() + WL_GU, TOK, 2 * DFF, 1024}; pg8::StaticOrder S; S.init(TOK, 2 * DFF, P.G, (int)blockIdx.x);
                  pg8::EpiSwiGLU E{P_HID(), DFF, P_RS()};
                  pg8::gemm_phase<pg8::EpiSwiGLU, pg8::StaticOrder, GEMM_ALIGN, GEMM_SP2>(P.lds, gm, S, E); }
#endif
                }
                SEAM(sb + 10);
            }
            if (RUNK(sb + 11, 12)) {
                _Pragma("unroll 1") for (int rep_ = 0; rep_ < REPS(12); ++rep_) {
                { PFRAME(); pg8::Gemm gm{P_HID(), P_WL() + WL_D, TOK, 1024, DFF}; pg8::StaticOrder S; S.init(TOK, 1024, P.G, (int)blockIdx.x);
                  pg8::EpiBf16 E{P_FO(), 1024, 1.f, nullptr, nullptr};
                  pg8::gemm_phase<pg8::EpiBf16, pg8::StaticOrder, GEMM_ALIGN, GEMM_SP2>(P.lds, gm, S, E); }
                }
                SEAM(sb + 11);
            }
        }
    }
#undef RUNK
#undef SEAM
}

extern "C" void kernel_launch(void* const* d_in, const int* in_sizes, int n_in, void* d_out, int out_size, void* d_ws, size_t ws_size, hipStream_t stream) {
    static int grid = 0;
    if (grid == 0) {
        if (n_in != 35 || out_size != 2 * TOK * DM || ws_size < WS_END) { fprintf(stderr, "kernel_launch: unexpected shapes (n_in %d out %d ws %zu)\n", n_in, out_size, ws_size); grid = -1; return; }
        int dev = 0, cus = 0, per_cu = 0;
        if (hipGetDevice(&dev) != hipSuccess || hipDeviceGetAttribute(&cus, hipDeviceAttributeMultiprocessorCount, dev) != hipSuccess) { grid = -1; return; }
        if (hipFuncSetAttribute((const void*)hymba_fwd, hipFuncAttributeMaxDynamicSharedMemorySize, LDS_BYTES) != hipSuccess) { fprintf(stderr, "kernel_launch: hipFuncSetAttribute failed\n"); grid = -1; return; }
        if (hipOccupancyMaxActiveBlocksPerMultiprocessor(&per_cu, (const void*)hymba_fwd, NTHR, LDS_BYTES) != hipSuccess || per_cu < 1) { fprintf(stderr, "kernel_launch: occupancy query reports %d\n", per_cu); per_cu = 1; }
        (void)hipGetLastError();
        grid = cus;
    }
    if (grid < 0) return;
    (void)hipMemsetAsync((char*)d_ws + WS_CTL, 0, CTL_ZERO_BYTES, stream);
    Args a{};
    for (int i = 0; i < 35; ++i) a.p[i] = d_in[i];
    a.p[35] = d_out; a.p[36] = d_ws; a.pad = 0;
#if MK_PER_STEP
    for (int s = 0; s < N_STEPS; ++s) { a.s_lo = s; a.s_hi = s + 1; a.li = 0; hipLaunchKernelGGL(hymba_fwd, dim3(grid), dim3(NTHR), LDS_BYTES, stream, a); }
#else
    a.s_lo = 0; a.s_hi = N_STEPS; a.li = 0;
    hipLaunchKernelGGL(hymba_fwd, dim3(grid), dim3(NTHR), LDS_BYTES, stream, a);
#endif
}
```

```cpp
#include <hip/hip_runtime.h>
#include <cstdio>
#include <cstdint>
#define MK_PER_STEP 0
namespace pg8 {
#define PG8_LAS __attribute__((address_space(3)))
typedef unsigned short bf16_t;
typedef short bf16x8 __attribute__((ext_vector_type(8)));
typedef float f32x4 __attribute__((ext_vector_type(4)));
typedef unsigned u32x4 __attribute__((ext_vector_type(4)));
constexpr int BM = 256, BK = 64, HALF = 128, HTB = HALF * BK * 2  , STAGE_BYTES = 8 * HTB, NXCD = 8, WGM = 8;

__host__ __device__ __forceinline__ int lds_byte(int r, int c) { const int st = (r >> 4) * 2 + (c >> 5), rr = r & 15, cc = c & 31, ob = rr * 64 + cc * 2; return st * 1024 + (ob ^ (((ob >> 9) & 1) << 5)); }
__host__ __device__ __forceinline__ void stage_rc(int b, int& R, int& C) { const int st = b / 1024, sb = b % 1024, swz = sb ^ (((sb >> 9) & 1) << 5); R = (st >> 1) * 16 + swz / 64; C = (st & 1) * 32 + (swz % 64) / 2; }
__host__ __device__ __forceinline__ int perm32(int rho) { const int n = rho >> 4, i = rho & 15; return 8 * (i >> 2) + 4 * n + (i & 3); }

struct Unit { int pm, pn; };
struct Gemm { const bf16_t* A; const bf16_t* Bt; int M, N, K; };

struct StaticOrder {
    int nM, nN, nwg, G, c;
    __host__ __device__ void init(int M, int N, int G_, int c_) { nM = M / BM; nN = N / BM; nwg = nM * nN; G = G_; c = c_; }
    __host__ __device__ bool next(int i, Unit& u) const {
        const long L = (long)i * G + c; if (L >= nwg) return false;
        int wgid = (int)L; { const int q = nwg / NXCD, r = nwg % NXCD, xcd = wgid % NXCD, off = wgid / NXCD; wgid = (xcd < r ? xcd * (q + 1) : r * (q + 1) + (xcd - r) * q) + off; }
        const int nig = WGM * nN, gid = wgid / nig, fm = gid * WGM, gsz = (nM - fm) < WGM ? (nM - fm) : WGM;
        u.pm = fm + ((wgid % nig) % gsz); u.pn = (wgid % nig) / gsz; return true;
    }
    __device__ __forceinline__ void a_ready(const Unit&) const {}
    __device__ __forceinline__ void done(const Unit&) const {}
};
struct PanelOrder {
    int nM, nN, G, c; bool tr;
    __host__ __device__ void init(int M, int N, int G_, int c_, bool tr_) { nM = M / BM; nN = N / BM; G = G_; c = c_; tr = tr_; }
    __host__ __device__ bool next(int i, Unit& u) const {
        const int per = tr ? nM : nN, np = tr ? nN : nM; const int pi = i / per, ti = i % per; const int p = c + pi * G; if (p >= np) return false;
        if (tr) { u.pm = ti; u.pn = p; } else { u.pm = p; u.pn = ti; } return true;
    }
    __device__ __forceinline__ void a_ready(const Unit&) const {}
    __device__ __forceinline__ void done(const Unit&) const {}
};
typedef unsigned u32x2 __attribute__((ext_vector_type(2)));
__device__ __forceinline__ unsigned cvt_pk_bf16(float lo, float hi) { unsigned r; asm volatile("v_cvt_pk_bf16_f32 %0, %1, %2" : "=v"(r) : "v"(lo), "v"(hi)); return r; }

struct EpiBf16 {
    static constexpr bool PERM = true, AFTER_DRAIN = false;
    bf16_t* O; int ldc; float scale; const float* rowscale; const float* colscale;
    __device__ __forceinline__ void operator()(const f32x4 (&acc)[2][2][4][2], const Unit& u, int wr, int wc, int fr, int fq) const {
        const int row0 = u.pm * BM + wr * 64 + fr; const int col0 = u.pn * BM + wc * 32 + 8 * fq;
        f32x4 cs[2][2];
#pragma unroll
        for (int bj = 0; bj < 2; ++bj) { if (colscale) { cs[bj][0] = *(const f32x4*)(colscale + col0 + bj * HALF); cs[bj][1] = *(const f32x4*)(colscale + col0 + bj * HALF + 4); }
            else { cs[bj][0] = (f32x4){1.f, 1.f, 1.f, 1.f}; cs[bj][1] = cs[bj][0]; } }
        float rsv[2][4];
#pragma unroll
        for (int ai = 0; ai < 2; ++ai)
#pragma unroll
            for (int m = 0; m < 4; ++m) rsv[ai][m] = rowscale ? scale * rowscale[row0 + ai * HALF + m * 16] : scale;
#pragma unroll
        for (int ai = 0; ai < 2; ++ai)
#pragma unroll
            for (int m = 0; m < 4; ++m) { const int row = row0 + ai * HALF + m * 16; bf16_t* rowp = O + (size_t)row * ldc + col0; const float sc = rsv[ai][m];
#pragma unroll
                for (int bj = 0; bj < 2; ++bj) { const f32x4 v0 = acc[ai][bj][m][0] * cs[bj][0] * sc, v1 = acc[ai][bj][m][1] * cs[bj][1] * sc;
                    u32x4 w; w.x = cvt_pk_bf16(v0[0], v0[1]); w.y = cvt_pk_bf16(v0[2], v0[3]); w.z = cvt_pk_bf16(v1[0], v1[1]); w.w = cvt_pk_bf16(v1[2], v1[3]);
                    *(u32x4*)(rowp + bj * HALF) = w; } }
    }
};
struct EpiRopeQK {
    static constexpr bool PERM = true, AFTER_DRAIN = false;
    bf16_t* O; const float* tab; int lmask; float qscale; const float* rowscale;
    __device__ __forceinline__ void operator()(const f32x4 (&acc)[2][2][4][2], const Unit& u, int wr, int wc, int fr, int fq) const {
        const int row0 = u.pm * BM + wr * 64 + fr; const int col0 = u.pn * BM + wc * 32 + 8 * fq;
        const float sc0 = (u.pn < 2) ? qscale : 1.f;
        const bool ropew = (wc & 1) == 0;
        float scv[2][4];
#pragma unroll
        for (int ai = 0; ai < 2; ++ai)
#pragma unroll
            for (int m = 0; m < 4; ++m) scv[ai][m] = sc0 * rowscale[row0 + ai * HALF + m * 16];
#pragma unroll
        for (int ai = 0; ai < 2; ++ai)
#pragma unroll
          for (int mh = 0; mh < 2; ++mh) {
            f32x4 c0v[2], c1v[2], s0v[2], s1v[2];
#pragma unroll
            for (int mm = 0; mm < 2; ++mm) { const int row = row0 + ai * HALF + (2 * mh + mm) * 16;
                c0v[mm] = (f32x4){1.f, 1.f, 1.f, 1.f}; c1v[mm] = c0v[mm]; s0v[mm] = (f32x4){0.f, 0.f, 0.f, 0.f}; s1v[mm] = s0v[mm];
                if (ropew) { const float* tp = tab + (size_t)(row & lmask) * 16; c0v[mm] = *(const f32x4*)(tp); c1v[mm] = *(const f32x4*)(tp + 4); s0v[mm] = *(const f32x4*)(tp + 8); s1v[mm] = *(const f32x4*)(tp + 12); } }
#pragma unroll
            for (int mm = 0; mm < 2; ++mm) { const int m = 2 * mh + mm; const int row = row0 + ai * HALF + m * 16; bf16_t* rowp = O + (size_t)row * 1024 + col0; const float sc = scv[ai][m];
                f32x4 c0 = c0v[mm], c1 = c1v[mm], s0 = s0v[mm], s1 = s1v[mm];
                if (ropew) {
                    if (fq == 1) { s0 = -s0; s1 = -s1; }
                    if (fq >= 2) { s0 = (f32x4){0.f, 0.f, 0.f, 0.f}; s1 = s0; c0 = (f32x4){1.f, 1.f, 1.f, 1.f}; c1 = c0; } }
#pragma unroll
                for (int bj = 0; bj < 2; ++bj) { f32x4 v0 = acc[ai][bj][m][0], v1 = acc[ai][bj][m][1];
                    if (ropew) { f32x4 p0, p1;
#pragma unroll
                        for (int j = 0; j < 4; ++j) { p0[j] = __shfl_xor(v0[j], 16); p1[j] = __shfl_xor(v1[j], 16); }
                        v0 = v0 * c0 - p0 * s0; v1 = v1 * c1 - p1 * s1; }
                    v0 = v0 * sc; v1 = v1 * sc;
                    u32x4 w; w.x = cvt_pk_bf16(v0[0], v0[1]); w.y = cvt_pk_bf16(v0[2], v0[3]); w.z = cvt_pk_bf16(v1[0], v1[1]); w.w = cvt_pk_bf16(v1[2], v1[3]);
                    *(u32x4*)(rowp + bj * HALF) = w; } }
          }
    }
};
struct EpiSwiGLU {
    static constexpr bool PERM = true, AFTER_DRAIN = false;
    bf16_t* O; int ldc; const float* rowscale;
    __device__ __forceinline__ void operator()(const f32x4 (&acc)[2][2][4][2], const Unit& u, int wr, int wc, int fr, int fq) const {
        const int row0 = u.pm * BM + wr * 64 + fr; const int col0 = (u.pn * BM + wc * 32 + 8 * fq) >> 1;
        float rsv[2][4];
#pragma unroll
        for (int ai = 0; ai < 2; ++ai)
#pragma unroll
            for (int m = 0; m < 4; ++m) rsv[ai][m] = rowscale[row0 + ai * HALF + m * 16];
#pragma unroll
        for (int ai = 0; ai < 2; ++ai)
#pragma unroll
            for (int m = 0; m < 4; ++m) { const int row = row0 + ai * HALF + m * 16; bf16_t* rowp = O + (size_t)row * ldc + col0; const float rsc = rsv[ai][m];
#pragma unroll
                for (int bj = 0; bj < 2; ++bj) { const f32x4 g = acc[ai][bj][m][0] * rsc, up = acc[ai][bj][m][1] * rsc; f32x4 h;
#pragma unroll
                    for (int j = 0; j < 4; ++j) { const float e = __builtin_amdgcn_exp2f(-g[j] * 1.4426950408889634f); h[j] = g[j] * __builtin_amdgcn_rcpf(1.f + e) * up[j]; }
                    u32x2 w; w.x = cvt_pk_bf16(h[0], h[1]); w.y = cvt_pk_bf16(h[2], h[3]);
                    *(u32x2*)(rowp + bj * (HALF / 2)) = w; } }
    }
};
template <class Epi, class Sched, bool ALIGN_EPI = false, bool SP2 = false>
__device__ __forceinline__ void gemm_phase(PG8_LAS unsigned char* lds, const Gemm g, const Sched& S, const Epi& E) {
    int tid_l = threadIdx.x; asm volatile("" : "+v"(tid_l));
    const int tid = tid_l, wid = __builtin_amdgcn_readfirstlane(tid >> 6), lane = tid & 63, wr = wid >> 2, wc = wid & 3, fr = lane & 15, fq = lane >> 4;
    const int K = g.K, nt = K / BK;
    unsigned voffA[2], voffB[2];
#pragma unroll
    for (int i = 0; i < 2; ++i) { int R, C; stage_rc(tid * 16 + i * 8192, R, C); const int Rb = Epi::PERM ? ((R & ~31) + perm32(R & 31)) : R;
        voffA[i] = (unsigned)(R * K + C) * 2u; voffB[i] = (unsigned)(Rb * K + C) * 2u; }
    const size_t kstep = (size_t)(BK * 2);
    const size_t hstep = (size_t)HALF * K * 2;
    const size_t tstep = 2 * hstep;
    const unsigned ldsw = (unsigned)wid * 1024u;
    const int aoff = lds_byte(wr * 64 + fr, fq * 8), boff = lds_byte(wc * 32 + fr, fq * 8);
#define PG8_SA(b, h) (((b) * 2 + (h)) * HTB)
#define PG8_SB(b, h) ((4 + (b) * 2 + (h)) * HTB)
#define PG8_STAGE(bufoff, gbase, voff) do { _Pragma("unroll") for (int _i = 0; _i < 2; ++_i) \
        __builtin_amdgcn_global_load_lds((const unsigned*)((const char*)(gbase) + (voff)[_i]), (PG8_LAS unsigned*)(lds + (bufoff) + ldsw + _i * 8192), 16, 0, 0); } while (0)
#define PG8_LDA(dst, b, h) do { _Pragma("unroll") for (int m = 0; m < 4; ++m) _Pragma("unroll") for (int k = 0; k < 2; ++k) dst[m][k] = *(const PG8_LAS bf16x8*)(lds + PG8_SA(b, h) + aoff + m * 2048 + k * 1024); } while (0)
#define PG8_LDB(dst, b, h) do { _Pragma("unroll") for (int n = 0; n < 2; ++n) _Pragma("unroll") for (int k = 0; k < 2; ++k) dst[n][k] = *(const PG8_LAS bf16x8*)(lds + PG8_SB(b, h) + boff + n * 2048 + k * 1024); } while (0)
#define PG8_MMA(ai, bj, At, Bt) do { __builtin_amdgcn_s_setprio(1); _Pragma("unroll") for (int m = 0; m < 4; ++m) _Pragma("unroll") for (int n = 0; n < 2; ++n) _Pragma("unroll") for (int k = 0; k < 2; ++k) \
        acc[ai][bj][m][n] = __builtin_amdgcn_mfma_f32_16x16x32_bf16(Bt[n][k], At[m][k], acc[ai][bj][m][n], 0, 0, 0); __builtin_amdgcn_s_setprio(0); } while (0)
#define PG8_WAIT_V(n) asm volatile("s_waitcnt vmcnt(" #n ")" ::: "memory")
#define PG8_WAIT_L(n) asm volatile("s_waitcnt lgkmcnt(" #n ")" ::: "memory")
#define PG8_BAR __builtin_amdgcn_s_barrier()
#define PG8_SCHED __builtin_amdgcn_sched_barrier(0)
    Unit cur, nxt; int ui = 0;
    if (!S.next(0, cur)) return;
    f32x4 acc[2][2][4][2];
#pragma unroll
    for (int a = 0; a < 2; ++a)
#pragma unroll
        for (int b = 0; b < 2; ++b)
#pragma unroll
            for (int m = 0; m < 4; ++m)
#pragma unroll
                for (int n = 0; n < 2; ++n) acc[a][b][m][n] = (f32x4){0.f, 0.f, 0.f, 0.f};
    bf16x8 At[4][2], B0[2][2], B1[2][2];
    const char* cA = (const char*)g.A + (size_t)cur.pm * tstep; const char* cB = (const char*)g.Bt + (size_t)cur.pn * tstep;
    S.a_ready(cur);
    if constexpr (SP2) {
        PG8_STAGE(PG8_SB(0, 0), cB, voffB); PG8_STAGE(PG8_SB(0, 1), cB + hstep, voffB); PG8_STAGE(PG8_SA(0, 0), cA, voffA); PG8_STAGE(PG8_SA(0, 1), cA + hstep, voffA);
        if (wr == 1) PG8_BAR;
        PG8_WAIT_V(2); PG8_BAR;
        PG8_STAGE(PG8_SB(1, 0), cB + kstep, voffB); PG8_STAGE(PG8_SA(1, 0), cA + kstep, voffA); PG8_STAGE(PG8_SB(1, 1), cB + hstep + kstep, voffB);
        PG8_WAIT_V(6); PG8_BAR;
    } else {
        PG8_STAGE(PG8_SB(0, 0), cB, voffB); PG8_STAGE(PG8_SA(0, 0), cA, voffA); PG8_STAGE(PG8_SB(0, 1), cB + hstep, voffB); PG8_STAGE(PG8_SA(0, 1), cA + hstep, voffA);
        if (wr == 1) PG8_BAR;
        PG8_WAIT_V(4); PG8_BAR;
        PG8_STAGE(PG8_SB(1, 0), cB + kstep, voffB); PG8_STAGE(PG8_SA(1, 0), cA + kstep, voffA); PG8_STAGE(PG8_SB(1, 1), cB + hstep + kstep, voffB);
        PG8_WAIT_V(6); PG8_BAR;
    }
    for (;;) {
        const bool has_next = S.next(ui + 1, nxt);
        const char* nA = has_next ? (const char*)g.A + (size_t)nxt.pm * tstep : cA; const char* nB = has_next ? (const char*)g.Bt + (size_t)nxt.pn * tstep : cB;
        for (int t = 0; t < nt; t += 2) {
            const bool last = (t == nt - 2);
            const char* a1 = cA + (size_t)(t + 1) * kstep;
            const char* a2 = last ? nA : cA + (size_t)(t + 2) * kstep; const char* b2 = last ? nB : cB + (size_t)(t + 2) * kstep;
            const char* a3 = a2 + kstep; const char* b3 = b2 + kstep;
            if (last && has_next) S.a_ready(nxt);
            if constexpr (SP2) {
            PG8_LDB(B0, 0, 0); PG8_LDB(B1, 0, 1); PG8_SCHED; PG8_LDA(At, 0, 0); PG8_STAGE(PG8_SA(1, 1), a1 + hstep, voffA);
            PG8_WAIT_V(8); PG8_WAIT_L(0); PG8_BAR; PG8_MMA(0, 0, At, B0); PG8_MMA(0, 1, At, B1); PG8_BAR; PG8_SCHED;
            PG8_LDA(At, 0, 1); PG8_STAGE(PG8_SB(0, 0), b2, voffB); PG8_STAGE(PG8_SB(0, 1), b2 + hstep, voffB); PG8_STAGE(PG8_SA(0, 0), a2, voffA);
            PG8_WAIT_V(8); PG8_WAIT_L(0); PG8_BAR; PG8_MMA(1, 0, At, B0); PG8_MMA(1, 1, At, B1); PG8_BAR; PG8_SCHED;
            PG8_LDB(B0, 1, 0); PG8_LDB(B1, 1, 1); PG8_SCHED; PG8_LDA(At, 1, 0); PG8_STAGE(PG8_SA(0, 1), a2 + hstep, voffA);
            PG8_WAIT_V(8); PG8_WAIT_L(0); PG8_BAR; PG8_MMA(0, 0, At, B0); PG8_MMA(0, 1, At, B1); PG8_BAR; PG8_SCHED;
            PG8_LDA(At, 1, 1); PG8_STAGE(PG8_SB(1, 0), b3, voffB); PG8_STAGE(PG8_SB(1, 1), b3 + hstep, voffB); PG8_STAGE(PG8_SA(1, 0), a3, voffA);
            PG8_WAIT_V(8); PG8_WAIT_L(0); PG8_BAR; PG8_MMA(1, 0, At, B0); PG8_MMA(1, 1, At, B1); PG8_BAR; PG8_SCHED;
            } else {
            PG8_LDB(B0, 0, 0); PG8_SCHED; PG8_LDA(At, 0, 0); PG8_STAGE(PG8_SA(1, 1), a1 + hstep, voffA);
            PG8_WAIT_L(8); PG8_BAR; PG8_WAIT_L(0); PG8_MMA(0, 0, At, B0); PG8_BAR; PG8_SCHED;
            PG8_LDB(B1, 0, 1); PG8_STAGE(PG8_SB(0, 0), b2, voffB);
            PG8_BAR; PG8_WAIT_L(0); PG8_MMA(0, 1, At, B1); PG8_BAR;
            PG8_LDA(At, 0, 1); PG8_STAGE(PG8_SA(0, 0), a2, voffA);
            PG8_BAR; PG8_WAIT_L(0); PG8_MMA(1, 0, At, B0); PG8_BAR; PG8_SCHED;
            PG8_STAGE(PG8_SB(0, 1), b2 + hstep, voffB);
            PG8_WAIT_V(6); PG8_BAR; PG8_MMA(1, 1, At, B1); PG8_BAR;
            PG8_LDB(B0, 1, 0); PG8_SCHED; PG8_LDA(At, 1, 0); PG8_STAGE(PG8_SA(0, 1), a2 + hstep, voffA);
            PG8_WAIT_L(8); PG8_BAR; PG8_WAIT_L(0); PG8_MMA(0, 0, At, B0); PG8_BAR; PG8_SCHED;
            PG8_LDB(B1, 1, 1); PG8_STAGE(PG8_SB(1, 0), b3, voffB);
            PG8_BAR; PG8_WAIT_L(0); PG8_MMA(0, 1, At, B1); PG8_BAR;
            PG8_LDA(At, 1, 1); PG8_STAGE(PG8_SA(1, 0), a3, voffA);
            PG8_BAR; PG8_WAIT_L(0); PG8_MMA(1, 0, At, B0); PG8_BAR; PG8_SCHED;
            PG8_STAGE(PG8_SB(1, 1), b3 + hstep, voffB);
            PG8_WAIT_V(6); PG8_BAR; PG8_MMA(1, 1, At, B1); PG8_BAR;
            }
        }
        if constexpr (ALIGN_EPI) { if (wr == 0) PG8_BAR; }
        if constexpr (!Epi::AFTER_DRAIN) { E(acc, cur, wr, wc, fr, fq); S.done(cur); }
        if (!has_next) break;
#pragma unroll
        for (int a = 0; a < 2; ++a)
#pragma unroll
            for (int b = 0; b < 2; ++b)
#pragma unroll
                for (int m = 0; m < 4; ++m)
#pragma unroll
                    for (int n = 0; n < 2; ++n) acc[a][b][m][n] = (f32x4){0.f, 0.f, 0.f, 0.f};
        cur = nxt; cA = nA; cB = nB; ++ui;
        if constexpr (ALIGN_EPI) { if (wr == 1) PG8_BAR; }
    }
    PG8_WAIT_V(0);
    if constexpr (!ALIGN_EPI) { if (wr == 0) PG8_BAR; }
    PG8_BAR;
    if constexpr (Epi::AFTER_DRAIN) { E.fused(acc, cur, wr, wc, fr, fq, lds, wid, lane); S.done(cur); }
#undef PG8_SA
#undef PG8_SB
#undef PG8_STAGE
#undef PG8_LDA
#undef PG8_LDB
#undef PG8_MMA
#undef PG8_WAIT_V
#undef PG8_WAIT_L
#undef PG8_BAR
#undef PG8_SCHED
}
}
#define GAS __attribute__((address_space(1)))
#define LAS __attribute__((address_space(3)))
typedef unsigned short bf16;
typedef float f32x4 __attribute__((ext_vector_type(4)));
typedef float f32x2 __attribute__((ext_vector_type(2)));
typedef float f32x16 __attribute__((ext_vector_type(16)));
typedef short bf16x8 __attribute__((ext_vector_type(8)));
typedef short s16x4 __attribute__((ext_vector_type(4)));
typedef unsigned u32x4 __attribute__((ext_vector_type(4)));
typedef unsigned u32x2 __attribute__((ext_vector_type(2)));

constexpr int DM = 1024, DEPTH = 4, TOK = 65536, NMEMK = 256, DFF = 2816, NWAVES = 8, NTHR = 512;
constexpr float EPS = 1e-6f;
constexpr float LOG2E = 1.4426950408889634f;
constexpr size_t MiB = 1u << 20;
constexpr size_t WS_CTL = 0, CTL_ZERO_BYTES = 2 * MiB;
constexpr size_t WS_TAB = 2 * MiB;
constexpr size_t WS_RS = WS_TAB + 512 * 1024;
constexpr size_t WS_W = 3 * MiB;
constexpr size_t WL_IN = 0, WL_OUT = 3072 * 1024, WL_Q = WL_OUT + 1024 * 1024, WL_K = WL_Q + 1024 * 1024, WL_V = WL_K + 1024 * 1024, WL_O = WL_V + 1024 * 1024,
                 WL_GU = WL_O + 1024 * 1024, WL_D = WL_GU + 5632 * 1024, WL_STRIDE = WL_D + 1024 * 2816;
static_assert(WL_STRIDE * 2 * 4 == 130 * MiB, "weights");
constexpr size_t WS_HN = 133 * MiB;
constexpr size_t WS_QK = 261 * MiB;
constexpr size_t WS_VHT = 389 * MiB;
constexpr size_t WS_MIX = 645 * MiB;
constexpr size_t WS_YT = 773 * MiB;
constexpr size_t WS_KF = 837 * MiB;
constexpr size_t WS_KERNT = 901 * MiB;
constexpr size_t WS_MN = 933 * MiB, WS_KX = 949 * MiB, WS_VXT = 965 * MiB, WS_END = 981 * MiB;
constexpr int N_STEPS = 1 + 2 * 49;
constexpr int LDS_BYTES = 160 * 1024 - 512;
constexpr int LDS_MISC = 144 * 1024;
typedef GAS unsigned gu32;
#define RLX_AGENT __ATOMIC_RELAXED, __HIP_MEMORY_SCOPE_AGENT
#define LDS_WAIT() asm volatile("s_waitcnt lgkmcnt(0)" ::: "memory")
#define VM_WAIT() asm volatile("s_waitcnt vmcnt(0)" ::: "memory")
typedef __bf16 bf16x2_t __attribute__((ext_vector_type(2)));
__device__ __forceinline__ unsigned pkbf(float lo, float hi) { const f32x2 v = {lo, hi}; const bf16x2_t b = __builtin_convertvector(v, bf16x2_t); return __builtin_bit_cast(unsigned, b); }
__device__ __forceinline__ float bf_lo(unsigned w) { return __uint_as_float(w << 16); }
__device__ __forceinline__ float bf_hi(unsigned w) { return __uint_as_float(w & 0xffff0000u); }
__device__ __forceinline__ float bf1(bf16 h) { return __uint_as_float(((unsigned)h) << 16); }
__device__ __forceinline__ float dpp_add(float v, const int ctrl_sel) {
    const int x = __builtin_bit_cast(int, v); int y;
    if (ctrl_sel == 0) y = __builtin_amdgcn_update_dpp(0, x, 0xB1, 0xF, 0xF, true);
    else if (ctrl_sel == 1) y = __builtin_amdgcn_update_dpp(0, x, 0x4E, 0xF, 0xF, true);
    else if (ctrl_sel == 2) y = __builtin_amdgcn_update_dpp(0, x, 0x141, 0xF, 0xF, true);
    else y = __builtin_amdgcn_update_dpp(0, x, 0x140, 0xF, 0xF, true);
    return v + __builtin_bit_cast(float, y);
}
__device__ __forceinline__ float wave_sum(float v) {
    v = dpp_add(v, 0); v = dpp_add(v, 1); v = dpp_add(v, 2); v = dpp_add(v, 3);
    const int x = __builtin_bit_cast(int, v);
    const float r0 = __builtin_bit_cast(float, __builtin_amdgcn_readlane(x, 0)), r1 = __builtin_bit_cast(float, __builtin_amdgcn_readlane(x, 16)),
                r2 = __builtin_bit_cast(float, __builtin_amdgcn_readlane(x, 32)), r3 = __builtin_bit_cast(float, __builtin_amdgcn_readlane(x, 48));
    return (r0 + r1) + (r2 + r3);
}
#define XB_TMO      128
#define XB_XCNT(j)  (256  + 64 * (j))
#define XB_XSUB(j)  (1280 + 64 * (j))
#define XB_XGEN(j)  (2304 + 64 * (j))
#define XB_TOP      3328
#define XB_TOPGEN   3392
#define XCD_BAR_WORDS 3456
#define XB_SPIN_CAP (1u << 18)

__device__ __forceinline__ unsigned xb_ld(unsigned* p)              { return __hip_atomic_load(p, __ATOMIC_RELAXED, __HIP_MEMORY_SCOPE_AGENT); }
__device__ __forceinline__ unsigned xb_add(unsigned* p, unsigned v) { return __hip_atomic_fetch_add(p, v, __ATOMIC_RELAXED, __HIP_MEMORY_SCOPE_AGENT); }
__device__ __forceinline__ unsigned xb_xcc_id() { return (unsigned)__builtin_amdgcn_s_getreg((3 << 11) | 20) & 0xFu; }
#define XB_SPIN(cond, bar) do { unsigned _sp = 0; while (cond) { __builtin_amdgcn_s_sleep(1); \
    if ((++_sp & 255u) == 0u) { if (xb_ld(&(bar)[XB_TMO])) break; if (_sp > XB_SPIN_CAP) { atomicAdd(&(bar)[XB_TMO], 1u); break; } } } } while (0)

struct XcdBarrier {
    unsigned* bar; unsigned x;
    volatile LAS unsigned* st;
};

__device__ __forceinline__ XcdBarrier xcd_barrier_post(unsigned* bar, volatile LAS unsigned* st) {
    XcdBarrier b; b.bar = bar; b.x = xb_xcc_id(); b.st = st;
    if (threadIdx.x == 0) (void)xb_add(&bar[XB_XCNT(b.x)], 1u);
    return b;
}
__device__ __forceinline__ void xcd_barrier_complete(unsigned* bar, unsigned x, unsigned& nloc, unsigned& nx) {
    const unsigned G = gridDim.x * gridDim.y * gridDim.z;
    unsigned sum, cnt, mine, sp = 0u;
    for (;;) {
        sum = 0u; cnt = 0u; mine = 0u;
#pragma unroll
        for (unsigned j = 0; j < 16; ++j) { const unsigned c = xb_ld(&bar[XB_XCNT(j)]); sum += c; cnt += (c > 0u) ? 1u : 0u; mine = (j == x) ? c : mine; }
        if (sum == G) break;
        __builtin_amdgcn_s_sleep(1);
        if ((++sp & 255u) == 0u) { if (xb_ld(&bar[XB_TMO])) break; if (sp > XB_SPIN_CAP) { atomicAdd(&bar[XB_TMO], 1u); break; } }
    }
    nloc = mine > 0u ? mine : 1u; nx = cnt > 0u ? cnt : 1u;
}

__device__ __forceinline__ void xcd_barrier(const XcdBarrier& b) {
    asm volatile("s_waitcnt vmcnt(0)" ::: "memory");
    __syncthreads();
    if (threadIdx.x == 0) {
        unsigned* bar = b.bar;
        __builtin_amdgcn_s_waitcnt(0);
        unsigned nloc = b.st[0], nx = b.st[1];
        if (nloc == 0u) { xcd_barrier_complete(bar, b.x, nloc, nx); b.st[0] = nloc; b.st[1] = nx; }
        const unsigned old = xb_add(&bar[XB_XSUB(b.x)], 1u);
        const unsigned gen = old / nloc;
        if (old + 1u == (gen + 1u) * nloc) {
            __builtin_amdgcn_fence(__ATOMIC_RELEASE, "agent");
            asm volatile("s_waitcnt vmcnt(0)" ::: "memory");
            const unsigned og = xb_add(&bar[XB_TOP], 1u);
            const unsigned tg = og / nx;
            if (og + 1u == (tg + 1u) * nx) xb_add(&bar[XB_TOPGEN], 1u);
            else XB_SPIN(xb_ld(&bar[XB_TOPGEN]) == tg, bar);
            __builtin_amdgcn_fence(__ATOMIC_ACQUIRE, "agent");
            xb_add(&bar[XB_XGEN(b.x)], 1u);
            asm volatile("s_waitcnt vmcnt(0)" ::: "memory");
        } else {
            XB_SPIN(xb_ld(&bar[XB_XGEN(b.x)]) == gen, bar);
            __builtin_amdgcn_fence(__ATOMIC_ACQUIRE, "agent");
            asm volatile("s_waitcnt vmcnt(0)" ::: "memory");
        }
    }
    __syncthreads();
}
struct Args { const void* p[37]; int s_lo, s_hi, li, pad; };
#define AIN(a, k, zs) ((const float*)(a).p[(k) + (zs)])
#define AWS(a, zs) ((unsigned char*)(a).p[36 + (zs)])
#define AOUT(a, zs) ((float*)(a).p[35 + (zs)])
struct Frame {
    LAS unsigned char* lds;
    int tid, lane, wave, vcu, G, zs;
};
__device__ __forceinline__ int grpB(int g) { return g == 0 ? 32 : 8; }
__device__ __forceinline__ int grpL(int g) { return g == 0 ? 2048 : 8192; }
__device__ __forceinline__ int grpMem(int g) { return g == 0 ? 8192 : 2048; }

__device__ __forceinline__ void transpose_item(const float* W, int K, int N, bf16* WT, int mode, LAS float* scr, int item, int lane, const float* gk = nullptr) {
    const int nblk = N / 32, kb = item / nblk, nb = item % nblk, k0 = 64 * kb, n0 = 32 * nb;
#pragma unroll 8
    for (int i = 0; i < 32; ++i) { const int kk = 2 * i + (lane >> 5); scr[kk * 33 + (lane & 31)] = W[(size_t)(k0 + kk) * N + n0 + (lane & 31)]; }
    LDS_WAIT(); asm volatile("" ::: "memory");
    const int c = lane & 7;
    f32x4 g0 = (f32x4){1.f, 1.f, 1.f, 1.f}, g1 = g0;
    if (gk) { g0 = *(const GAS f32x4*)(gk + k0 + 8 * c); g1 = *(const GAS f32x4*)(gk + k0 + 8 * c + 4); }
#pragma unroll
    for (int j = 0; j < 4; ++j) { const int n = (lane >> 3) + 8 * j; const LAS float* s = scr + (8 * c) * 33 + n;
        u32x4 o; o.x = pkbf(s[0 * 33] * g0.x, s[1 * 33] * g0.y); o.y = pkbf(s[2 * 33] * g0.z, s[3 * 33] * g0.w); o.z = pkbf(s[4 * 33] * g1.x, s[5 * 33] * g1.y); o.w = pkbf(s[6 * 33] * g1.z, s[7 * 33] * g1.w);
        const int ng = n0 + n; const int dr = (mode == 0) ? ng : (8 * (ng >> 2) + (ng & 3) + (mode == 2 ? 4 : 0));
        *(GAS u32x4*)(WT + (size_t)dr * K + k0 + 8 * c) = o; }
    LDS_WAIT(); asm volatile("" ::: "memory");
}
__device__ __forceinline__ void phase_prologue(const Frame& F, const Args& a) {
    LAS float* scr = (LAS float*)(F.lds + F.wave * 16384);
    const int gw = F.vcu * NWAVES + F.wave, NGW = F.G * NWAVES;
    bf16* WB = (bf16*)(AWS(a, F.zs) + WS_W);
    constexpr int I_IN = 16 * 96, I_SQ = 16 * 32, I_G = 16 * 88, I_D = 44 * 32;
    constexpr int PER_LAYER = I_IN + 5 * I_SQ + 2 * I_G + I_D;
    for (int it = gw; it < DEPTH * PER_LAYER; it += NGW) {
        const int l = it / PER_LAYER; int r = it % PER_LAYER; bf16* wl = WB + (size_t)l * WL_STRIDE;
        if (r < I_IN) { transpose_item(AIN(a, 6, F.zs) + (size_t)l * 1024 * 3072, 1024, 3072, wl + WL_IN, 0, scr, r, F.lane, AIN(a, 4, F.zs) + l * DM); continue; } r -= I_IN;
        if (r < I_SQ) { transpose_item(AIN(a, 22, F.zs) + (size_t)l * 1024 * 1024, 1024, 1024, wl + WL_OUT, 0, scr, r, F.lane); continue; } r -= I_SQ;
        if (r < I_SQ) { transpose_item(AIN(a, 26, F.zs) + (size_t)l * 1024 * 1024, 1024, 1024, wl + WL_Q, 0, scr, r, F.lane, AIN(a, 23, F.zs) + l * DM); continue; } r -= I_SQ;
        if (r < I_SQ) { transpose_item(AIN(a, 27, F.zs) + (size_t)l * 1024 * 1024, 1024, 1024, wl + WL_K, 0, scr, r, F.lane); continue; } r -= I_SQ;
        if (r < I_SQ) { transpose_item(AIN(a, 28, F.zs) + (size_t)l * 1024 * 1024, 1024, 1024, wl + WL_V, 0, scr, r, F.lane); continue; } r -= I_SQ;
        if (r < I_SQ) { transpose_item(AIN(a, 29, F.zs) + (size_t)l * 1024 * 1024, 1024, 1024, wl + WL_O, 0, scr, r, F.lane); continue; } r -= I_SQ;
        if (r < I_G) { transpose_item(AIN(a, 32, F.zs) + (size_t)l * 1024 * DFF, 1024, DFF, wl + WL_GU, 1, scr, r, F.lane, AIN(a, 30, F.zs) + l * DM); continue; } r -= I_G;
        if (r < I_G) { transpose_item(AIN(a, 33, F.zs) + (size_t)l * 1024 * DFF, 1024, DFF, wl + WL_GU, 2, scr, r, F.lane, AIN(a, 30, F.zs) + l * DM); continue; } r -= I_G;
        transpose_item(AIN(a, 34, F.zs) + (size_t)l * DFF * 1024, DFF, 1024, wl + WL_D, 0, scr, r, F.lane);
    }
    float* tab = (float*)(AWS(a, F.zs) + WS_TAB);
    for (int i = F.vcu * NTHR + F.tid; i < 8192 * 8; i += F.G * NTHR) { const int pos = i >> 3, j = i & 7;
        const float inv = (float)pow(500000.0, -(double)j / 8.0); const float ang = (float)pos * inv;
        tab[pos * 16 + j] = (float)cos((double)ang); tab[pos * 16 + 8 + j] = (float)sin((double)ang); }
}

template <int R> __device__ __forceinline__ void rowop_rows(const float* xin, const bf16* sub, const float* gpost, float* xout, const float* gpre, bf16* hn, int m0, int rstride, int lane) {
    f32x4 v[R][4]; u32x2 sw[R][4];
#pragma unroll
    for (int r = 0; r < R; ++r) { const GAS f32x4* xr = (const GAS f32x4*)(xin + (size_t)(m0 + r * rstride) * DM) + lane;
#pragma unroll
        for (int j = 0; j < 4; ++j) v[r][j] = __builtin_nontemporal_load(xr + 64 * j); }
    if (sub) {
#pragma unroll
        for (int r = 0; r < R; ++r) { const GAS u32x2* sr = (const GAS u32x2*)(sub + (size_t)(m0 + r * rstride) * DM) + lane;
#pragma unroll
            for (int j = 0; j < 4; ++j) sw[r][j] = __builtin_nontemporal_load(sr + 64 * j); }
        f32x4 gp[4];
#pragma unroll
        for (int j = 0; j < 4; ++j) gp[j] = ((const GAS f32x4*)gpost + lane)[64 * j];
        float ss[R];
#pragma unroll
        for (int r = 0; r < R; ++r) { ss[r] = 0.f;
#pragma unroll
            for (int j = 0; j < 4; ++j) { const float a = bf_lo(sw[r][j].x), b = bf_hi(sw[r][j].x), c = bf_lo(sw[r][j].y), d = bf_hi(sw[r][j].y); ss[r] += (a * a + b * b) + (c * c + d * d); } }
#pragma unroll
        for (int r = 0; r < R; ++r) ss[r] = wave_sum(ss[r]);
#pragma unroll
        for (int r = 0; r < R; ++r) { const float rs = 1.0f / sqrtf(ss[r] * (1.f / DM) + EPS); GAS f32x4* xo = (GAS f32x4*)(xout + (size_t)(m0 + r * rstride) * DM) + lane;
#pragma unroll
            for (int j = 0; j < 4; ++j) { const f32x4 sv = (f32x4){bf_lo(sw[r][j].x), bf_hi(sw[r][j].x), bf_lo(sw[r][j].y), bf_hi(sw[r][j].y)};
                v[r][j] = v[r][j] + (sv * rs) * gp[j]; __builtin_nontemporal_store(v[r][j], xo + 64 * j); } }
    }
    if (hn) {
        f32x4 gq[4];
#pragma unroll
        for (int j = 0; j < 4; ++j) gq[j] = ((const GAS f32x4*)gpre + lane)[64 * j];
        float ss[R];
#pragma unroll
        for (int r = 0; r < R; ++r) { ss[r] = 0.f;
#pragma unroll
            for (int j = 0; j < 4; ++j) ss[r] += (v[r][j].x * v[r][j].x + v[r][j].y * v[r][j].y) + (v[r][j].z * v[r][j].z + v[r][j].w * v[r][j].w); }
#pragma unroll
        for (int r = 0; r < R; ++r) ss[r] = wave_sum(ss[r]);
#pragma unroll
        for (int r = 0; r < R; ++r) { const float rs = 1.0f / sqrtf(ss[r] * (1.f / DM) + EPS); GAS u32x2* ho = (GAS u32x2*)(hn + (size_t)(m0 + r * rstride) * DM) + lane;
#pragma unroll
            for (int j = 0; j < 4; ++j) { const f32x4 o = (v[r][j] * rs) * gq[j]; u32x2 w; w.x = pkbf(o.x, o.y); w.y = pkbf(o.z, o.w); ho[64 * j] = w; } }
    }
}

__device__ __forceinline__ void unpack8(const u32x4 w, float (&f)[8]) { f[0] = bf_lo(w.x); f[1] = bf_hi(w.x); f[2] = bf_lo(w.y); f[3] = bf_hi(w.y); f[4] = bf_lo(w.z); f[5] = bf_hi(w.z); f[6] = bf_lo(w.w); f[7] = bf_hi(w.w); }
__device__ __forceinline__ u32x4 pack8(const float (&f)[8]) { return (u32x4){pkbf(f[0], f[1]), pkbf(f[2], f[3]), pkbf(f[4], f[5]), pkbf(f[6], f[7])}; }
template <int MODE, int R> __device__ __forceinline__ void rowop_bf(const float* xf, bf16* xb, const bf16* sub, const float* gpost, float* rsout, float* outf, int m0, int rstride, int lane, bf16* xbo = nullptr) {
    if (!xbo) xbo = xb;
    f32x4 xr[MODE == 0 ? R : 1][4]; u32x4 xw[MODE == 0 ? 1 : R][2], sw[MODE == 0 ? 1 : R][2];
    if (MODE == 0) {
#pragma unroll
        for (int r = 0; r < R; ++r) { const GAS f32x4* p = (const GAS f32x4*)(xf + (size_t)(m0 + r * rstride) * DM) + 2 * lane;
            xr[r][0] = __builtin_nontemporal_load(p); xr[r][1] = __builtin_nontemporal_load(p + 1); xr[r][2] = __builtin_nontemporal_load(p + 128); xr[r][3] = __builtin_nontemporal_load(p + 129); }
    } else {
#pragma unroll
        for (int r = 0; r < R; ++r) { const GAS u32x4* p = (const GAS u32x4*)(xb + (size_t)(m0 + r * rstride) * DM) + lane; xw[r][0] = p[0]; xw[r][1] = p[64];
            const GAS u32x4* q = (const GAS u32x4*)(sub + (size_t)(m0 + r * rstride) * DM) + lane; sw[r][0] = __builtin_nontemporal_load(q); sw[r][1] = __builtin_nontemporal_load(q + 64); }
    }
    float g[16];
    if (MODE != 0) { const GAS f32x4* gp = (const GAS f32x4*)gpost + 2 * lane; const f32x4 a = gp[0], b = gp[1], c = gp[128], d = gp[129];
        g[0] = a.x; g[1] = a.y; g[2] = a.z; g[3] = a.w; g[4] = b.x; g[5] = b.y; g[6] = b.z; g[7] = b.w; g[8] = c.x; g[9] = c.y; g[10] = c.z; g[11] = c.w; g[12] = d.x; g[13] = d.y; g[14] = d.z; g[15] = d.w; }
#pragma unroll
    for (int r = 0; r < R; ++r) {
        const int m = m0 + r * rstride; float x[16];
        if (MODE == 0) {
#pragma unroll
            for (int j = 0; j < 4; ++j) { x[4 * j] = xr[r][j].x; x[4 * j + 1] = xr[r][j].y; x[4 * j + 2] = xr[r][j].z; x[4 * j + 3] = xr[r][j].w; }
        } else {
            float s0[8], s1[8], x0[8], x1[8]; unpack8(sw[r][0], s0); unpack8(sw[r][1], s1); unpack8(xw[r][0], x0); unpack8(xw[r][1], x1);
            float ss = 0.f;
#pragma unroll
            for (int j = 0; j < 8; ++j) ss += s0[j] * s0[j] + s1[j] * s1[j];
            const float rs = 1.0f / sqrtf(wave_sum(ss) * (1.f / DM) + EPS);
#pragma unroll
            for (int j = 0; j < 8; ++j) { x[j] = x0[j] + (s0[j] * rs) * g[j]; x[8 + j] = x1[j] + (s1[j] * rs) * g[8 + j]; }
        }
        if (MODE == 2) {
            GAS f32x4* p = (GAS f32x4*)(outf + (size_t)m * DM) + 2 * lane;
            __builtin_nontemporal_store((f32x4){x[0], x[1], x[2], x[3]}, p); __builtin_nontemporal_store((f32x4){x[4], x[5], x[6], x[7]}, p + 1);
            __builtin_nontemporal_store((f32x4){x[8], x[9], x[10], x[11]}, p + 128); __builtin_nontemporal_store((f32x4){x[12], x[13], x[14], x[15]}, p + 129);
        } else {
            float ss = 0.f;
#pragma unroll
            for (int j = 0; j < 16; ++j) ss += x[j] * x[j];
            ss = wave_sum(ss);
            GAS u32x4* p = (GAS u32x4*)(xbo + (size_t)m * DM) + lane; float a[8], b[8];
#pragma unroll
            for (int j = 0; j < 8; ++j) { a[j] = x[j]; b[j] = x[8 + j]; }
            p[0] = pack8(a); p[64] = pack8(b);
            if (lane == 0) rsout[m] = 1.0f / sqrtf(ss * (1.f / DM) + EPS);
        }
    }
}
__device__ __forceinline__ f32x2 cmul(f32x2 a, f32x2 b) { return (f32x2){a.x * b.x - a.y * b.y, a.x * b.y + a.y * b.x}; }
__device__ __forceinline__ f32x2 twid(float ph) { return (f32x2){__builtin_amdgcn_cosf(ph), -__builtin_amdgcn_sinf(ph)}; }
#define ZI(i) ((i) ^ (((i) >> 4) & 15))
template <bool INV> __device__ __forceinline__ void r4bf(f32x2& a0, f32x2& a1, f32x2& a2, f32x2& a3, float ph) {
    if (!INV) {
        const f32x2 t0 = a0 + a2, t1 = a0 - a2, t2 = a1 + a3, d = a1 - a3; const f32x2 t3 = (f32x2){d.y, -d.x};
        a0 = t0 + t2; a1 = cmul(t1 + t3, twid(ph)); a2 = cmul(t0 - t2, twid(2.f * ph)); a3 = cmul(t1 - t3, twid(3.f * ph));
    } else {
        f32x2 w1 = twid(ph), w2 = twid(2.f * ph), w3 = twid(3.f * ph); w1.y = -w1.y; w2.y = -w2.y; w3.y = -w3.y;
        const f32x2 b1 = cmul(a1, w1), b2 = cmul(a2, w2), b3 = cmul(a3, w3);
        const f32x2 t0 = a0 + b2, t1 = a0 - b2, t2 = b1 + b3, d = b1 - b3; const f32x2 t3 = (f32x2){-d.y, d.x};
        a0 = t0 + t2; a1 = t1 + t3; a2 = t0 - t2; a3 = t1 - t3;
    }
}
template <int LOGN, int NSEQ, int LS, bool INV, bool ZHALF> __device__ __forceinline__ void fft_pass16(LAS f32x2* z, int tid_in) {
    int tid = tid_in; asm volatile("" : "+v"(tid));
    constexpr int N = 1 << LOGN, NB = NSEQ * (N / 16), IT = (NB + NTHR - 1) / NTHR, s = 1 << LS;
#pragma unroll 1
    for (int jb = 0; jb < IT; ++jb) {
        const int j = tid + jb * NTHR;
        if (NB % NTHR == 0 || j < NB) {
            const int q = j >> (LOGN - 4), jj = j & (N / 16 - 1), k = jj & (s - 1), base = ((jj >> LS) << (LS + 4)) + k;
            LAS f32x2* zq = z + q * N;
            f32x2 a[16];
#pragma unroll
            for (int m = 0; m < 16; ++m) { if (ZHALF && !INV && m >= 8) a[m] = (f32x2){0.f, 0.f}; else a[m] = zq[ZI(base + m * s)]; }
            const float phb = (float)k * (1.0f / (float)(4 * s));
            if (!INV) {
#pragma unroll
                for (int r = 0; r < 4; ++r) r4bf<false>(a[r], a[r + 4], a[r + 8], a[r + 12], (float)(k + r * s) * (1.0f / (float)(16 * s)));
#pragma unroll
                for (int p = 0; p < 4; ++p) r4bf<false>(a[4 * p], a[4 * p + 1], a[4 * p + 2], a[4 * p + 3], phb);
            } else {
#pragma unroll
                for (int p = 0; p < 4; ++p) r4bf<true>(a[4 * p], a[4 * p + 1], a[4 * p + 2], a[4 * p + 3], phb);
#pragma unroll
                for (int r = 0; r < 4; ++r) r4bf<true>(a[r], a[r + 4], a[r + 8], a[r + 12], (float)(k + r * s) * (1.0f / (float)(16 * s)));
            }
#pragma unroll
            for (int m = 0; m < 16; ++m) { if (!(ZHALF && INV && m >= 8)) zq[ZI(base + m * s)] = a[m]; }
        }
    }
    __syncthreads();
}
template <int LOGN, int NSEQ, bool INV> __device__ __forceinline__ void fft_pass4s1(LAS f32x2* z, int tid_in) {
    int tid = tid_in; asm volatile("" : "+v"(tid));
    constexpr int N = 1 << LOGN, NB = NSEQ * (N / 4), IT = NB / NTHR, BT = 4;
    static_assert(IT % BT == 0, "span-1 stage: whole batches");
#pragma unroll 1
    for (int jb = 0; jb < IT; jb += BT) {
        f32x2 a[BT][4]; int idx[BT];
#pragma unroll
        for (int b = 0; b < BT; ++b) { const int j = tid + (jb + b) * NTHR; idx[b] = (j >> (LOGN - 2)) * N + 4 * (j & (N / 4 - 1));
#pragma unroll
            for (int qq = 0; qq < 4; ++qq) a[b][qq] = z[(idx[b] & ~(N - 1)) + ZI((idx[b] & (N - 1)) + qq)]; }
#pragma unroll
        for (int b = 0; b < BT; ++b) { r4bf<INV>(a[b][0], a[b][1], a[b][2], a[b][3], 0.f);
#pragma unroll
            for (int qq = 0; qq < 4; ++qq) z[(idx[b] & ~(N - 1)) + ZI((idx[b] & (N - 1)) + qq)] = a[b][qq]; }
    }
    __syncthreads();
}
template <int LOGN, int NSEQ, bool ZPAD> __device__ __forceinline__ void fft_fwd(LAS f32x2* z, int tid) {
    static_assert(LOGN == 12 || LOGN == 14, "sizes in use");
    if constexpr (LOGN == 14) { fft_pass16<14, NSEQ, 10, false, ZPAD>(z, tid); fft_pass16<14, NSEQ, 6, false, false>(z, tid); fft_pass16<14, NSEQ, 2, false, false>(z, tid); fft_pass4s1<14, NSEQ, false>(z, tid); }
    else { fft_pass16<12, NSEQ, 8, false, ZPAD>(z, tid); fft_pass16<12, NSEQ, 4, false, false>(z, tid); fft_pass16<12, NSEQ, 0, false, false>(z, tid); }
}
template <int LOGN, int NSEQ, bool ZPAD> __device__ __forceinline__ void fft_inv(LAS f32x2* z, int tid) {
    if constexpr (LOGN == 14) { fft_pass4s1<14, NSEQ, true>(z, tid); fft_pass16<14, NSEQ, 2, true, false>(z, tid); fft_pass16<14, NSEQ, 6, true, false>(z, tid); fft_pass16<14, NSEQ, 10, true, ZPAD>(z, tid); }
    else { fft_pass16<12, NSEQ, 0, true, false>(z, tid); fft_pass16<12, NSEQ, 4, true, false>(z, tid); fft_pass16<12, NSEQ, 8, true, ZPAD>(z, tid); }
}

__device__ __forceinline__ float sin_rev(float x) { return __builtin_amdgcn_sinf(x * 0.15915494309189535f); }
__device__ __forceinline__ float cos_rev(float x) { return __builtin_amdgcn_cosf(x * 0.15915494309189535f); }
__device__ __forceinline__ void filt_f1_item(const Frame& F, const Args& a, int l, int L, int item) {
    LAS float* zf = (LAS float*)F.lds;
    LAS float* h1 = zf + 33 * 64;
    LAS float* h2 = h1 + 64 * 64;
    LAS float* w3s = h2 + 64 * 64;
    const int jc = item >> 2, ch = item & 3, j0 = jc * 64, tid = F.tid, j = tid & 63, wv = F.wave, lane = F.lane;
    const float* w1 = AIN(a, 14, F.zs) + (size_t)l * 33 * 64; const float* b1 = AIN(a, 15, F.zs) + l * 64; const float* fr1 = AIN(a, 16, F.zs) + l * 64;
    const float* w2 = AIN(a, 17, F.zs) + (size_t)l * 64 * 64; const float* b2 = AIN(a, 18, F.zs) + l * 64; const float* fr2 = AIN(a, 19, F.zs) + l * 64;
    const float* w3 = AIN(a, 20, F.zs) + (size_t)l * 64 * 1024;
    const int jj = j0 + j; const float tj = (float)jj / (float)(L - 1);
    {
        const float w = (6.283185307179586f * (float)jj) / (float)L;
#pragma unroll
        for (int q = 0; q < 2; ++q) { const int m = 2 * wv + q; const float f = 1e-4f + (float)m * ((15.0f - 1e-4f) / 15.0f); const float fw = f * w;
            zf[(1 + m) * 64 + j] = cos_rev(fw); zf[(17 + m) * 64 + j] = -sin_rev(fw); }
        if (wv == 0) zf[j] = tj;
    }
    __syncthreads();
#pragma unroll 1
    for (int q = 0; q < 8; ++q) { const int o = wv * 8 + q; const float wl = (lane < 33) ? w1[lane * 64 + o] : 0.f; float acc = b1[o];
#pragma unroll
        for (int i = 0; i < 33; ++i) { const float wi = __builtin_bit_cast(float, __builtin_amdgcn_readlane(__builtin_bit_cast(int, wl), i)); const float zv = zf[i * 64 + j];
            asm("v_fmac_f32 %0, %1, %2" : "+v"(acc) : "v"(zv), "v"(wi)); }
        h1[o * 64 + j] = sin_rev(fr1[o] * acc); }
    __syncthreads();
#pragma unroll 1
    for (int q = 0; q < 8; ++q) { const int o = wv * 8 + q; const float wl = w2[lane * 64 + o]; float acc = b2[o];
#pragma unroll
        for (int i = 0; i < 64; ++i) { const float wi = __builtin_bit_cast(float, __builtin_amdgcn_readlane(__builtin_bit_cast(int, wl), i)); const float hv = h1[i * 64 + j];
            asm("v_fmac_f32 %0, %1, %2" : "+v"(acc) : "v"(hv), "v"(wi)); if ((i & 7) == 7) __builtin_amdgcn_sched_barrier(0); }
        h2[o * 64 + j] = sin_rev(fr2[o] * acc); }
    __syncthreads();
    float* KT = (float*)(AWS(a, F.zs) + WS_KERNT);
    float hreg[64];
#pragma unroll
    for (int i = 0; i < 64; ++i) hreg[i] = h2[i * 64 + j];
    LAS float* ws_ = w3s + wv * (64 * 16);
#pragma unroll 1
    for (int cc = 0; cc < 2; ++cc) {
        const int col0 = ch * 256 + wv * 32 + cc * 16;
        { const GAS f32x4* src = (const GAS f32x4*)(w3 + (size_t)lane * 1024 + col0);
          const f32x4 a0 = src[0], a1 = src[1], a2 = src[2], a3 = src[3];
          LAS f32x4* dst = (LAS f32x4*)(ws_ + lane * 16); dst[0] = a0; dst[1] = a1; dst[2] = a2; dst[3] = a3; }
        LDS_WAIT(); asm volatile("" ::: "memory");
#pragma unroll 1
        for (int c4 = 0; c4 < 4; ++c4) {
            float acc[4] = {0.f, 0.f, 0.f, 0.f};
#pragma unroll
            for (int kb = 0; kb < 8; ++kb) { f32x4 wv_[8];
#pragma unroll
                for (int u = 0; u < 8; ++u) wv_[u] = *(const LAS f32x4*)(ws_ + (kb * 8 + u) * 16 + c4 * 4);
#pragma unroll
                for (int u = 0; u < 8; ++u) { const float h_ = hreg[kb * 8 + u];
                    asm("v_fmac_f32 %0, %1, %2" : "+v"(acc[0]) : "v"(wv_[u].x), "v"(h_)); asm("v_fmac_f32 %0, %1, %2" : "+v"(acc[1]) : "v"(wv_[u].y), "v"(h_));
                    asm("v_fmac_f32 %0, %1, %2" : "+v"(acc[2]) : "v"(wv_[u].z), "v"(h_)); asm("v_fmac_f32 %0, %1, %2" : "+v"(acc[3]) : "v"(wv_[u].w), "v"(h_)); }
                __builtin_amdgcn_sched_barrier(0); }
#pragma unroll
            for (int e = 0; e < 4; ++e) { const int col = col0 + c4 * 4 + e; const int c = col & 511;
                const float delta = 3.0701134573253944f + (float)c * ((15.350567286626972f - 3.0701134573253944f) / 511.0f);
                KT[(size_t)col * 8192 + jj] = acc[e] * __builtin_amdgcn_exp2f(-tj * delta * 1.4426950408889634f); }
        }
        LDS_WAIT(); asm volatile("" ::: "memory");
    }
    __syncthreads();
}
template <int LOGN> __device__ __forceinline__ void filt_f2_item(const Frame& F, const Args& a, int l, int c) {
    constexpr int N = 1 << LOGN, L = N / 2;
    LAS f32x2* z = (LAS f32x2*)F.lds; LAS float* red = (LAS float*)(F.lds + LDS_MISC + 64);
    const float* KT = (const float*)(AWS(a, F.zs) + WS_KERNT); const float* hf = KT + (size_t)c * 8192; const float* hb = KT + (size_t)(512 + c) * 8192;
    const int tid = F.tid; float asum = 0.f;
    for (int j = tid; j < L; j += NTHR) { const float f = hf[j], b = hb[j];
        if (j == 0) { z[ZI(0)] = (f32x2){f + b, 0.f}; z[ZI(L)] = (f32x2){0.f, 0.f}; asum += fabsf(f + b); }
        else { z[ZI(j)] = (f32x2){f, 0.f}; z[ZI(N - j)] = (f32x2){b, 0.f}; asum += fabsf(f) + fabsf(b); } }
    asum = wave_sum(asum); if (F.lane == 0) red[F.wave] = asum;
    __syncthreads();
    float S = 0.f;
#pragma unroll
    for (int w = 0; w < NWAVES; ++w) S += red[w];
    fft_fwd<LOGN, 1, false>(z, tid);
    const float dsk = AIN(a, 21, F.zs)[l * 512 + c]; const float rS = 1.0f / S, rN = 1.0f / (float)N;
    f32x2* KF = (f32x2*)(AWS(a, F.zs) + WS_KF) + (size_t)c * N;
    for (int i = tid; i < N; i += NTHR) { const f32x2 v = z[i]; KF[i] = (f32x2){(v.x * rS + dsk) * rN, (v.y * rS) * rN}; }
    __syncthreads();
}

struct Chunk8 { u32x4 v; unsigned short pm, pp; };
__device__ __forceinline__ Chunk8 ld_chunk(const bf16* row, int ci, int nch) {
    Chunk8 c; c.v = *(const GAS u32x4*)(row + 8 * ci);
    c.pm = (ci > 0) ? *(const GAS unsigned short*)(row + 8 * ci - 1) : (unsigned short)0;
    c.pp = (ci + 1 < nch) ? *(const GAS unsigned short*)(row + 8 * ci + 8) : (unsigned short)0;
    return c;
}
__device__ __forceinline__ void conv8(const Chunk8& c, float w0, float w1, float w2, float b, float (&o)[8]) {
    float e[10]; e[0] = bf1(c.pm); e[9] = bf1(c.pp);
    e[1] = bf_lo(c.v.x); e[2] = bf_hi(c.v.x); e[3] = bf_lo(c.v.y); e[4] = bf_hi(c.v.y); e[5] = bf_lo(c.v.z); e[6] = bf_hi(c.v.z); e[7] = bf_lo(c.v.w); e[8] = bf_hi(c.v.w);
#pragma unroll
    for (int i = 0; i < 8; ++i) o[i] = w0 * e[i] + w1 * e[i + 1] + w2 * e[i + 2] + b;
}
template <int LOGN, int NSEQ> __device__ __forceinline__ void hyena_unit(const Frame& F, const Args& a, int l, int c, int p0) {
    constexpr int N = 1 << LOGN, L = N / 2, LOGCH = LOGN - 4, NCH = 1 << LOGCH, CPT = (NSEQ * NCH) / NTHR;
    static_assert(CPT * NTHR == NSEQ * NCH, "chunks divide evenly");
    LAS f32x2* z = (LAS f32x2*)F.lds; const int tid = F.tid;
    const bf16* VHT = (const bf16*)(AWS(a, F.zs) + WS_VHT);
    const float* cw = AIN(a, 12, F.zs) + (size_t)l * 3 * 1536; const float* cb = AIN(a, 13, F.zs) + l * 1536;
    const bf16* x0r = VHT + (size_t)(512 + c) * TOK + (size_t)(2 * p0) * L;
    const bf16* x1r = VHT + (size_t)(1024 + c) * TOK + (size_t)(2 * p0) * L;
    const bf16* vhr = VHT + (size_t)(1536 + c) * TOK + (size_t)(2 * p0) * L;
    const float a0 = cw[c], a1 = cw[1536 + c], a2 = cw[3072 + c], ab = cb[c];
    const float b0 = cw[512 + c], b1 = cw[1536 + 512 + c], b2 = cw[3072 + 512 + c], bb = cb[512 + c];
    const float c0 = cw[1024 + c], c1 = cw[1536 + 1024 + c], c2 = cw[3072 + 1024 + c], cbb = cb[1024 + c];
    constexpr int KPT = (N / 2) / NTHR; f32x4 kreg[KPT];
    {
        Chunk8 q1a[CPT], qva[CPT], q1b[CPT], qvb[CPT];
#pragma unroll
        for (int i = 0; i < CPT; ++i) { const int cg = tid + NTHR * i, q = cg >> LOGCH, ci = cg & (NCH - 1); const size_t ro = (size_t)(2 * q) * L;
            q1a[i] = ld_chunk(x1r + ro, ci, NCH); qva[i] = ld_chunk(vhr + ro, ci, NCH); q1b[i] = ld_chunk(x1r + ro + L, ci, NCH); qvb[i] = ld_chunk(vhr + ro + L, ci, NCH); }
#pragma unroll
        for (int i = 0; i < CPT; ++i) { const int cg = tid + NTHR * i, q = cg >> LOGCH, ci = cg & (NCH - 1);
            float xa[8], va[8], xb[8], vb[8]; conv8(q1a[i], b0, b1, b2, bb, xa); conv8(qva[i], c0, c1, c2, cbb, va); conv8(q1b[i], b0, b1, b2, bb, xb); conv8(qvb[i], c0, c1, c2, cbb, vb);
            const bool swp = (ci >> 1) & 1;
#pragma unroll
            for (int j = 0; j < 4; ++j) { const f32x2 e0 = (f32x2){xa[2 * j] * va[2 * j], xb[2 * j] * vb[2 * j]}, e1 = (f32x2){xa[2 * j + 1] * va[2 * j + 1], xb[2 * j + 1] * vb[2 * j + 1]};
                *(LAS f32x4*)(z + q * N + (ZI(8 * ci + 2 * j) & ~1)) = swp ? (f32x4){e1.x, e1.y, e0.x, e0.y} : (f32x4){e0.x, e0.y, e1.x, e1.y}; } }
    }
    __syncthreads();
#define HY_LOADK() do { const f32x2* KF = (const f32x2*)(AWS(a, F.zs) + WS_KF) + (size_t)c * N; \
        _Pragma("unroll") for (int ii = 0; ii < KPT; ++ii) kreg[ii] = *(const GAS f32x4*)(KF + 2 * (tid + NTHR * ii)); } while (0)
    if constexpr (LOGN == 14) { fft_pass16<14, NSEQ, 10, false, true>(z, tid); fft_pass16<14, NSEQ, 6, false, false>(z, tid); fft_pass16<14, NSEQ, 2, false, false>(z, tid); HY_LOADK(); fft_pass4s1<14, NSEQ, false>(z, tid); }
    else { fft_pass16<12, NSEQ, 8, false, true>(z, tid); fft_pass16<12, NSEQ, 4, false, false>(z, tid); HY_LOADK(); fft_pass16<12, NSEQ, 0, false, false>(z, tid); }
#undef HY_LOADK
#pragma unroll
    for (int ii = 0; ii < KPT; ++ii) { const int i = tid + NTHR * ii; const f32x4 k = kreg[ii];
#pragma unroll
        for (int q = 0; q < NSEQ; ++q) { const f32x4 v = *(LAS f32x4*)(z + q * N + 2 * i);
            *(LAS f32x4*)(z + q * N + 2 * i) = (f32x4){v.x * k.x - v.y * k.y, v.x * k.y + v.y * k.x, v.z * k.z - v.w * k.w, v.z * k.w + v.w * k.z}; } }
    __syncthreads();
    Chunk8 q0a[CPT], q0b[CPT];
#define HY_LOADX0() do { _Pragma("unroll") for (int i = 0; i < CPT; ++i) { const int cg = tid + NTHR * i, q = cg >> LOGCH, ci = cg & (NCH - 1); const size_t ro = (size_t)(2 * q) * L; \
        q0a[i] = ld_chunk(x0r + ro, ci, NCH); q0b[i] = ld_chunk(x0r + ro + L, ci, NCH); } } while (0)
    if constexpr (LOGN == 14) { fft_pass4s1<14, NSEQ, true>(z, tid); fft_pass16<14, NSEQ, 2, true, false>(z, tid); fft_pass16<14, NSEQ, 6, true, false>(z, tid); HY_LOADX0(); fft_pass16<14, NSEQ, 10, true, true>(z, tid); }
    else { fft_pass16<12, NSEQ, 0, true, false>(z, tid); fft_pass16<12, NSEQ, 4, true, false>(z, tid); HY_LOADX0(); fft_pass16<12, NSEQ, 8, true, true>(z, tid); }
#undef HY_LOADX0
    bf16* YT = (bf16*)(AWS(a, F.zs) + WS_YT) + (size_t)c * TOK + (size_t)(2 * p0) * L;
    {
#pragma unroll
        for (int i = 0; i < CPT; ++i) { const int cg = tid + NTHR * i, q = cg >> LOGCH, ci = cg & (NCH - 1); const size_t ro = (size_t)(2 * q) * L;
            float ga[8], gb[8]; conv8(q0a[i], a0, a1, a2, ab, ga); conv8(q0b[i], a0, a1, a2, ab, gb);
            float ya[8], yb[8];
            const bool swp = (ci >> 1) & 1;
#pragma unroll
            for (int j = 0; j < 4; ++j) { f32x4 v = *(LAS f32x4*)(z + q * N + (ZI(8 * ci + 2 * j) & ~1)); if (swp) v = (f32x4){v.z, v.w, v.x, v.y};
                ya[2 * j] = v.x * ga[2 * j]; yb[2 * j] = v.y * gb[2 * j]; ya[2 * j + 1] = v.z * ga[2 * j + 1]; yb[2 * j + 1] = v.w * gb[2 * j + 1]; }
            *(GAS u32x4*)(YT + ro + 8 * ci) = (u32x4){pkbf(ya[0], ya[1]), pkbf(ya[2], ya[3]), pkbf(ya[4], ya[5]), pkbf(ya[6], ya[7])};
            *(GAS u32x4*)(YT + ro + L + 8 * ci) = (u32x4){pkbf(yb[0], yb[1]), pkbf(yb[2], yb[3]), pkbf(yb[4], yb[5]), pkbf(yb[6], yb[7])}; }
    }
    __syncthreads();
}
__device__ __forceinline__ void ytrans_tile(const Frame& F, const Args& a, int tile) {
    LAS bf16* sm = (LAS bf16*)F.lds;
    const int cb = tile & 7, tb = tile >> 3, tid = F.tid;
    const bf16* YT = (const bf16*)(AWS(a, F.zs) + WS_YT); bf16* MIX = (bf16*)(AWS(a, F.zs) + WS_MIX);
    { const int c = tid >> 3, ch = tid & 7; const u32x4 v = *(const GAS u32x4*)(YT + (size_t)(cb * 64 + c) * TOK + (size_t)tb * 64 + ch * 8);
      *(LAS u32x4*)(sm + c * 72 + ch * 8) = v; }
    __syncthreads();
    { const int t = tid >> 3, cc = tid & 7; unsigned w[4];
#pragma unroll
      for (int q = 0; q < 4; ++q) { const unsigned lo = sm[(cc * 8 + 2 * q) * 72 + t], hi = sm[(cc * 8 + 2 * q + 1) * 72 + t]; w[q] = lo | (hi << 16); }
      *(GAS u32x4*)(MIX + (size_t)(tb * 64 + t) * 1024 + 512 + cb * 64 + cc * 8) = (u32x4){w[0], w[1], w[2], w[3]}; }
    __syncthreads();
}
__device__ __forceinline__ int crow(int r, int hi) { return (r & 3) + 8 * (r >> 2) + 4 * hi; }
template <bool DIFF> struct AttnCfg {
    static constexpr int DQK = DIFF ? 64 : 256, KW = DIFF ? 128 : 256, VR = DIFF ? 128 : 256;
    static constexpr int KROWB = KW * 2 + 16, VROWB = 136, KBYTES = 64 * KROWB, VBYTES = VR * VROWB, STAGE = KBYTES + VBYTES;
    static constexpr int NKP = 64 * (KW / 8) / NTHR, NVP = VR * 8 / NTHR, NKS = DQK / 16;
};
struct AttnPtrs {
    const bf16* Q; int ldq;
    const bf16* K; int ldk;
    const bf16* VT; size_t ldv;
    int nkeys;
    bf16* O; int ldo;
};
template <bool DIFF> __device__ __forceinline__ void attn_unit(const Frame& F, const AttnPtrs& P, float lam, float outscale, const float* subg) {
    typedef AttnCfg<DIFF> C;
    const int tid = F.tid, lane = F.lane, wid = F.wave, r32 = lane & 31, hi = lane >> 5, qsub = wid >> 1, role = wid & 1;
    LAS unsigned char* lds = F.lds;
#ifndef XQ_REGS
#define XQ_REGS 0
#endif
    constexpr bool QREG = DIFF || XQ_REGS;
    bf16x8 qf[QREG ? C::NKS : 1];
    const bf16* qp = P.Q + (size_t)(qsub * 32 + r32) * P.ldq + (DIFF ? role * 64 : 0) + hi * 8;
    if constexpr (QREG) {
#pragma unroll
      for (int ks = 0; ks < C::NKS; ++ks) qf[ks] = *(const GAS bf16x8*)(qp + ks * 16); }
    u32x4 kst[C::NKP];
    const int NT = P.nkeys / 64;
#define ATT_LOADK(t) do { \
        _Pragma("unroll") for (int i = 0; i < C::NKP; ++i) { const int p = tid + NTHR * i, key = p / (C::KW / 8), ch = p % (C::KW / 8); \
            kst[i] = *(const GAS u32x4*)(P.K + (size_t)((t) * 64 + key) * P.ldk + ch * 8); } } while (0)
#define ATT_LOADV(t) do { \
        _Pragma("unroll") for (int i = 0; i < C::NVP; ++i) { const int p = tid + NTHR * i, row = p >> 3, ch = p & 7; \
            kst[i] = *(const GAS u32x4*)(P.VT + (size_t)row * P.ldv + (size_t)(t) * 64 + ch * 8); } } while (0)
#define ATT_STOREK(buf) do { LAS unsigned char* kb_ = lds + (buf) * C::STAGE; \
        _Pragma("unroll") for (int i = 0; i < C::NKP; ++i) { const int p = tid + NTHR * i, key = p / (C::KW / 8), ch = p % (C::KW / 8); \
            *(LAS u32x4*)(kb_ + key * C::KROWB + ch * 16) = kst[i]; } } while (0)
#define ATT_STOREV(buf) do { LAS unsigned char* vb_ = lds + (buf) * C::STAGE + C::KBYTES; \
        _Pragma("unroll") for (int i = 0; i < C::NVP; ++i) { const int p = tid + NTHR * i, row = p >> 3, ch = p & 7; \
            *(LAS u32x2*)(vb_ + row * C::VROWB + ch * 16) = (u32x2){kst[i].x, kst[i].y}; *(LAS u32x2*)(vb_ + row * C::VROWB + ch * 16 + 8) = (u32x2){kst[i].z, kst[i].w}; } } while (0)
    static_assert(C::NKP == C::NVP, "one staging register set serves K then V");
    ATT_LOADK(0); ATT_STOREK(0); ATT_LOADV(0); ATT_STOREV(0);
    __syncthreads();
    f32x16 o[4];
#pragma unroll
    for (int d = 0; d < 4; ++d) o[d] = (f32x16){0.f, 0.f, 0.f, 0.f, 0.f, 0.f, 0.f, 0.f, 0.f, 0.f, 0.f, 0.f, 0.f, 0.f, 0.f, 0.f};
    float mrun = -INFINITY, lrun = 0.f;
    const int koff = (DIFF ? role * 64 : 0) * 2 + hi * 16, vroff = (DIFF ? 0 : role * 128);
#pragma unroll 1
    for (int t = 0; t < NT; ++t) {
        if (t + 1 < NT) ATT_LOADK(t + 1);
        const LAS unsigned char* kb = lds + (t & 1) * C::STAGE; const LAS unsigned char* vb = kb + C::KBYTES;
        f32x16 s0 = (f32x16){0.f, 0.f, 0.f, 0.f, 0.f, 0.f, 0.f, 0.f, 0.f, 0.f, 0.f, 0.f, 0.f, 0.f, 0.f, 0.f}, s1 = s0;
        int zo = 0; if constexpr (!QREG) asm volatile("" : "+v"(zo));
#pragma unroll
        for (int ks = 0; ks < C::NKS; ++ks) {
            const bf16x8 a0 = *(const LAS bf16x8*)(kb + r32 * C::KROWB + koff + ks * 32);
            const bf16x8 a1 = *(const LAS bf16x8*)(kb + (32 + r32) * C::KROWB + koff + ks * 32);
            bf16x8 qv; if constexpr (QREG) qv = qf[ks]; else qv = *(const GAS bf16x8*)(qp + ks * 16 + zo);
            s0 = __builtin_amdgcn_mfma_f32_32x32x16_bf16(a0, qv, s0, 0, 0, 0);
            s1 = __builtin_amdgcn_mfma_f32_32x32x16_bf16(a1, qv, s1, 0, 0, 0);
        }
        if (t + 1 < NT) { ATT_STOREK((t + 1) & 1); ATT_LOADV(t + 1); }
        float mx = fmaxf(s0[0], s1[0]);
#pragma unroll
        for (int r = 1; r < 16; ++r) mx = fmaxf(mx, fmaxf(s0[r], s1[r]));
        mx = fmaxf(mx, __shfl_xor(mx, 32));
        const float mnew = fmaxf(mrun, mx), alpha = __builtin_amdgcn_exp2f(mrun - mnew); mrun = mnew;
        float rs = 0.f;
#pragma unroll
        for (int r = 0; r < 16; ++r) { s0[r] = __builtin_amdgcn_exp2f(s0[r] - mnew); s1[r] = __builtin_amdgcn_exp2f(s1[r] - mnew); rs += s0[r] + s1[r]; }
        lrun = lrun * alpha + rs;
#pragma unroll
        for (int d = 0; d < 4; ++d)
#pragma unroll
            for (int r = 0; r < 16; ++r) o[d][r] *= alpha;
        bf16x8 pf[2][2];
#pragma unroll
        for (int s = 0; s < 2; ++s) {
            u32x4 w0, w1;
            w0.x = pkbf(s0[8 * s + 0], s0[8 * s + 1]); w0.y = pkbf(s0[8 * s + 2], s0[8 * s + 3]); w0.z = pkbf(s0[8 * s + 4], s0[8 * s + 5]); w0.w = pkbf(s0[8 * s + 6], s0[8 * s + 7]);
            w1.x = pkbf(s1[8 * s + 0], s1[8 * s + 1]); w1.y = pkbf(s1[8 * s + 2], s1[8 * s + 3]); w1.z = pkbf(s1[8 * s + 4], s1[8 * s + 5]); w1.w = pkbf(s1[8 * s + 6], s1[8 * s + 7]);
            pf[0][s] = __builtin_bit_cast(bf16x8, w0); pf[1][s] = __builtin_bit_cast(bf16x8, w1);
        }
#pragma unroll
        for (int d = 0; d < 4; ++d)
#pragma unroll
            for (int kt = 0; kt < 2; ++kt)
#pragma unroll
                for (int s = 0; s < 2; ++s) {
                    const LAS unsigned char* vp = vb + (vroff + 32 * d + r32) * C::VROWB + (32 * kt + 16 * s + 4 * hi) * 2;
                    const s16x4 lo = *(const LAS s16x4*)(vp), hh = *(const LAS s16x4*)(vp + 16);
                    const bf16x8 vf = (bf16x8){lo[0], lo[1], lo[2], lo[3], hh[0], hh[1], hh[2], hh[3]};
                    o[d] = __builtin_amdgcn_mfma_f32_32x32x16_bf16(vf, pf[kt][s], o[d], 0, 0, 0);
                }
        if (t + 1 < NT) ATT_STOREV((t + 1) & 1);
        __syncthreads();
    }
#undef ATT_LOADK
#undef ATT_LOADV
#undef ATT_STOREK
#undef ATT_STOREV
    const float linv = 1.0f / (lrun + __shfl_xor(lrun, 32));
#pragma unroll
    for (int d = 0; d < 4; ++d)
#pragma unroll
        for (int r = 0; r < 16; ++r) o[d][r] *= linv;
    if constexpr (DIFF) {
        LAS float* ex = (LAS float*)lds + (size_t)qsub * 64 * 64 + lane;
        if (role == 1) {
#pragma unroll
            for (int d = 0; d < 4; ++d)
#pragma unroll
                for (int r = 0; r < 16; ++r) ex[(d * 16 + r) * 64] = o[d][r];
        }
        __syncthreads();
        if (role == 0) {
            float ss = 0.f;
#pragma unroll
            for (int d = 0; d < 4; ++d)
#pragma unroll
                for (int r = 0; r < 16; ++r) { const float v = o[d][r] - lam * ex[(d * 16 + r) * 64]; o[d][r] = v; ss += v * v; }
            ss += __shfl_xor(ss, 32);
            const float rstd = outscale / sqrtf(ss * (1.f / 128.f) + EPS);
            bf16* op = P.O + (size_t)(qsub * 32 + r32) * P.ldo;
#pragma unroll
            for (int d = 0; d < 4; ++d)
#pragma unroll
                for (int rg = 0; rg < 4; ++rg) { const int dd = 32 * d + 8 * rg + 4 * hi; const f32x4 g = *(const f32x4*)(subg + dd);
                    u32x2 w; w.x = pkbf(o[d][4 * rg + 0] * rstd * g.x, o[d][4 * rg + 1] * rstd * g.y); w.y = pkbf(o[d][4 * rg + 2] * rstd * g.z, o[d][4 * rg + 3] * rstd * g.w);
                    *(GAS u32x2*)(op + dd) = w; }
        }
        __syncthreads();
    } else {
        bf16* op = P.O + (size_t)(qsub * 32 + r32) * P.ldo + role * 128;
#pragma unroll
        for (int d = 0; d < 4; ++d)
#pragma unroll
            for (int rg = 0; rg < 4; ++rg) { const int dd = 32 * d + 8 * rg + 4 * hi;
                u32x2 w; w.x = pkbf(o[d][4 * rg + 0], o[d][4 * rg + 1]); w.y = pkbf(o[d][4 * rg + 2], o[d][4 * rg + 3]);
                *(GAS u32x2*)(op + dd) = w; }
    }
}
constexpr int OST_ROWB = 272, OST_BYTES = 32 * OST_ROWB;
__device__ __forceinline__ void stage_rows_out(const LAS unsigned char* stg, bf16* orow0, int ldo, int lane) {
    asm volatile("s_waitcnt lgkmcnt(0)" ::: "memory");
#pragma unroll
    for (int i = 0; i < 8; ++i) { const int row = 4 * i + (lane >> 4), ch = lane & 15;
        const u32x4 v = *(const LAS u32x4*)(stg + row * OST_ROWB + ch * 16);
        *(GAS u32x4*)(orow0 + (size_t)row * ldo + ch * 8) = v;
        if (i & 1) __builtin_amdgcn_sched_barrier(0); }
}
template <bool DIFF> struct PA {
    static constexpr int TK = DIFF ? 64 : 32, NKT = TK / 32, NKS = DIFF ? 4 : 16, KW = DIFF ? 128 : 256, VR = DIFF ? 128 : 256;
    static constexpr int KROWB = KW * 2 + 16, VROWB = TK * 2 + 16, KB = TK * KROWB, VB = VR * VROWB, VOFF = 2 * KB, LDSB = 2 * KB + 3 * VB;
    static constexpr int KCH = KW / 8, VCH = TK / 8;
    static constexpr int NQK = NKS * NKT, NPV = 4 * NKT * 2, EPG = (16 * NKT) / NQK;
    static_assert(TK * KCH == 2 * NTHR && VR * VCH == 2 * NTHR, "two staging pieces per thread for K and for V");
};
#ifndef DTHR_VAL
#define DTHR_VAL 8.0f
#endif
constexpr float DTHR = DTHR_VAL;
__device__ __forceinline__ float half_swap_max(float m) {
    auto rr = __builtin_amdgcn_permlane32_swap(__float_as_uint(m), __float_as_uint(m), false, false);
    return fmaxf(__uint_as_float(rr[0]), __uint_as_float(rr[1]));
}
__device__ __forceinline__ float half_swap_sum(float m) {
    auto rr = __builtin_amdgcn_permlane32_swap(__float_as_uint(m), __float_as_uint(m), false, false);
    return __uint_as_float(rr[0]) + __uint_as_float(rr[1]);
}
__device__ __forceinline__ float max16(const f32x16& a) {
    float x = fmaxf(fmaxf(a[0], a[1]), a[2]), y = fmaxf(fmaxf(a[3], a[4]), a[5]);
    x = fmaxf(fmaxf(x, a[6]), a[7]); y = fmaxf(fmaxf(y, a[8]), a[9]); x = fmaxf(fmaxf(x, a[10]), a[11]); y = fmaxf(fmaxf(y, a[12]), a[13]); x = fmaxf(fmaxf(x, a[14]), a[15]);
    return fmaxf(x, y);
}
template <bool DIFF> __device__ __forceinline__ void pipe_attn_unit(const Frame& F, const AttnPtrs& P, float lam, float outscale, const float* subg) {
    typedef PA<DIFF> C;
    const int tid = F.tid, lane = F.lane, wid = F.wave, r32 = lane & 31, hi = lane >> 5, qsub = wid >> 1, role = wid & 1;
    LAS unsigned char* lds = F.lds;
    bf16x8 qf[C::NKS];
    { const bf16* qp = P.Q + (size_t)(qsub * 32 + r32) * P.ldq + (DIFF ? role * 64 : 0) + hi * 8;
#pragma unroll
      for (int ks = 0; ks < C::NKS; ++ks) qf[ks] = *(const GAS bf16x8*)(qp + ks * 16); }
    u32x4 kst[2], vst[2];
    const int NT = P.nkeys / C::TK;
    const int kkey0 = tid / C::KCH, kch = tid % C::KCH, vrow0 = tid / C::VCH, vch = tid % C::VCH;
    const bf16* kg = P.K + (size_t)kkey0 * P.ldk + kch * 8; const bf16* vg = P.VT + (size_t)vrow0 * P.ldv + vch * 8;
    const int kl = kkey0 * C::KROWB + kch * 16, vl = vrow0 * C::VROWB + (vch >> 1) * 32 + (vch & 1) * 8;
#define DA_LOADK(t) do { kst[0] = *(const GAS u32x4*)(kg + (size_t)(t) * C::TK * P.ldk); kst[1] = *(const GAS u32x4*)(kg + (size_t)((t) * C::TK + C::TK / 2) * P.ldk); } while (0)
#define DA_LOADV(t) do { vst[0] = *(const GAS u32x4*)(vg + (size_t)(t) * C::TK); vst[1] = *(const GAS u32x4*)(vg + (size_t)(C::VR / 2) * P.ldv + (size_t)(t) * C::TK); } while (0)
#define DA_STOREK(b) do { *(LAS u32x4*)(lds + (b) * C::KB + kl) = kst[0]; *(LAS u32x4*)(lds + (b) * C::KB + kl + (C::TK / 2) * C::KROWB) = kst[1]; } while (0)
#define DA_STOREV(off) do { LAS unsigned char* v_ = lds + (off) + vl; *(LAS u32x2*)(v_) = (u32x2){vst[0].x, vst[0].y}; *(LAS u32x2*)(v_ + 16) = (u32x2){vst[0].z, vst[0].w}; \
        *(LAS u32x2*)(v_ + (C::VR / 2) * C::VROWB) = (u32x2){vst[1].x, vst[1].y}; *(LAS u32x2*)(v_ + (C::VR / 2) * C::VROWB + 16) = (u32x2){vst[1].z, vst[1].w}; } while (0)
    const int koff = (DIFF ? role * 128 : 0) + hi * 16, vroff = DIFF ? 0 : role * 128;
    const f32x16 Z16 = (f32x16){0.f, 0.f, 0.f, 0.f, 0.f, 0.f, 0.f, 0.f, 0.f, 0.f, 0.f, 0.f, 0.f, 0.f, 0.f, 0.f};
    f32x16 o[4]; o[0] = Z16; o[1] = Z16; o[2] = Z16; o[3] = Z16;
    f32x16 A[C::NKT], B[C::NKT];
    float mref, lrun = 0.f;
#define DA_PIN(x) asm volatile("" : "+v"(x))
#define DA_SB() __builtin_amdgcn_sched_barrier(0)
#define DA_KFR(i) (*(const LAS bf16x8*)(kb_ + ((i) % C::NKT) * 32 * C::KROWB + ((i) / C::NKT) * 32))
#define DA_VOFS(i) ((32 * ((i) / (2 * C::NKT))) * C::VROWB + (32 * (((i) >> 1) % C::NKT) + 16 * ((i) & 1)) * 2)
#define DA_VFR(i) (*(const LAS bf16x8*)(vb_ + DA_VOFS(i)))
#define DA_PV(i) do { \
        o[(i) / (2 * C::NKT)] = __builtin_amdgcn_mfma_f32_32x32x16_bf16(vfr_[(i) % 3], __builtin_bit_cast(bf16x8, pw_[(((i) >> 1) % C::NKT) * 2 + ((i) & 1)]), o[(i) / (2 * C::NKT)], 0, 0, 0); } while (0)
#define DA_QK0(S, b) do { const LAS unsigned char* kb_ = lds + (b) * C::KB + r32 * C::KROWB + koff; \
        _Pragma("unroll") for (int i = 0; i < C::NQK; ++i) { const bf16x8 a_ = DA_KFR(i); \
            if (i < C::NKT) S[i % C::NKT] = __builtin_amdgcn_mfma_f32_32x32x16_bf16(a_, qf[i / C::NKT], Z16, 0, 0, 0); else S[i % C::NKT] = __builtin_amdgcn_mfma_f32_32x32x16_bf16(a_, qf[i / C::NKT], S[i % C::NKT], 0, 0, 0); } } while (0)
    DA_LOADK(0); DA_LOADV(0);
    DA_STOREK(0); DA_LOADK(1); DA_STOREV(C::VOFF);
    __syncthreads();
    DA_QK0(A, 0);
    DA_STOREK(1); DA_LOADV(1);
    { float mx = max16(A[0]); if (C::NKT == 2) mx = fmaxf(mx, max16(A[C::NKT - 1])); mref = half_swap_max(mx); }
#pragma unroll
    for (int kt = 0; kt < C::NKT; ++kt)
#pragma unroll
        for (int r = 0; r < 16; ++r) A[kt][r] = __builtin_amdgcn_exp2f(A[kt][r] - mref);
    DA_STOREV(C::VOFF + C::VB);
    DA_LOADK(2); DA_LOADV(2);
    __syncthreads();
    int vprev = 0, vcur = C::VB, vnext = 2 * C::VB;
#define DA_STEP(S, Pv, t, KBUF, PF, PF2) do { \
        if (PF) DA_STOREK(1 - (KBUF)); if (PF2) DA_LOADK((t) + 2); \
        const LAS unsigned char* kb_ = lds + (KBUF) * C::KB + r32 * C::KROWB + koff; \
        bf16x8 kf_[3]; kf_[0] = DA_KFR(0); kf_[1] = DA_KFR(1); \
        u32x4 pw_[2 * C::NKT]; float rs_ = 0.f; \
        DA_SB(); \
        _Pragma("unroll") for (int i = 0; i < C::NQK; ++i) { \
            if (i + 2 < C::NQK) kf_[(i + 2) % 3] = DA_KFR(i + 2); \
            if (i < C::NKT) S[i % C::NKT] = __builtin_amdgcn_mfma_f32_32x32x16_bf16(kf_[i % 3], qf[i / C::NKT], Z16, 0, 0, 0); \
            else S[i % C::NKT] = __builtin_amdgcn_mfma_f32_32x32x16_bf16(kf_[i % 3], qf[i / C::NKT], S[i % C::NKT], 0, 0, 0); \
              \
            _Pragma("unroll") for (int e = i * C::EPG; e < (i + 1) * C::EPG; ++e) { rs_ += Pv[e >> 4][e & 15]; \
                if (e & 1) { const int kt_ = e >> 4, r_ = e & 15; pw_[kt_ * 2 + (r_ >> 3)][(r_ & 7) >> 1] = pkbf(Pv[kt_][r_ - 1], Pv[kt_][r_]); } } \
            DA_PIN(rs_); if (((i + 1) * C::EPG) % 8 == 0 || C::EPG >= 2) DA_PIN(pw_[(((i + 1) * C::EPG - 1) >> 4) * 2 + ((((i + 1) * C::EPG - 1) & 15) >> 3)]); \
            DA_SB(); } \
        lrun += rs_; \
        if (PF) DA_STOREV(C::VOFF + vnext); if (PF2) DA_LOADV((t) + 2); \
        float mx_ = max16(S[0]); if (C::NKT == 2) mx_ = fmaxf(mx_, max16(S[C::NKT - 1])); mx_ = half_swap_max(mx_); \
        float dl_ = 0.f; bool resc_ = false; \
        if (__builtin_expect(__any(mx_ > mref + DTHR), 0)) { dl_ = fmaxf(mx_ - mref, 0.f); mref += dl_; resc_ = true; } \
        const LAS unsigned char* vb_ = lds + C::VOFF + vprev + (vroff + r32) * C::VROWB + hi * 16; \
        bf16x8 vfr_[3]; vfr_[0] = DA_VFR(0); vfr_[1] = DA_VFR(1); \
        DA_SB(); \
        _Pragma("unroll") for (int i = 0; i < C::NPV; ++i) { \
            if (i + 2 < C::NPV) vfr_[(i + 2) % 3] = DA_VFR(i + 2); \
            DA_PV(i); \
            { const int e0_ = 2 * i, e1_ = 2 * i + 1; S[e0_ >> 4][e0_ & 15] = __builtin_amdgcn_exp2f(S[e0_ >> 4][e0_ & 15] - mref); S[e1_ >> 4][e1_ & 15] = __builtin_amdgcn_exp2f(S[e1_ >> 4][e1_ & 15] - mref); } \
            DA_PIN(S[(2 * i) >> 4]); DA_SB(); } \
        if (resc_) { const float f_ = __builtin_amdgcn_exp2f(-dl_); lrun *= f_; \
            _Pragma("unroll") for (int d = 0; d < 4; ++d) _Pragma("unroll") for (int r = 0; r < 16; ++r) o[d][r] *= f_; } \
        __syncthreads(); \
        { const int tmp_ = vprev; vprev = vcur; vcur = vnext; vnext = tmp_; } \
    } while (0)
    if (wid >= 4) __builtin_amdgcn_s_setprio(1);
#pragma unroll 1
    for (int t = 1; t < NT - 3; t += 2) {
        DA_STEP(B, A, t, 1, true, true);
        DA_STEP(A, B, t + 1, 0, true, true);
    }
    DA_STEP(B, A, NT - 3, 1, true, true);
    DA_STEP(A, B, NT - 2, 0, true, false);
    DA_STEP(B, A, NT - 1, 1, false, false);
    {
        float rs_ = 0.f; u32x4 pw_[2 * C::NKT];
#pragma unroll
        for (int kt = 0; kt < C::NKT; ++kt) {
#pragma unroll
            for (int r = 0; r < 16; ++r) rs_ += B[kt][r];
#pragma unroll
            for (int s = 0; s < 2; ++s) { pw_[kt * 2 + s].x = pkbf(B[kt][8 * s + 0], B[kt][8 * s + 1]); pw_[kt * 2 + s].y = pkbf(B[kt][8 * s + 2], B[kt][8 * s + 3]); pw_[kt * 2 + s].z = pkbf(B[kt][8 * s + 4], B[kt][8 * s + 5]); pw_[kt * 2 + s].w = pkbf(B[kt][8 * s + 6], B[kt][8 * s + 7]); } }
        lrun += rs_;
        const LAS unsigned char* vb_ = lds + C::VOFF + vprev + (vroff + r32) * C::VROWB + hi * 16;
#pragma unroll
        for (int i = 0; i < C::NPV; ++i) { const bf16x8 vf_ = DA_VFR(i);
            o[i / (2 * C::NKT)] = __builtin_amdgcn_mfma_f32_32x32x16_bf16(vf_, __builtin_bit_cast(bf16x8, pw_[((i >> 1) % C::NKT) * 2 + (i & 1)]), o[i / (2 * C::NKT)], 0, 0, 0); }
    }
#undef DA_STEP
#undef DA_QK0
#undef DA_PIN
#undef DA_SB
#undef DA_KFR
#undef DA_VOFS
#undef DA_VFR
#undef DA_PV
#undef DA_LOADK
#undef DA_LOADV
#undef DA_STOREK
#undef DA_STOREV
    if (wid >= 4) __builtin_amdgcn_s_setprio(0);
    const float linv = 1.0f / half_swap_sum(lrun);
#pragma unroll
    for (int d = 0; d < 4; ++d)
#pragma unroll
        for (int r = 0; r < 16; ++r) o[d][r] *= linv;
    __syncthreads();
    if constexpr (DIFF) {
        LAS float* ex = (LAS float*)lds + (size_t)qsub * 64 * 64 + lane;
        if (role == 1) {
#pragma unroll
            for (int d = 0; d < 4; ++d)
#pragma unroll
                for (int r = 0; r < 16; ++r) ex[(d * 16 + r) * 64] = o[d][r];
        }
        __syncthreads();
        if (role == 0) {
            float ss = 0.f;
#pragma unroll
            for (int d = 0; d < 4; ++d)
#pragma unroll
                for (int r = 0; r < 16; ++r) { const float v = o[d][r] - lam * ex[(d * 16 + r) * 64]; o[d][r] = v; ss += v * v; }
            ss = half_swap_sum(ss);
            const float rstd = outscale / sqrtf(ss * (1.f / 128.f) + EPS);
            int ln_ = lane; asm volatile("" : "+v"(ln_));
            const int r32e = ln_ & 31, hie = ln_ >> 5;
            LAS unsigned char* stg = lds + 65536 + qsub * OST_BYTES;
#pragma unroll
            for (int d = 0; d < 4; ++d)
#pragma unroll
                for (int rg = 0; rg < 4; ++rg) { const int dd = 32 * d + 8 * rg + 4 * hie; const f32x4 g = *(const f32x4*)(subg + dd);
                    u32x2 w; w.x = pkbf(o[d][4 * rg + 0] * rstd * g.x, o[d][4 * rg + 1] * rstd * g.y); w.y = pkbf(o[d][4 * rg + 2] * rstd * g.z, o[d][4 * rg + 3] * rstd * g.w);
                    *(LAS u32x2*)(stg + r32e * OST_ROWB + dd * 2) = w; if (rg == 3) __builtin_amdgcn_sched_barrier(0); }
            stage_rows_out(stg, P.O + (size_t)(qsub * 32) * P.ldo, P.ldo, ln_);
        }
        __syncthreads();
    } else {
        int ln_ = lane; asm volatile("" : "+v"(ln_)); const int r32e = ln_ & 31, hie = ln_ >> 5;
        LAS unsigned char* stg = lds + wid * OST_BYTES;
#pragma unroll
        for (int d = 0; d < 4; ++d)
#pragma unroll
            for (int rg = 0; rg < 4; ++rg) { const int dd = 32 * d + 8 * rg + 4 * hie; u32x2 w; w.x = pkbf(o[d][4 * rg + 0], o[d][4 * rg + 1]); w.y = pkbf(o[d][4 * rg + 2], o[d][4 * rg + 3]);
                *(LAS u32x2*)(stg + r32e * OST_ROWB + dd * 2) = w; }
        stage_rows_out(stg, P.O + (size_t)(qsub * 32) * P.ldo + role * 128, P.ldo, ln_);
        __syncthreads();
    }
}
#ifndef MK_PER_STEP
#define MK_PER_STEP 0
#endif
#ifndef PH_MASK
#define PH_MASK 0x1fff
#endif
#ifndef DUP_MASK
#define DUP_MASK 0
#endif
#define REPS(k) ((((DUP_MASK) >> (k)) & 1) ? 2 : 1)
#ifndef SITE_MASK
#define SITE_MASK 7
#endif
#define PFRAME() Frame P = F; { int t_ = F.tid; asm volatile("" : "+v"(t_)); P.tid = t_; P.lane = t_ & 63; P.wave = __builtin_amdgcn_readfirstlane(t_ >> 6); int z_ = 0; asm volatile("" : "+s"(z_)); P.zs = z_; } \
    const int gw = P.vcu * NWAVES + P.wave, NGW = P.G * NWAVES; (void)gw; (void)NGW; unsigned char* const ws = AWS(args, P.zs); (void)ws
#define WSP(off) ((bf16*)(ws + (off)))
#define P_WL()  (WSP(WS_W) + (size_t)l * WL_STRIDE)
#define P_HN()  WSP(WS_HN)
#define P_QK()  WSP(WS_QK)
#define P_VHT() WSP(WS_VHT)
#define P_MIX() WSP(WS_MIX)
#define P_MO()  WSP(WS_QK)
#define P_XO()  WSP(WS_QK)
#define P_HID() WSP(WS_QK)
#define P_QX()  WSP(WS_VHT)
#define P_OX()  (WSP(WS_VHT) + (size_t)TOK * 1024)
#define P_FO()  WSP(WS_MIX)
#define P_MN()  WSP(WS_MN)
#define P_KX()  WSP(WS_KX)
#define P_VXT() WSP(WS_VXT)
#define P_XRES() (AOUT(args, P.zs) + (size_t)g * TOK * DM)
#define P_RS() ((float*)(ws + WS_RS))

__global__ void __launch_bounds__(NTHR, 2) hymba_fwd(Args args) {
    extern __shared__ __attribute__((aligned(16))) unsigned char lds_raw[];
    Frame F;
    F.lds = (LAS unsigned char*)lds_raw;
    F.tid = threadIdx.x; F.lane = F.tid & 63; F.wave = __builtin_amdgcn_readfirstlane(F.tid >> 6); F.zs = 0;
    F.G = gridDim.x; { const int bx = blockIdx.x; F.vcu = (F.G % 8 == 0) ? (bx % 8) * (F.G / 8) + bx / 8 : bx; }
    volatile LAS unsigned* MISC = (volatile LAS unsigned*)(F.lds + LDS_MISC);
    if (F.tid < 64) MISC[F.tid] = 0u;
    __syncthreads();
    XcdBarrier bar = xcd_barrier_post((unsigned*)(AWS(args, 0) + WS_CTL) + 1024 + (size_t)args.li * XCD_BAR_WORDS, MISC);
    const int s_lo = args.s_lo, s_hi = args.s_hi;
#define RUNK(s, k) ((((PH_MASK) >> (k)) & 1) && s_lo <= (s) && (s) < s_hi)
#ifndef GEMM_ALIGN
#define GEMM_ALIGN true
#endif
#ifndef GEMM_SP2
#define GEMM_SP2 true
#endif
#ifndef SEAM_REPS
#define SEAM_REPS 1
#endif
#define SEAM(s) do { if ((s) + 1 < s_hi) { for (int sr_ = 0; sr_ < SEAM_REPS; ++sr_) xcd_barrier(bar); } } while (0)

    if (RUNK(0, 0)) { _Pragma("unroll 1") for (int rep_ = 0; rep_ < REPS(0); ++rep_) { PFRAME(); phase_prologue(P, args); } SEAM(0); }

#pragma unroll 1
    for (int g = 0; g < 2; ++g) {
#pragma unroll 1
        for (int l = 0; l <= DEPTH; ++l) {
            const int sb = 1 + g * 49 + l * 12;
            const int L = grpL(g), NB = grpB(g), MG = grpMem(g);
            if (RUNK(sb + 0, 1)) {
                _Pragma("unroll 1") for (int rep_ = 0; rep_ < REPS(1); ++rep_) {
                { PFRAME();
                bf16* XB = P_HN(); float* RS = P_RS(); const float* gpost = AIN(args, 31, P.zs) + (size_t)(l > 0 ? l - 1 : 0) * DM;
#ifndef SKIP_ROWOPA
                if (l == 0) { const float* xi = AIN(args, g, P.zs); for (int m = gw; m < TOK; m += 4 * NGW) rowop_bf<0, 4>(xi, XB, nullptr, nullptr, RS, nullptr, m, NGW, P.lane); }
                else if (l < DEPTH) { const bf16* FO = P_FO(); for (int m = gw; m < TOK; m += 8 * NGW) rowop_bf<1, 8>(nullptr, XB, FO, gpost, RS, nullptr, m, NGW, P.lane); }
                else { const bf16* FO = P_FO(); float* xres = P_XRES(); for (int m = gw; m < TOK; m += 8 * NGW) rowop_bf<2, 8>(nullptr, XB, FO, gpost, nullptr, xres, m, NGW, P.lane); }
#endif
                if (l < DEPTH) {
                    const float* gm = AIN(args, 25, P.zs) + (size_t)l * DM; const float* memin = AIN(args, 2 + g, P.zs); bf16* MN = P_MN();
                    for (int m = gw; m < MG; m += NGW) rowop_rows<1>(memin, nullptr, nullptr, nullptr, gm, MN, m, 0, P.lane);
                    const int nit = (L / 64) * 4;
                    _Pragma("unroll 1") for (int r2_ = 0; r2_ < REPS(14); ++r2_)
                    for (int it = P.vcu; it < nit; it += P.G) filt_f1_item(P, args, l, L, it);
                } }
                }
                SEAM(sb + 0);
            }
            if (l == DEPTH) continue;
            if (RUNK(sb + 1, 2)) {
                _Pragma("unroll 1") for (int rep_ = 0; rep_ < REPS(2); ++rep_) {
                { PFRAME(); pg8::Gemm gq{P_HN(), P_WL() + WL_IN, TOK, 1024, 1024}; pg8::StaticOrder S; S.init(TOK, 1024, P.G, (int)blockIdx.x);
                  pg8::EpiRopeQK E{P_QK(), (const float*)(ws + WS_TAB), L - 1, 0.125f * LOG2E, P_RS()};
                  pg8::gemm_phase<pg8::EpiRopeQK, pg8::StaticOrder, GEMM_ALIGN, GEMM_SP2>(P.lds, gq, S, E); }
                { PFRAME(); pg8::Gemm gv{P_WL() + WL_IN + (size_t)1024 * 1024, P_HN(), 2048, TOK, 1024}; pg8::StaticOrder S; S.init(2048, TOK, P.G, (int)blockIdx.x);
                  pg8::EpiBf16 E{P_VHT(), TOK, 1.f, nullptr, P_RS()};
                  pg8::gemm_phase<pg8::EpiBf16, pg8::StaticOrder, GEMM_ALIGN, GEMM_SP2>(P.lds, gv, S, E); }
                __syncthreads();
                _Pragma("unroll 1") for (int r2_ = 0; r2_ < REPS(15); ++r2_)
                { PFRAME();
                if (g == 0) { for (int c = P.vcu; c < 512; c += P.G) filt_f2_item<12>(P, args, l, c); }
                else        { for (int c = P.vcu; c < 512; c += P.G) filt_f2_item<14>(P, args, l, c); } }
                }
                SEAM(sb + 1);
            }
            if (RUNK(sb + 2, 3)) {
                _Pragma("unroll 1") for (int rep_ = 0; rep_ < REPS(3); ++rep_) {
                { PFRAME();
                float lam, lam_init;
                { const float p1 = AIN(args, 7, P.zs)[l * 64 + P.lane] * AIN(args, 8, P.zs)[l * 64 + P.lane]; const float p2 = AIN(args, 9, P.zs)[l * 64 + P.lane] * AIN(args, 10, P.zs)[l * 64 + P.lane];
                  lam_init = 0.8f - 0.6f * expf(-0.3f * (float)l); lam = expf(wave_sum(p1)) - expf(wave_sum(p2)) + lam_init; }
                const int nqb = L / 128, nun = NB * 4 * nqb; bf16* QK = P_QK(); bf16* VHT = P_VHT(); bf16* MIX = P_MIX(); const float* sg = AIN(args, 11, P.zs) + l * 128;
#pragma unroll 1
                for (int u = P.vcu; u < nun; u += P.G) {
                    const int qb = u % nqb, bh = u / nqb, h = bh & 3, b = bh >> 2; const size_t t0 = (size_t)b * L;
                    AttnPtrs A; A.Q = QK + (t0 + (size_t)qb * 128) * 1024 + h * 128; A.ldq = 1024;
                    A.K = QK + t0 * 1024 + 512 + h * 128; A.ldk = 1024; A.VT = VHT + (size_t)(h * 128) * TOK + t0; A.ldv = TOK; A.nkeys = L;
                    A.O = MIX + (t0 + (size_t)qb * 128) * 1024 + h * 128; A.ldo = 1024;
#ifndef SKIP_DATTN
                    pipe_attn_unit<true>(P, A, lam, 1.f - lam_init, sg);
#endif
                } } }
                __syncthreads();
                _Pragma("unroll 1") for (int rep_ = 0; rep_ < REPS(13); ++rep_) {
                { PFRAME();
                if (g == 0) { for (int u = P.vcu; u < 512 * 4; u += P.G) hyena_unit<12, 4>(P, args, l, u >> 2, (u & 3) * 4); }
                else        { for (int u = P.vcu; u < 512 * 4; u += P.G) hyena_unit<14, 1>(P, args, l, u >> 2, u & 3); } }
                }
                SEAM(sb + 2);
            }
            if (RUNK(sb + 3, 4)) {
                _Pragma("unroll 1") for (int rep_ = 0; rep_ < REPS(4); ++rep_) { { PFRAME(); for (int t = P.vcu; t < 8 * (TOK / 64); t += P.G) ytrans_tile(P, args, t); } }
                SEAM(sb + 3); }
            if (RUNK(sb + 4, 5)) {
                _Pragma("unroll 1") for (int rep_ = 0; rep_ < REPS(5); ++rep_) {
                { PFRAME(); pg8::Gemm gm{P_MIX(), P_WL() + WL_OUT, TOK, 1024, 1024}; pg8::StaticOrder S; S.init(TOK, 1024, P.G, (int)blockIdx.x);
                  pg8::EpiBf16 E{P_MO(), 1024, 1.f, nullptr, nullptr};
                  pg8::gemm_phase<pg8::EpiBf16, pg8::StaticOrder, GEMM_ALIGN, GEMM_SP2>(P.lds, gm, S, E); }
                }
                SEAM(sb + 4);
            }
            if (RUNK(sb + 5, 6)) {
                _Pragma("unroll 1") for (int rep_ = 0; rep_ < REPS(6); ++rep_) {
                { PFRAME();
                bf16* XB = P_HN(); float* RS = P_RS(); const bf16* MO = P_MO(); const float* gpost = AIN(args, 5, P.zs) + (size_t)l * DM;
                if (rep_ == 0) for (int m = gw; m < TOK; m += 8 * NGW) rowop_bf<1, 8>(nullptr, XB, MO, gpost, RS, nullptr, m, NGW, P.lane);
                else for (int m = gw; m < TOK; m += 8 * NGW) rowop_bf<1, 8>(nullptr, XB, MO, gpost, (float*)(ws + WS_MIX), nullptr, m, NGW, P.lane, WSP(WS_VHT)); }
                }
                SEAM(sb + 5);
            }
            if (RUNK(sb + 6, 7)) {
                _Pragma("unroll 1") for (int rep_ = 0; rep_ < REPS(7); ++rep_) {
                if (SITE_MASK & 1) { PFRAME(); pg8::Gemm gq{P_HN(), P_WL() + WL_Q, TOK, 1024, 1024}; pg8::StaticOrder S; S.init(TOK, 1024, P.G, (int)blockIdx.x);
                  pg8::EpiBf16 E{P_QX(), 1024, 0.0625f * LOG2E, P_RS(), nullptr};
                  pg8::gemm_phase<pg8::EpiBf16, pg8::StaticOrder, GEMM_ALIGN, GEMM_SP2>(P.lds, gq, S, E); }
                if (SITE_MASK & 2) { PFRAME(); pg8::Gemm gk{P_MN(), P_WL() + WL_K, MG, 1024, 1024}; pg8::StaticOrder S; S.init(MG, 1024, P.G, (int)blockIdx.x);
                  pg8::EpiBf16 E{P_KX(), 1024, 1.f, nullptr, nullptr};
                  pg8::gemm_phase<pg8::EpiBf16, pg8::StaticOrder, GEMM_ALIGN, GEMM_SP2>(P.lds, gk, S, E); }
                if (SITE_MASK & 4) { PFRAME(); pg8::Gemm gv{P_WL() + WL_V, P_MN(), 1024, MG, 1024}; pg8::StaticOrder S; S.init(1024, MG, P.G, (int)((blockIdx.x + P.G / 2) % P.G));
                  pg8::EpiBf16 E{P_VXT(), MG, 1.f, nullptr, nullptr};
                  pg8::gemm_phase<pg8::EpiBf16, pg8::StaticOrder, GEMM_ALIGN, GEMM_SP2>(P.lds, gv, S, E); }
                }
                SEAM(sb + 6);
            }
            if (RUNK(sb + 7, 8)) {
                _Pragma("unroll 1") for (int rep_ = 0; rep_ < REPS(8); ++rep_) {
                { PFRAME();
                const int nqb = L / 128, nun = NB * 4 * nqb; bf16* QX = P_QX(); bf16* KX = P_KX(); bf16* VXT = P_VXT(); bf16* OX = P_OX();
#pragma unroll 1
                for (int u = P.vcu; u < nun; u += P.G) {
                    const int qb = u % nqb, bh = u / nqb, h = bh & 3, b = bh >> 2; const size_t t0 = (size_t)b * L;
                    AttnPtrs A; A.Q = QX + (t0 + (size_t)qb * 128) * 1024 + h * 256; A.ldq = 1024;
                    A.K = KX + (size_t)(b * NMEMK) * 1024 + h * 256; A.ldk = 1024; A.VT = VXT + (size_t)(h * 256) * MG + (size_t)b * NMEMK; A.ldv = MG; A.nkeys = NMEMK;
                    A.O = OX + (t0 + (size_t)qb * 128) * 1024 + h * 256; A.ldo = 1024;
                    pipe_attn_unit<false>(P, A, 0.f, 1.f, nullptr);
                } }
                }
                SEAM(sb + 7);
            }
            if (RUNK(sb + 8, 9)) {
                _Pragma("unroll 1") for (int rep_ = 0; rep_ < REPS(9); ++rep_) {
                { PFRAME(); pg8::Gemm gm{P_OX(), P_WL() + WL_O, TOK, 1024, 1024}; pg8::StaticOrder S; S.init(TOK, 1024, P.G, (int)blockIdx.x);
                  pg8::EpiBf16 E{P_XO(), 1024, 1.f, nullptr, nullptr};
                  pg8::gemm_phase<pg8::EpiBf16, pg8::StaticOrder, GEMM_ALIGN, GEMM_SP2>(P.lds, gm, S, E); }
                }
                SEAM(sb + 8);
            }
            if (RUNK(sb + 9, 10)) {
                _Pragma("unroll 1") for (int rep_ = 0; rep_ < REPS(10); ++rep_) {
                { PFRAME();
                bf16* XB = P_HN(); float* RS = P_RS(); const bf16* XO = P_XO(); const float* gpost = AIN(args, 24, P.zs) + (size_t)l * DM;
                if (rep_ == 0) for (int m = gw; m < TOK; m += 8 * NGW) rowop_bf<1, 8>(nullptr, XB, XO, gpost, RS, nullptr, m, NGW, P.lane);
                else for (int m = gw; m < TOK; m += 8 * NGW) rowop_bf<1, 8>(nullptr, XB, XO, gpost, (float*)(ws + WS_MIX), nullptr, m, NGW, P.lane, WSP(WS_VHT)); }
                }
                SEAM(sb + 9);
            }
            if (RUNK(sb + 10, 11)) {
                _Pragma("unroll 1") for (int rep_ = 0; rep_ < REPS(11); ++rep_) {
#ifdef PANEL_GU
                { PFRAME(); pg8::Gemm gm{P_HN(), P_WL() + WL_GU, TOK, 2 * DFF, 1024}; pg8::PanelOrder S; S.init(TOK, 2 * DFF, P.G, P.vcu, false);
                  pg8::EpiSwiGLU E{P_HID(), DFF, P_RS()};
                  pg8::gemm_phase<pg8::EpiSwiGLU, pg8::PanelOrder, true, true>(P.lds, gm, S, E); }
#else
                { PFRAME(); pg8::Gemm gm{P_HN(), P_WL() + WL_GU, TOK, 2 * DFF, 1024}; pg8::StaticOrder S; S.init(TOK, 2 * DFF, P.G, (int)blockIdx.x);
                  pg8::EpiSwiGLU E{P_HID(), DFF, P_RS()};
                  pg8::gemm_phase<pg8::EpiSwiGLU, pg8::StaticOrder, GEMM_ALIGN, GEMM_SP2>(P.lds, gm, S, E); }
#endif
                }
                SEAM(sb + 10);
            }
            if (RUNK(sb + 11, 12)) {
                _Pragma("unroll 1") for (int rep_ = 0; rep_ < REPS(12); ++rep_) {
                { PFRAME(); pg8::Gemm gm{P_HID(), P_WL() + WL_D, TOK, 1024, DFF}; pg8::StaticOrder S; S.init(TOK, 1024, P.G, (int)blockIdx.x);
                  pg8::EpiBf16 E{P_FO(), 1024, 1.f, nullptr, nullptr};
                  pg8::gemm_phase<pg8::EpiBf16, pg8::StaticOrder, GEMM_ALIGN, GEMM_SP2>(P.lds, gm, S, E); }
                }
                SEAM(sb + 11);
            }
        }
    }
#undef RUNK
#undef SEAM
}

extern "C" void kernel_launch(void* const* d_in, const int* in_sizes, int n_in, void* d_out, int out_size, void* d_ws, size_t ws_size, hipStream_t stream) {
    static int grid = 0;
    if (grid == 0) {
        if (n_in != 35 || out_size != 2 * TOK * DM || ws_size < WS_END) { fprintf(stderr, "kernel_launch: unexpected shapes (n_in %d out %d ws %zu)\n", n_in, out_size, ws_size); grid = -1; return; }
        int dev = 0, cus = 0, per_cu = 0;
        if (hipGetDevice(&dev) != hipSuccess || hipDeviceGetAttribute(&cus, hipDeviceAttributeMultiprocessorCount, dev) != hipSuccess) { grid = -1; return; }
        if (hipFuncSetAttribute((const void*)hymba_fwd, hipFuncAttributeMaxDynamicSharedMemorySize, LDS_BYTES) != hipSuccess) { fprintf(stderr, "kernel_launch: hipFuncSetAttribute failed\n"); grid = -1; return; }
        if (hipOccupancyMaxActiveBlocksPerMultiprocessor(&per_cu, (const void*)hymba_fwd, NTHR, LDS_BYTES) != hipSuccess || per_cu < 1) { fprintf(stderr, "kernel_launch: occupancy query reports %d\n", per_cu); per_cu = 1; }
        (void)hipGetLastError();
        grid = cus;
    }
    if (grid < 0) return;
    (void)hipMemsetAsync((char*)d_ws + WS_CTL, 0, CTL_ZERO_BYTES, stream);
    Args a{};
    for (int i = 0; i < 35; ++i) a.p[i] = d_in[i];
    a.p[35] = d_out; a.p[36] = d_ws; a.pad = 0;
#if MK_PER_STEP
    for (int s = 0; s < N_STEPS; ++s) { a.s_lo = s; a.s_hi = s + 1; a.li = 0; hipLaunchKernelGGL(hymba_fwd, dim3(grid), dim3(NTHR), LDS_BYTES, stream, a); }
#else
    a.s_lo = 0; a.s_hi = N_STEPS; a.li = 0;
    hipLaunchKernelGGL(hymba_fwd, dim3(grid), dim3(NTHR), LDS_BYTES, stream, a);
#endif
}
```
